# Optimizing an MI355X kernel written in HIP

```python
import math
import jax, jax.numpy as jnp
from jax import lax
import numpy as np

D_MODEL = 2048
BATCH = 1
SEQ = 8192
DEPTH = 1

SSM_EXPAND = 2
D_INNER = SSM_EXPAND * D_MODEL
SSM_HEAD_DIM = 64
SSM_HEADS = D_INNER // SSM_HEAD_DIM
SSM_GROUPS = 8
SSM_HEADS_PER_GROUP = SSM_HEADS // SSM_GROUPS
SSM_STATE = 128
SSM_CONV = 4
SSM_CHUNK = 256
D_XBC = D_INNER + 2 * SSM_GROUPS * SSM_STATE
ATTN_HEAD_DIM = 128
ATTN_HEADS = D_MODEL // ATTN_HEAD_DIM
D_ATTN = ATTN_HEADS * ATTN_HEAD_DIM
MOBA_BLOCK = 256
MOBA_TOPK = 3
MOBA_QCHUNK = 32
REL_BUCKETS = 32
REL_MAX_DIST = 128
D_FF = 5632
FFN_CONV = 3
EPS = 1e-6
IN_SPLITS = (D_INNER, D_XBC, SSM_HEADS, D_ATTN, D_ATTN, D_ATTN, 2 * D_MODEL)
D_IN_PROJ = sum(IN_SPLITS)

kernel_name = "hybrid_ssd_moba_convffn"


def _split_points(sizes):
    pts, acc = [], 0
    for s in sizes[:-1]:
        acc += s
        pts.append(acc)
    return pts


def rmsnorm(x, w):
    xf = x.astype(jnp.float32)
    y = xf * lax.rsqrt(jnp.mean(xf * xf, axis=-1, keepdims=True) + EPS)
    return (y * w.astype(jnp.float32)).astype(x.dtype)


def causal_dwconv(x, w, b):
    K = w.shape[0]
    S = x.shape[1]
    xp = jnp.pad(x, ((0, 0), (K - 1, 0), (0, 0)))
    y = b
    for k in range(K):
        y = y + xp[:, k:k + S] * w[k]
    return y


def rel_bucket(dist):
    n = jnp.maximum(dist, 0)
    max_exact = REL_BUCKETS // 2
    nf = jnp.maximum(n, 1).astype(jnp.float32)
    large = max_exact + (jnp.log(nf / max_exact) / math.log(REL_MAX_DIST / max_exact)
                         * (REL_BUCKETS - max_exact)).astype(jnp.int32)
    large = jnp.minimum(large, REL_BUCKETS - 1)
    return jnp.where(n < max_exact, n, large)


def ssd_mixer(z, xbc, dt_raw, conv_w, conv_b, dt_bias, a_log, d_skip, norm_w):
    Bsz, S, _ = xbc.shape
    G, R, P, N, L = SSM_GROUPS, SSM_HEADS_PER_GROUP, SSM_HEAD_DIM, SSM_STATE, SSM_CHUNK
    xbc = jax.nn.silu(causal_dwconv(xbc, conv_w, conv_b))
    xs, Bm, Cm = jnp.split(xbc, [D_INNER, D_INNER + G * N], axis=-1)
    dt = jax.nn.softplus((dt_raw + dt_bias).astype(jnp.float32))
    A = -jnp.exp(a_log.astype(jnp.float32))
    pad = (-S) % L
    Sp = S + pad
    NC = Sp // L

    def chunked(t, tail):
        t = jnp.pad(t, ((0, 0), (0, pad), (0, 0)))
        return t.reshape((Bsz, NC, L) + tail)

    x = chunked(xs, (G, R, P)).astype(jnp.float32)
    Bc = chunked(Bm, (G, N)).astype(jnp.float32)
    Cc = chunked(Cm, (G, N)).astype(jnp.float32)
    dtc = chunked(dt, (G, R))
    X = x * dtc[..., None]
    a_cs = jnp.cumsum(dtc * A.reshape(G, R), axis=2)
    causal = jnp.tril(jnp.ones((L, L), dtype=bool))[None, None, :, :, None, None]
    decay = jnp.exp(jnp.where(causal, a_cs[:, :, :, None] - a_cs[:, :, None, :], -jnp.inf))
    cb = jnp.einsum('bclgn,bcsgn->bclsg', Cc, Bc)
    y_diag = jnp.einsum('bclsg,bclsgr,bcsgrp->bclgrp', cb, decay, X)
    decay_states = jnp.exp(a_cs[:, :, -1:] - a_cs)
    states = jnp.einsum('bclgn,bclgr,bclgrp->bcgrpn', Bc, decay_states, X)
    chunk_decay = jnp.exp(a_cs[:, :, -1])

    def step(h, inp):
        dec, st = inp
        return h * dec[..., None, None] + st, h

    h0 = jnp.zeros((Bsz, G, R, P, N), jnp.float32)
    _, h_prev = lax.scan(step, h0, (jnp.moveaxis(chunk_decay, 1, 0), jnp.moveaxis(states, 1, 0)))
    h_prev = jnp.moveaxis(h_prev, 0, 1)
    y_off = jnp.einsum('bclgn,bcgrpn,bclgr->bclgrp', Cc, h_prev, jnp.exp(a_cs))
    y = y_diag + y_off + x * d_skip.astype(jnp.float32).reshape(G, R)[:, :, None]
    y = y.reshape(Bsz, Sp, D_INNER)[:, :S]
    yg = (y * jax.nn.silu(z.astype(jnp.float32))).reshape(Bsz, S, G, D_INNER // G)
    yg = yg * lax.rsqrt(jnp.mean(yg * yg, axis=-1, keepdims=True) + EPS)
    yg = yg.reshape(Bsz, S, D_INNER) * norm_w.astype(jnp.float32)
    return yg.astype(z.dtype)


def moba_attention(q, k, v, q_norm_w, k_norm_w, rel_table):
    Bsz, S, H, D = q.shape
    BS, QC = MOBA_BLOCK, MOBA_QCHUNK
    q = rmsnorm(q, q_norm_w) * (D ** -0.5)
    k = rmsnorm(k, k_norm_w)
    pad = (-S) % BS
    Sp = S + pad
    NB = Sp // BS
    topk = min(MOBA_TOPK, NB)
    kb = jnp.pad(k, ((0, 0), (0, pad), (0, 0), (0, 0))).reshape(Bsz, NB, BS, H, D).transpose(0, 3, 1, 2, 4)
    vb = jnp.pad(v, ((0, 0), (0, pad), (0, 0), (0, 0))).reshape(Bsz, NB, BS, H, D).transpose(0, 3, 1, 2, 4)
    kbar = jnp.mean(kb, axis=3)
    NQ = S // QC
    qc = jnp.moveaxis(q.transpose(0, 2, 1, 3).reshape(Bsz, H, NQ, QC, D), 2, 0)
    table_h = rel_table.T
    bidx = jnp.arange(Bsz)[:, None, None, None]
    hidx = jnp.arange(H)[None, :, None, None]
    hidx5 = hidx[..., None]

    def one_chunk(args):
        qi, ci = args
        qpos = ci * QC + jnp.arange(QC)
        blk = (ci * QC) // BS
        gate = jnp.einsum('bhqd,bhnd->bhqn', qi, kbar).astype(jnp.float32)
        gate = jnp.where(jnp.arange(NB) < blk, gate, -jnp.inf)
        _, sel = lax.top_k(gate, topk)
        valid = jnp.arange(topk) < blk
        ksel = kb[bidx, hidx, sel]
        vsel = vb[bidx, hidx, sel]
        s_sel = jnp.einsum('bhqd,bhqtkd->bhqtk', qi, ksel).astype(jnp.float32)
        kpos_sel = sel[..., None] * BS + jnp.arange(BS)
        bias_sel = table_h[hidx5, rel_bucket(qpos[:, None, None] - kpos_sel)]
        s_sel = jnp.where(valid[:, None], s_sel + bias_sel, -jnp.inf)
        kown = lax.dynamic_index_in_dim(kb, blk, axis=2, keepdims=False)
        vown = lax.dynamic_index_in_dim(vb, blk, axis=2, keepdims=False)
        s_own = jnp.einsum('bhqd,bhkd->bhqk', qi, kown).astype(jnp.float32)
        dist = qpos[:, None] - (blk * BS + jnp.arange(BS))[None, :]
        bias_own = table_h[:, rel_bucket(dist)]
        s_own = jnp.where(dist >= 0, s_own + bias_own, -jnp.inf)
        logits = jnp.concatenate([s_sel.reshape(Bsz, H, QC, topk * BS), s_own], axis=-1)
        p = jax.nn.softmax(logits, axis=-1).astype(v.dtype)
        p_sel = p[..., :topk * BS].reshape(Bsz, H, QC, topk, BS)
        p_own = p[..., topk * BS:]
        return (jnp.einsum('bhqtk,bhqtkd->bhqd', p_sel, vsel)
                + jnp.einsum('bhqk,bhkd->bhqd', p_own, vown))

    out = lax.map(one_chunk, (qc, jnp.arange(NQ)))
    out = jnp.moveaxis(out, 0, 2).reshape(Bsz, H, S, D).transpose(0, 2, 1, 3)
    return out.reshape(Bsz, S, H * D)


def setup_inputs(seed: int = 0) -> dict:
    key = jax.random.key(seed)
    ks = jax.random.split(key, 24)
    f32 = jnp.float32

    def nrm(k, shape, scale):
        return jax.random.normal(k, shape, f32) * scale

    dt0 = jnp.exp(jax.random.uniform(ks[5], (DEPTH, SSM_HEADS), f32, math.log(1e-3), math.log(1e-1)))
    return {
        "x": nrm(ks[0], (BATCH, SEQ, D_MODEL), 1.0),
        "attn_norm_w": 1.0 + nrm(ks[1], (DEPTH, D_MODEL), 0.02),
        "w_in": nrm(ks[2], (DEPTH, D_MODEL, D_IN_PROJ), D_MODEL ** -0.5),
        "b_gate": nrm(ks[3], (DEPTH, 2 * D_MODEL), 0.02),
        "ssm_conv_w": nrm(ks[4], (DEPTH, SSM_CONV, D_XBC), SSM_CONV ** -0.5),
        "ssm_conv_b": nrm(ks[6], (DEPTH, D_XBC), 0.02),
        "ssm_dt_bias": dt0 + jnp.log(-jnp.expm1(-dt0)),
        "ssm_a_log": jnp.log(jax.random.uniform(ks[7], (DEPTH, SSM_HEADS), f32, 1.0, 16.0)),
        "ssm_d": 1.0 + nrm(ks[8], (DEPTH, SSM_HEADS), 0.1),
        "ssm_norm_w": 1.0 + nrm(ks[9], (DEPTH, D_INNER), 0.02),
        "q_norm_w": 1.0 + nrm(ks[10], (DEPTH, ATTN_HEAD_DIM), 0.02),
        "k_norm_w": 1.0 + nrm(ks[11], (DEPTH, ATTN_HEAD_DIM), 0.02),
        "rel_bias": nrm(ks[12], (REL_BUCKETS, ATTN_HEADS), 0.5),
        "w_ssm_out": nrm(ks[13], (DEPTH, D_INNER, D_MODEL), D_INNER ** -0.5),
        "w_attn_out": nrm(ks[14], (DEPTH, D_ATTN, D_MODEL), D_ATTN ** -0.5),
        "w_out": nrm(ks[15], (DEPTH, D_MODEL, D_MODEL), D_MODEL ** -0.5),
        "ffn_norm_w": 1.0 + nrm(ks[16], (DEPTH, D_MODEL), 0.02),
        "w_up": nrm(ks[17], (DEPTH, D_MODEL, 2 * D_FF), D_MODEL ** -0.5),
        "ffn_conv_w": nrm(ks[18], (DEPTH, FFN_CONV, 2 * D_FF), FFN_CONV ** -0.5),
        "ffn_conv_b": nrm(ks[19], (DEPTH, 2 * D_FF), 0.02),
        "w_down": nrm(ks[20], (DEPTH, D_FF, D_MODEL), D_FF ** -0.5),
    }


def reference(x, attn_norm_w, w_in, b_gate, ssm_conv_w, ssm_conv_b, ssm_dt_bias, ssm_a_log,
              ssm_d, ssm_norm_w, q_norm_w, k_norm_w, rel_bias, w_ssm_out, w_attn_out, w_out,
              ffn_norm_w, w_up, ffn_conv_w, ffn_conv_b, w_down):
    Bsz, S, _ = x.shape
    pts = _split_points(IN_SPLITS)
    for l in range(DEPTH):
        h = rmsnorm(x, attn_norm_w[l])
        proj = h @ w_in[l]
        z, xbc, dt_raw, q, k, v, g = jnp.split(proj, pts, axis=-1)
        y_ssm = ssd_mixer(z, xbc, dt_raw, ssm_conv_w[l], ssm_conv_b[l], ssm_dt_bias[l],
                          ssm_a_log[l], ssm_d[l], ssm_norm_w[l]) @ w_ssm_out[l]
        q = q.reshape(Bsz, S, ATTN_HEADS, ATTN_HEAD_DIM)
        k = k.reshape(Bsz, S, ATTN_HEADS, ATTN_HEAD_DIM)
        v = v.reshape(Bsz, S, ATTN_HEADS, ATTN_HEAD_DIM)
        y_attn = moba_attention(q, k, v, q_norm_w[l], k_norm_w[l], rel_bias) @ w_attn_out[l]
        g_ssm, g_attn = jnp.split(jax.nn.sigmoid(g + b_gate[l]), 2, axis=-1)
        x = x + (g_ssm * y_ssm + g_attn * y_attn) @ w_out[l]
        h = rmsnorm(x, ffn_norm_w[l])
        u = causal_dwconv(h @ w_up[l], ffn_conv_w[l], ffn_conv_b[l])
        u_gate, u_up = jnp.split(u, 2, axis=-1)
        x = x + (jax.nn.silu(u_gate) * u_up) @ w_down[l]
    return x
```

```cpp
#define MK_VARIANT 1
#include <hip/hip_runtime.h>
#include <cstdio>
#include <cstdint>
namespace pg8 {
#define PG8_LAS __attribute__((address_space(3)))
typedef unsigned short bf16_t;
typedef short bf16x8 __attribute__((ext_vector_type(8)));
typedef float f32x4 __attribute__((ext_vector_type(4)));
typedef unsigned u32x4 __attribute__((ext_vector_type(4)));
constexpr int BM = 256, BK = 64, HALF = 128, HTB = HALF * BK * 2  , STAGE_BYTES = 8 * HTB, NXCD = 8, WGM = 8;

__host__ __device__ __forceinline__ int lds_byte(int r, int c) { const int st = (r >> 4) * 2 + (c >> 5), rr = r & 15, cc = c & 31, ob = rr * 64 + cc * 2; return st * 1024 + (ob ^ (((ob >> 9) & 1) << 5)); }
__host__ __device__ __forceinline__ void stage_rc(int b, int& R, int& C) { const int st = b / 1024, sb = b % 1024, swz = sb ^ (((sb >> 9) & 1) << 5); R = (st >> 1) * 16 + swz / 64; C = (st & 1) * 32 + (swz % 64) / 2; }
__host__ __device__ __forceinline__ int perm32(int rho) { const int n = rho >> 4, i = rho & 15; return 8 * (i >> 2) + 4 * n + (i & 3); }

struct Unit { int pm, pn; };
struct Gemm { const bf16_t* A; const bf16_t* Bt; int M, N, K; };

struct StaticOrder {
    int nM, nN, nwg, G, c;
    __host__ __device__ void init(int M, int N, int G_, int c_) { nM = M / BM; nN = N / BM; nwg = nM * nN; G = G_; c = c_; }
    __host__ __device__ bool next(int i, Unit& u) const {
        const long L = (long)i * G + c; if (L >= nwg) return false;
        int wgid = (int)L; { const int q = nwg / NXCD, r = nwg % NXCD, xcd = wgid % NXCD, off = wgid / NXCD; wgid = (xcd < r ? xcd * (q + 1) : r * (q + 1) + (xcd - r) * q) + off; }
        const int nig = WGM * nN, gid = wgid / nig, fm = gid * WGM, gsz = (nM - fm) < WGM ? (nM - fm) : WGM;
        u.pm = fm + ((wgid % nig) % gsz); u.pn = (wgid % nig) / gsz; return true;
    }
    __device__ __forceinline__ void a_ready(const Unit&) const {}
    __device__ __forceinline__ void done(const Unit&) const {}
};

__device__ __forceinline__ unsigned cvt_pk_bf16(float lo, float hi) { unsigned r; asm volatile("v_cvt_pk_bf16_f32 %0, %1, %2" : "=v"(r) : "v"(lo), "v"(hi)); return r; }
typedef float f32x2 __attribute__((ext_vector_type(2)));
template <class Epi, class Sched, bool ALIGN_EPI = false, bool SP2 = false>
__device__ __forceinline__ void gemm_phase(PG8_LAS unsigned char* lds, const Gemm g, const Sched& S, const Epi& E) {
    const int tid = threadIdx.x, wid = __builtin_amdgcn_readfirstlane(tid >> 6), lane = tid & 63, wr = wid >> 2, wc = wid & 3, fr = lane & 15, fq = lane >> 4;
    const int K = g.K, nt = K / BK;
    unsigned voffA[2], voffB[2];
#pragma unroll
    for (int i = 0; i < 2; ++i) { int R, C; stage_rc(tid * 16 + i * 8192, R, C); const int Rb = Epi::PERM ? ((R & ~31) + perm32(R & 31)) : R;
        voffA[i] = (unsigned)(R * K + C) * 2u; voffB[i] = (unsigned)(Rb * K + C) * 2u; }
    const size_t kstep = (size_t)(BK * 2);
    const size_t hstep = (size_t)HALF * K * 2;
    const size_t tstep = 2 * hstep;
    const unsigned ldsw = (unsigned)wid * 1024u;
    const int aoff = lds_byte(wr * 64 + fr, fq * 8), boff = lds_byte(wc * 32 + fr, fq * 8);
#define PG8_SA(b, h) (((b) * 2 + (h)) * HTB)
#define PG8_SB(b, h) ((4 + (b) * 2 + (h)) * HTB)
#define PG8_STAGE(bufoff, gbase, voff) do { _Pragma("unroll") for (int _i = 0; _i < 2; ++_i) \
        __builtin_amdgcn_global_load_lds((const unsigned*)((const char*)(gbase) + (voff)[_i]), (PG8_LAS unsigned*)(lds + (bufoff) + ldsw + _i * 8192), 16, 0, 0); } while (0)
#define PG8_LDA(dst, b, h) do { _Pragma("unroll") for (int m = 0; m < 4; ++m) _Pragma("unroll") for (int k = 0; k < 2; ++k) dst[m][k] = *(const PG8_LAS bf16x8*)(lds + PG8_SA(b, h) + aoff + m * 2048 + k * 1024); } while (0)
#define PG8_LDB(dst, b, h) do { _Pragma("unroll") for (int n = 0; n < 2; ++n) _Pragma("unroll") for (int k = 0; k < 2; ++k) dst[n][k] = *(const PG8_LAS bf16x8*)(lds + PG8_SB(b, h) + boff + n * 2048 + k * 1024); } while (0)
#define PG8_MMA(ai, bj, At, Bt) do { __builtin_amdgcn_s_setprio(1); _Pragma("unroll") for (int m = 0; m < 4; ++m) _Pragma("unroll") for (int n = 0; n < 2; ++n) _Pragma("unroll") for (int k = 0; k < 2; ++k) \
        acc[ai][bj][m][n] = __builtin_amdgcn_mfma_f32_16x16x32_bf16(Bt[n][k], At[m][k], acc[ai][bj][m][n], 0, 0, 0); __builtin_amdgcn_s_setprio(0); } while (0)
#define PG8_WAIT_V(n) asm volatile("s_waitcnt vmcnt(" #n ")" ::: "memory")
#define PG8_WAIT_L(n) asm volatile("s_waitcnt lgkmcnt(" #n ")" ::: "memory")
#define PG8_BAR __builtin_amdgcn_s_barrier()
#define PG8_SCHED __builtin_amdgcn_sched_barrier(0)
    Unit cur, nxt; int ui = 0;
    if (!S.next(0, cur)) return;
    f32x4 acc[2][2][4][2];
#pragma unroll
    for (int a = 0; a < 2; ++a)
#pragma unroll
        for (int b = 0; b < 2; ++b)
#pragma unroll
            for (int m = 0; m < 4; ++m)
#pragma unroll
                for (int n = 0; n < 2; ++n) acc[a][b][m][n] = (f32x4){0.f, 0.f, 0.f, 0.f};
    bf16x8 At[4][2], B0[2][2], B1[2][2];
    const char* cA = (const char*)g.A + (size_t)cur.pm * tstep; const char* cB = (const char*)g.Bt + (size_t)cur.pn * tstep;
    S.a_ready(cur);
    if constexpr (SP2) {
        PG8_STAGE(PG8_SB(0, 0), cB, voffB); PG8_STAGE(PG8_SB(0, 1), cB + hstep, voffB); PG8_STAGE(PG8_SA(0, 0), cA, voffA); PG8_STAGE(PG8_SA(0, 1), cA + hstep, voffA);
        if (wr == 1) PG8_BAR;
        PG8_WAIT_V(2); PG8_BAR;
        PG8_STAGE(PG8_SB(1, 0), cB + kstep, voffB); PG8_STAGE(PG8_SA(1, 0), cA + kstep, voffA); PG8_STAGE(PG8_SB(1, 1), cB + hstep + kstep, voffB);
        PG8_WAIT_V(6); PG8_BAR;
    } else {
        PG8_STAGE(PG8_SB(0, 0), cB, voffB); PG8_STAGE(PG8_SA(0, 0), cA, voffA); PG8_STAGE(PG8_SB(0, 1), cB + hstep, voffB); PG8_STAGE(PG8_SA(0, 1), cA + hstep, voffA);
        if (wr == 1) PG8_BAR;
        PG8_WAIT_V(4); PG8_BAR;
        PG8_STAGE(PG8_SB(1, 0), cB + kstep, voffB); PG8_STAGE(PG8_SA(1, 0), cA + kstep, voffA); PG8_STAGE(PG8_SB(1, 1), cB + hstep + kstep, voffB);
        PG8_WAIT_V(6); PG8_BAR;
    }
    for (;;) {
        const bool has_next = S.next(ui + 1, nxt);
        const char* nA = has_next ? (const char*)g.A + (size_t)nxt.pm * tstep : cA; const char* nB = has_next ? (const char*)g.Bt + (size_t)nxt.pn * tstep : cB;
        for (int t = 0; t < nt; t += 2) {
            const bool last = (t == nt - 2);
            const char* a1 = cA + (size_t)(t + 1) * kstep;
            const char* a2 = last ? nA : cA + (size_t)(t + 2) * kstep; const char* b2 = last ? nB : cB + (size_t)(t + 2) * kstep;
            const char* a3 = a2 + kstep; const char* b3 = b2 + kstep;
            if (last && has_next) S.a_ready(nxt);
            if constexpr (SP2) {
            PG8_LDB(B0, 0, 0); PG8_LDB(B1, 0, 1); PG8_SCHED; PG8_LDA(At, 0, 0); PG8_STAGE(PG8_SA(1, 1), a1 + hstep, voffA);
            PG8_WAIT_V(8); PG8_WAIT_L(0); PG8_BAR; PG8_MMA(0, 0, At, B0); PG8_MMA(0, 1, At, B1); PG8_BAR; PG8_SCHED;
            PG8_LDA(At, 0, 1); PG8_STAGE(PG8_SB(0, 0), b2, voffB); PG8_STAGE(PG8_SB(0, 1), b2 + hstep, voffB); PG8_STAGE(PG8_SA(0, 0), a2, voffA);
            PG8_WAIT_V(8); PG8_WAIT_L(0); PG8_BAR; PG8_MMA(1, 0, At, B0); PG8_MMA(1, 1, At, B1); PG8_BAR; PG8_SCHED;
            PG8_LDB(B0, 1, 0); PG8_LDB(B1, 1, 1); PG8_SCHED; PG8_LDA(At, 1, 0); PG8_STAGE(PG8_SA(0, 1), a2 + hstep, voffA);
            PG8_WAIT_V(8); PG8_WAIT_L(0); PG8_BAR; PG8_MMA(0, 0, At, B0); PG8_MMA(0, 1, At, B1); PG8_BAR; PG8_SCHED;
            PG8_LDA(At, 1, 1); PG8_STAGE(PG8_SB(1, 0), b3, voffB); PG8_STAGE(PG8_SB(1, 1), b3 + hstep, voffB); PG8_STAGE(PG8_SA(1, 0), a3, voffA);
            PG8_WAIT_V(8); PG8_WAIT_L(0); PG8_BAR; PG8_MMA(1, 0, At, B0); PG8_MMA(1, 1, At, B1); PG8_BAR; PG8_SCHED;
            } else {
            PG8_LDB(B0, 0, 0); PG8_SCHED; PG8_LDA(At, 0, 0); PG8_STAGE(PG8_SA(1, 1), a1 + hstep, voffA);
            PG8_WAIT_L(8); PG8_BAR; PG8_WAIT_L(0); PG8_MMA(0, 0, At, B0); PG8_BAR; PG8_SCHED;
            PG8_LDB(B1, 0, 1); PG8_STAGE(PG8_SB(0, 0), b2, voffB);
            PG8_BAR; PG8_WAIT_L(0); PG8_MMA(0, 1, At, B1); PG8_BAR;
            PG8_LDA(At, 0, 1); PG8_STAGE(PG8_SA(0, 0), a2, voffA);
            PG8_BAR; PG8_WAIT_L(0); PG8_MMA(1, 0, At, B0); PG8_BAR; PG8_SCHED;
            PG8_STAGE(PG8_SB(0, 1), b2 + hstep, voffB);
            PG8_WAIT_V(6); PG8_BAR; PG8_MMA(1, 1, At, B1); PG8_BAR;
            PG8_LDB(B0, 1, 0); PG8_SCHED; PG8_LDA(At, 1, 0); PG8_STAGE(PG8_SA(0, 1), a2 + hstep, voffA);
            PG8_WAIT_L(8); PG8_BAR; PG8_WAIT_L(0); PG8_MMA(0, 0, At, B0); PG8_BAR; PG8_SCHED;
            PG8_LDB(B1, 1, 1); PG8_STAGE(PG8_SB(1, 0), b3, voffB);
            PG8_BAR; PG8_WAIT_L(0); PG8_MMA(0, 1, At, B1); PG8_BAR;
            PG8_LDA(At, 1, 1); PG8_STAGE(PG8_SA(1, 0), a3, voffA);
            PG8_BAR; PG8_WAIT_L(0); PG8_MMA(1, 0, At, B0); PG8_BAR; PG8_SCHED;
            PG8_STAGE(PG8_SB(1, 1), b3 + hstep, voffB);
            PG8_WAIT_V(6); PG8_BAR; PG8_MMA(1, 1, At, B1); PG8_BAR;
            }
        }
        if constexpr (ALIGN_EPI) { if (wr == 0) PG8_BAR; }
        if constexpr (!Epi::AFTER_DRAIN) { E(acc, cur, wr, wc, fr, fq); S.done(cur); }
        if (!has_next) break;
#pragma unroll
        for (int a = 0; a < 2; ++a)
#pragma unroll
            for (int b = 0; b < 2; ++b)
#pragma unroll
                for (int m = 0; m < 4; ++m)
#pragma unroll
                    for (int n = 0; n < 2; ++n) acc[a][b][m][n] = (f32x4){0.f, 0.f, 0.f, 0.f};
        cur = nxt; cA = nA; cB = nB; ++ui;
        if constexpr (ALIGN_EPI) { if (wr == 1) PG8_BAR; }
    }
    PG8_WAIT_V(0);
    if constexpr (!ALIGN_EPI) { if (wr == 0) PG8_BAR; }
    PG8_BAR;
    if constexpr (Epi::AFTER_DRAIN) { E.fused(acc, cur, wr, wc, fr, fq, lds, wid, lane); S.done(cur); }
#undef PG8_SA
#undef PG8_SB
#undef PG8_STAGE
#undef PG8_LDA
#undef PG8_LDB
#undef PG8_MMA
#undef PG8_WAIT_V
#undef PG8_WAIT_L
#undef PG8_BAR
#undef PG8_SCHED
}
}

#define GAS __attribute__((address_space(1)))
#define LAS __attribute__((address_space(3)))
typedef unsigned short bf16;
typedef unsigned v4u __attribute__((ext_vector_type(4)));
typedef unsigned v2u __attribute__((ext_vector_type(2)));
typedef float f32x4 __attribute__((ext_vector_type(4)));
typedef float f32x2 __attribute__((ext_vector_type(2)));
typedef float f32x16 __attribute__((ext_vector_type(16)));
typedef short bf16x8 __attribute__((ext_vector_type(8)));
typedef short s16x4 __attribute__((ext_vector_type(4)));
typedef GAS unsigned gu32;
#define RLX_AGENT __ATOMIC_RELAXED, __HIP_MEMORY_SCOPE_AGENT
#define LDS_WAIT() asm volatile("s_waitcnt lgkmcnt(0)" ::: "memory")
#define VM_WAIT() asm volatile("s_waitcnt vmcnt(0)" ::: "memory")

constexpr int NWAVES = 8, NTHR = 512;
constexpr int SEQ = 8192, DM = 2048, DI = 4096, NHS = 64, HP = 64, NG = 8, NST = 128, DXBC = 6144, CHK = 256, NCH = 32;
constexpr int AH = 16, AD = 128, DA = 2048, BLK = 256, NBLK = 32;
constexpr int DFF = 5632, DFF2 = 11264;
constexpr int NIN = 20480;
constexpr int DINP = 20544;
constexpr float EPS = 1e-6f;

enum { I_X = 0, I_ANW, I_WIN, I_BG, I_SCW, I_SCB, I_DTB, I_ALOG, I_SD, I_SNW, I_QNW, I_KNW, I_REL, I_WSS, I_WAT, I_WOUT, I_FNW, I_WUP, I_FCW, I_FCB, I_WDN, N_INPUTS };

constexpr size_t MiB = 1u << 20;
constexpr size_t WS_CTL = 0, CTL_ZERO_BYTES = 256 * 1024;
constexpr size_t WS_R1 = 1 * MiB;
constexpr size_t WS_SS2 = WS_R1 + 64 * 1024;
constexpr size_t WS_KBAR = WS_SS2 + 64 * 1024;
constexpr size_t WS_DT = 2 * MiB;
constexpr size_t WS_ACS = 4 * MiB;
constexpr size_t WS_WIN = 16 * MiB;
constexpr size_t WS_STATES = 16 * MiB;
constexpr size_t WS_WSS = 100 * MiB;
constexpr size_t WS_WAT = 116 * MiB;
constexpr size_t WS_WOUT = 124 * MiB;
constexpr size_t WS_WUP = 132 * MiB;
constexpr size_t WS_WDN = 176 * MiB;
constexpr size_t WS_XB = 200 * MiB;
constexpr size_t WS_Z = 232 * MiB;
constexpr size_t WS_XBC = 296 * MiB;
constexpr size_t WS_Q = 392 * MiB;
constexpr size_t WS_K = 424 * MiB;
constexpr size_t WS_V = 456 * MiB;
constexpr size_t WS_GT = 488 * MiB;
constexpr size_t WS_YG = 556 * MiB;
constexpr size_t WS_UPRE = 232 * MiB;
constexpr size_t WS_ACT = 456 * MiB;
constexpr size_t WS_END = 620 * MiB;

constexpr int CW_BAR = 4096;

__device__ __forceinline__ unsigned f2bf(float f) { unsigned u = __builtin_bit_cast(unsigned, f); return (u + 0x7fffu + ((u >> 16) & 1u)) >> 16; }
__device__ __forceinline__ unsigned pk2(float lo, float hi) { return f2bf(lo) | (f2bf(hi) << 16); }
__device__ __forceinline__ float bf2f(unsigned short b) { return __builtin_bit_cast(float, (unsigned)b << 16); }
__device__ __forceinline__ float bflo(unsigned w) { return __builtin_bit_cast(float, w << 16); }
__device__ __forceinline__ float bfhi(unsigned w) { return __builtin_bit_cast(float, w & 0xffff0000u); }
__device__ __forceinline__ float siluf(float v) { return v / (1.f + __expf(-v)); }
__device__ __forceinline__ float sigmf(float v) { return 1.f / (1.f + __expf(-v)); }
__device__ __forceinline__ float wave_sum(float v) {
#pragma unroll
    for (int o = 1; o < 64; o <<= 1) v += __shfl_xor(v, o);
    return v;
}

#define XB_TMO      128
#define XB_XCNT(j)  (256  + 64 * (j))
#define XB_XSUB(j)  (1280 + 64 * (j))
#define XB_XGEN(j)  (2304 + 64 * (j))
#define XB_TOP      3328
#define XB_TOPGEN   3392
#define XCD_BAR_WORDS 3456
#define XB_SPIN_CAP (1u << 20)
__device__ __forceinline__ unsigned xb_ld(unsigned* p)              { return __hip_atomic_load(p, __ATOMIC_RELAXED, __HIP_MEMORY_SCOPE_AGENT); }
__device__ __forceinline__ unsigned xb_add(unsigned* p, unsigned v) { return __hip_atomic_fetch_add(p, v, __ATOMIC_RELAXED, __HIP_MEMORY_SCOPE_AGENT); }
__device__ __forceinline__ unsigned xb_xcc_id() { return (unsigned)__builtin_amdgcn_s_getreg((3 << 11) | 20) & 0xFu; }
#define XB_SPIN(cond, bar) do { unsigned _sp = 0; while (cond) { __builtin_amdgcn_s_sleep(1); \
    if ((++_sp & 255u) == 0u) { if (xb_ld(&(bar)[XB_TMO])) break; if (_sp > XB_SPIN_CAP) { atomicAdd(&(bar)[XB_TMO], 1u); break; } } } } while (0)
struct XcdBarrier { unsigned* bar; unsigned x; volatile LAS unsigned* st; };
__device__ __forceinline__ XcdBarrier xcd_barrier_post(unsigned* bar, volatile LAS unsigned* st) {
    XcdBarrier b; b.bar = bar; b.x = xb_xcc_id(); b.st = st;
    if (threadIdx.x == 0) (void)xb_add(&bar[XB_XCNT(b.x)], 1u);
    return b;
}
__device__ __forceinline__ void xcd_barrier_complete(unsigned* bar, unsigned x, unsigned& nloc, unsigned& nx) {
    const unsigned G = gridDim.x * gridDim.y * gridDim.z;
    unsigned sum, cnt, mine, sp = 0u;
    for (;;) {
        sum = 0u; cnt = 0u; mine = 0u;
#pragma unroll
        for (unsigned j = 0; j < 16; ++j) { const unsigned c = xb_ld(&bar[XB_XCNT(j)]); sum += c; cnt += (c > 0u) ? 1u : 0u; mine = (j == x) ? c : mine; }
        if (sum == G) break;
        __builtin_amdgcn_s_sleep(1);
        if ((++sp & 255u) == 0u) { if (xb_ld(&bar[XB_TMO])) break; if (sp > XB_SPIN_CAP) { atomicAdd(&bar[XB_TMO], 1u); break; } }
    }
    nloc = mine > 0u ? mine : 1u; nx = cnt > 0u ? cnt : 1u;
}
__device__ __forceinline__ void xcd_barrier(const XcdBarrier& b) {
    asm volatile("s_waitcnt vmcnt(0)" ::: "memory");
    __syncthreads();
    if (threadIdx.x == 0) {
        unsigned* bar = b.bar;
        __builtin_amdgcn_s_waitcnt(0);
        unsigned nloc = b.st[0], nx = b.st[1];
        if (nloc == 0u) { xcd_barrier_complete(bar, b.x, nloc, nx); b.st[0] = nloc; b.st[1] = nx; }
        const unsigned old = xb_add(&bar[XB_XSUB(b.x)], 1u);
        const unsigned gen = old / nloc;
        if (old + 1u == (gen + 1u) * nloc) {
            __builtin_amdgcn_fence(__ATOMIC_RELEASE, "agent");
            asm volatile("s_waitcnt vmcnt(0)" ::: "memory");
            const unsigned og = xb_add(&bar[XB_TOP], 1u);
            const unsigned tg = og / nx;
            if (og + 1u == (tg + 1u) * nx) xb_add(&bar[XB_TOPGEN], 1u);
            else XB_SPIN(xb_ld(&bar[XB_TOPGEN]) == tg, bar);
            __builtin_amdgcn_fence(__ATOMIC_ACQUIRE, "agent");
            xb_add(&bar[XB_XGEN(b.x)], 1u);
            asm volatile("s_waitcnt vmcnt(0)" ::: "memory");
        } else {
            XB_SPIN(xb_ld(&bar[XB_XGEN(b.x)]) == gen, bar);
            __builtin_amdgcn_fence(__ATOMIC_ACQUIRE, "agent");
            asm volatile("s_waitcnt vmcnt(0)" ::: "memory");
        }
    }
    __syncthreads();
}

constexpr int RING_OFF = 0, RING_BYTES = 131072;
constexpr int LDSCTL_OFF = RING_BYTES, MISC_OFF = LDSCTL_OFF + 320;
constexpr int LDS_BYTES = 147456;

struct Args { const float* in[N_INPUTS]; float* out; unsigned char* ws; int ph_lo, ph_hi, li, pad; };
static_assert(sizeof(Args) == N_INPUTS * 8 + 8 + 8 + 16, "Args has no padding");

struct Frame {
    LAS unsigned char* lds;
    int tid, lane, wave, vcu, G;
};

__device__ __forceinline__ int map_ident(int n) { return n; }
__device__ __forceinline__ int map_win(int n) { return n < 10240 ? n : (n < 10304 ? 20480 + (n - 10240) : n - 64); }
template <int MAP>
__device__ __forceinline__ void p0_transpose_item(const float* __restrict__ W, int K, int N, bf16* WT, const float* __restrict__ kscale, LAS float* scr, int item, int lane) {
    const int nblk = N / 32, kb = item / nblk, nb = item % nblk, k0 = 64 * kb, n0 = 32 * nb;
#pragma unroll 8
    for (int i = 0; i < 32; ++i) { const int kk = 2 * i + (lane >> 5); float v = W[(size_t)(k0 + kk) * N + n0 + (lane & 31)]; if (kscale) v *= kscale[k0 + kk]; scr[kk * 33 + (lane & 31)] = v; }
    LDS_WAIT(); asm volatile("" ::: "memory");
    const int c = lane & 7;
#pragma unroll
    for (int j = 0; j < 4; ++j) { const int n = (lane >> 3) + 8 * j; const LAS float* s = scr + (8 * c) * 33 + n;
        v4u o; o.x = pk2(s[0 * 33], s[1 * 33]); o.y = pk2(s[2 * 33], s[3 * 33]); o.z = pk2(s[4 * 33], s[5 * 33]); o.w = pk2(s[6 * 33], s[7 * 33]);
        const int nn = n0 + n; const int dr = (MAP == 1) ? map_win(nn) : nn;
        *(GAS v4u*)(WT + (size_t)dr * K + k0 + 8 * c) = o; }
    LDS_WAIT(); asm volatile("" ::: "memory");
}
__device__ __forceinline__ void p0_prologue(Frame& F, const Args& A) {
    LAS float* scr = (LAS float*)(F.lds + RING_OFF + F.wave * 16384);
    const int gw = F.vcu * NWAVES + F.wave, NGW = F.G * NWAVES;
    unsigned char* ws = A.ws;
    constexpr int IT_WIN = (DM / 64) * (DINP / 32), IT_WSS = (DI / 64) * (DM / 32), IT_WAT = (DA / 64) * (DM / 32), IT_WOUT = (DM / 64) * (DM / 32),
                  IT_WUP = (DM / 64) * (DFF2 / 32), IT_WDN = (DFF / 64) * (DM / 32);
    constexpr int NITEMS = IT_WIN + IT_WSS + IT_WAT + IT_WOUT + IT_WUP + IT_WDN;
    for (int it = gw; it < NITEMS; it += NGW) {
        int r = it;
        if (r < IT_WIN) { p0_transpose_item<1>(A.in[I_WIN], DM, DINP, (bf16*)(ws + WS_WIN), A.in[I_ANW], scr, r, F.lane); continue; } r -= IT_WIN;
        if (r < IT_WSS) { p0_transpose_item<0>(A.in[I_WSS], DI, DM, (bf16*)(ws + WS_WSS), nullptr, scr, r, F.lane); continue; } r -= IT_WSS;
        if (r < IT_WAT) { p0_transpose_item<0>(A.in[I_WAT], DA, DM, (bf16*)(ws + WS_WAT), nullptr, scr, r, F.lane); continue; } r -= IT_WAT;
        if (r < IT_WOUT) { p0_transpose_item<0>(A.in[I_WOUT], DM, DM, (bf16*)(ws + WS_WOUT), nullptr, scr, r, F.lane); continue; } r -= IT_WOUT;
        if (r < IT_WUP) { p0_transpose_item<0>(A.in[I_WUP], DM, DFF2, (bf16*)(ws + WS_WUP), A.in[I_FNW], scr, r, F.lane); continue; } r -= IT_WUP;
        p0_transpose_item<0>(A.in[I_WDN], DFF, DM, (bf16*)(ws + WS_WDN), nullptr, scr, r, F.lane);
    }
    float* r1 = (float*)(ws + WS_R1); float* ss2 = (float*)(ws + WS_SS2);
    bf16* xb = (bf16*)(ws + WS_XB);
    for (int m = gw; m < SEQ; m += NGW) {
        const GAS f32x4* xr = (const GAS f32x4*)(A.in[I_X] + (size_t)m * DM) + F.lane;
        f32x4 v[8]; float s = 0.f;
#pragma unroll
        for (int j = 0; j < 8; ++j) { v[j] = xr[64 * j]; s += (v[j].x * v[j].x + v[j].y * v[j].y) + (v[j].z * v[j].z + v[j].w * v[j].w); }
        s = wave_sum(s);
        GAS unsigned long long* o8 = (GAS unsigned long long*)(xb + (size_t)m * DM) + F.lane;
#pragma unroll
        for (int j = 0; j < 8; ++j) o8[64 * j] = (unsigned long long)pk2(v[j].x, v[j].y) | ((unsigned long long)pk2(v[j].z, v[j].w) << 32);
        if (F.lane == 0) { r1[m] = 1.0f / sqrtf(s * (1.0f / DM) + EPS); ss2[m] = 0.f; }
    }
}

namespace pg8 {
struct EpiInProj {
    static constexpr bool PERM = true, AFTER_DRAIN = false;
    bf16_t *z, *xbc, *q, *k, *v, *gt; const float* r1; const float* bg;
    __device__ __forceinline__ void operator()(const f32x4 (&acc)[2][2][4][2], const Unit& u, int wr, int wc, int fr, int fq) const {
        const int pn = u.pn; bf16_t* base; int ldc, colt; bool isg = false;
        if (pn < 16) { base = z; ldc = DI; colt = pn * 256; }
        else if (pn < 40) { base = xbc; ldc = DXBC; colt = (pn - 16) * 256; }
        else if (pn < 48) { base = q; ldc = DA; colt = (pn - 40) * 256; }
        else if (pn < 56) { base = k; ldc = DA; colt = (pn - 48) * 256; }
        else if (pn < 64) { base = v; ldc = DA; colt = (pn - 56) * 256; }
        else { base = gt; ldc = DI; colt = (pn - 64) * 256; isg = true; }
        const int row0 = u.pm * BM + wr * 64 + fr, col0 = colt + wc * 32 + 8 * fq;
        f32x4 bv[2][2];
#pragma unroll
        for (int bj = 0; bj < 2; ++bj)
#pragma unroll
            for (int n = 0; n < 2; ++n) bv[bj][n] = isg ? *(const f32x4*)(bg + col0 + bj * HALF + 4 * n) : (f32x4){0.f, 0.f, 0.f, 0.f};
#pragma unroll
        for (int ai = 0; ai < 2; ++ai)
#pragma unroll
            for (int m = 0; m < 4; ++m) { const int row = row0 + ai * HALF + m * 16; const float rs = r1[row]; bf16_t* rowp = base + (size_t)row * ldc + col0;
#pragma unroll
                for (int bj = 0; bj < 2; ++bj) { f32x4 v0 = acc[ai][bj][m][0] * rs + bv[bj][0], v1 = acc[ai][bj][m][1] * rs + bv[bj][1];
                    if (isg) {
#pragma unroll
                        for (int e = 0; e < 4; ++e) { v0[e] = 1.f / (1.f + __expf(-v0[e])); v1[e] = 1.f / (1.f + __expf(-v1[e])); } }
                    u32x4 w; w.x = cvt_pk_bf16(v0[0], v0[1]); w.y = cvt_pk_bf16(v0[2], v0[3]); w.z = cvt_pk_bf16(v1[0], v1[1]); w.w = cvt_pk_bf16(v1[2], v1[3]);
                    *(u32x4*)(rowp + bj * HALF) = w; } }
    }
};
struct EpiGateF32 {
    static constexpr bool PERM = true, AFTER_DRAIN = false;
    float* T; const bf16_t* gt; int goff;
    __device__ __forceinline__ void operator()(const f32x4 (&acc)[2][2][4][2], const Unit& u, int wr, int wc, int fr, int fq) const {
        const int row0 = u.pm * BM + wr * 64 + fr, col0 = u.pn * BM + wc * 32 + 8 * fq;
#pragma unroll
        for (int ai = 0; ai < 2; ++ai)
#pragma unroll
            for (int m = 0; m < 4; ++m) { const int row = row0 + ai * HALF + m * 16;
#pragma unroll
                for (int bj = 0; bj < 2; ++bj) { const u32x4 g = *(const u32x4*)(gt + (size_t)row * DI + goff + col0 + bj * HALF);
                    f32x4 g0 = {__builtin_bit_cast(float, g.x << 16), __builtin_bit_cast(float, g.x & 0xffff0000u), __builtin_bit_cast(float, g.y << 16), __builtin_bit_cast(float, g.y & 0xffff0000u)};
                    f32x4 g1 = {__builtin_bit_cast(float, g.z << 16), __builtin_bit_cast(float, g.z & 0xffff0000u), __builtin_bit_cast(float, g.w << 16), __builtin_bit_cast(float, g.w & 0xffff0000u)};
                    float* tp = T + (size_t)row * DM + col0 + bj * HALF;
                    *(f32x4*)tp = acc[ai][bj][m][0] * g0; *(f32x4*)(tp + 4) = acc[ai][bj][m][1] * g1; } }
    }
};
struct EpiGateAddBf16 {
    static constexpr bool PERM = true, AFTER_DRAIN = false;
    const float* T; const bf16_t* gt; int goff; bf16_t* O;
    __device__ __forceinline__ void operator()(const f32x4 (&acc)[2][2][4][2], const Unit& u, int wr, int wc, int fr, int fq) const {
        const int row0 = u.pm * BM + wr * 64 + fr, col0 = u.pn * BM + wc * 32 + 8 * fq;
#pragma unroll
        for (int ai = 0; ai < 2; ++ai)
#pragma unroll
            for (int m = 0; m < 4; ++m) { const int row = row0 + ai * HALF + m * 16;
#pragma unroll
                for (int bj = 0; bj < 2; ++bj) { const u32x4 g = *(const u32x4*)(gt + (size_t)row * DI + goff + col0 + bj * HALF);
                    f32x4 g0 = {__builtin_bit_cast(float, g.x << 16), __builtin_bit_cast(float, g.x & 0xffff0000u), __builtin_bit_cast(float, g.y << 16), __builtin_bit_cast(float, g.y & 0xffff0000u)};
                    f32x4 g1 = {__builtin_bit_cast(float, g.z << 16), __builtin_bit_cast(float, g.z & 0xffff0000u), __builtin_bit_cast(float, g.w << 16), __builtin_bit_cast(float, g.w & 0xffff0000u)};
                    const float* tp = T + (size_t)row * DM + col0 + bj * HALF;
                    const f32x4 v0 = *(const f32x4*)tp + acc[ai][bj][m][0] * g0, v1 = *(const f32x4*)(tp + 4) + acc[ai][bj][m][1] * g1;
                    u32x4 w; w.x = cvt_pk_bf16(v0[0], v0[1]); w.y = cvt_pk_bf16(v0[2], v0[3]); w.z = cvt_pk_bf16(v1[0], v1[1]); w.w = cvt_pk_bf16(v1[2], v1[3]);
                    *(u32x4*)(O + (size_t)row * DM + col0 + bj * HALF) = w; } }
    }
};
struct EpiResid1 {
    static constexpr bool PERM = true, AFTER_DRAIN = false;
    const float* X; float* out; bf16_t* xb1; float* ss2;
    __device__ __forceinline__ void operator()(const f32x4 (&acc)[2][2][4][2], const Unit& u, int wr, int wc, int fr, int fq) const {
        const int row0 = u.pm * BM + wr * 64 + fr, col0 = u.pn * BM + wc * 32 + 8 * fq;
#pragma unroll
        for (int ai = 0; ai < 2; ++ai)
#pragma unroll
            for (int m = 0; m < 4; ++m) { const int row = row0 + ai * HALF + m * 16; float sq = 0.f;
#pragma unroll
                for (int bj = 0; bj < 2; ++bj) { const size_t off = (size_t)row * DM + col0 + bj * HALF;
                    const f32x4 v0 = *(const f32x4*)(X + off) + acc[ai][bj][m][0], v1 = *(const f32x4*)(X + off + 4) + acc[ai][bj][m][1];
                    *(f32x4*)(out + off) = v0; *(f32x4*)(out + off + 4) = v1;
                    sq += (v0[0] * v0[0] + v0[1] * v0[1]) + (v0[2] * v0[2] + v0[3] * v0[3]) + (v1[0] * v1[0] + v1[1] * v1[1]) + (v1[2] * v1[2] + v1[3] * v1[3]);
                    u32x4 w; w.x = cvt_pk_bf16(v0[0], v0[1]); w.y = cvt_pk_bf16(v0[2], v0[3]); w.z = cvt_pk_bf16(v1[0], v1[1]); w.w = cvt_pk_bf16(v1[2], v1[3]);
                    *(u32x4*)(xb1 + off) = w; }
                sq += __shfl_xor(sq, 16); sq += __shfl_xor(sq, 32);
                if (fq == 0) atomicAdd(ss2 + row, sq); }
    }
};
struct EpiUpPre {
    static constexpr bool PERM = true, AFTER_DRAIN = false;
    bf16_t* O; const float* ss2;
    __device__ __forceinline__ void operator()(const f32x4 (&acc)[2][2][4][2], const Unit& u, int wr, int wc, int fr, int fq) const {
        const int row0 = u.pm * BM + wr * 64 + fr, col0 = u.pn * BM + wc * 32 + 8 * fq;
#pragma unroll
        for (int ai = 0; ai < 2; ++ai)
#pragma unroll
            for (int m = 0; m < 4; ++m) { const int row = row0 + ai * HALF + m * 16; const float rs = 1.0f / sqrtf(ss2[row] * (1.0f / DM) + EPS);
#pragma unroll
                for (int bj = 0; bj < 2; ++bj) { const f32x4 v0 = acc[ai][bj][m][0] * rs, v1 = acc[ai][bj][m][1] * rs;
                    u32x4 w; w.x = cvt_pk_bf16(v0[0], v0[1]); w.y = cvt_pk_bf16(v0[2], v0[3]); w.z = cvt_pk_bf16(v1[0], v1[1]); w.w = cvt_pk_bf16(v1[2], v1[3]);
                    *(u32x4*)(O + (size_t)row * DFF2 + col0 + bj * HALF) = w; } }
    }
};
struct EpiResid2 {
    static constexpr bool PERM = true, AFTER_DRAIN = false;
    float* out;
    __device__ __forceinline__ void operator()(const f32x4 (&acc)[2][2][4][2], const Unit& u, int wr, int wc, int fr, int fq) const {
        const int row0 = u.pm * BM + wr * 64 + fr, col0 = u.pn * BM + wc * 32 + 8 * fq;
#pragma unroll
        for (int ai = 0; ai < 2; ++ai)
#pragma unroll
            for (int m = 0; m < 4; ++m) { const int row = row0 + ai * HALF + m * 16;
#pragma unroll
                for (int bj = 0; bj < 2; ++bj) { float* p = out + (size_t)row * DM + col0 + bj * HALF;
                    const f32x4 v0 = *(const f32x4*)p + acc[ai][bj][m][0], v1 = *(const f32x4*)(p + 4) + acc[ai][bj][m][1];
                    *(f32x4*)p = v0; *(f32x4*)(p + 4) = v1; } }
    }
};
}

__device__ __forceinline__ float softplusf(float v) { return v > 20.f ? v : log1pf(__expf(v)); }
__device__ __forceinline__ void dt_phase(Frame& F, const Args& A) {
    unsigned char* ws = A.ws;
    const bf16* xb = (const bf16*)(ws + WS_XB); const bf16* wt = (const bf16*)(ws + WS_WIN) + (size_t)NIN * DM;
    const float* r1 = (const float*)(ws + WS_R1); float* dt = (float*)(ws + WS_DT);
    const int gw = F.vcu * NWAVES + F.wave, NGW = F.G * NWAVES;
    for (int m = gw; m < SEQ; m += NGW) {
        const GAS v4u* xr = (const GAS v4u*)(xb + (size_t)m * DM) + F.lane;
        float xv[32];
#pragma unroll
        for (int j = 0; j < 4; ++j) { const v4u w = xr[64 * j];
            xv[8 * j + 0] = bflo(w.x); xv[8 * j + 1] = bfhi(w.x); xv[8 * j + 2] = bflo(w.y); xv[8 * j + 3] = bfhi(w.y);
            xv[8 * j + 4] = bflo(w.z); xv[8 * j + 5] = bfhi(w.z); xv[8 * j + 6] = bflo(w.w); xv[8 * j + 7] = bfhi(w.w); }
        const float rs = r1[m];
        for (int h = 0; h < NHS; ++h) {
            const GAS v4u* wr = (const GAS v4u*)(wt + (size_t)h * DM) + F.lane; float s = 0.f;
#pragma unroll
            for (int j = 0; j < 4; ++j) { const v4u w = wr[64 * j];
                s += xv[8 * j + 0] * bflo(w.x) + xv[8 * j + 1] * bfhi(w.x) + xv[8 * j + 2] * bflo(w.y) + xv[8 * j + 3] * bfhi(w.y)
                   + xv[8 * j + 4] * bflo(w.z) + xv[8 * j + 5] * bfhi(w.z) + xv[8 * j + 6] * bflo(w.w) + xv[8 * j + 7] * bfhi(w.w); }
            s = wave_sum(s);
            if (F.lane == 0) dt[(size_t)m * NHS + h] = softplusf(s * rs + A.in[I_DTB][h]);
        }
    }
}

__device__ __forceinline__ void attn_prep_phase(Frame& F, const Args& A) {
    unsigned char* ws = A.ws;
    bf16* Q = (bf16*)(ws + WS_Q); bf16* K = (bf16*)(ws + WS_K); float* kbar = (float*)(ws + WS_KBAR);
    LAS float* red = (LAS float*)(F.lds + RING_OFF);
    const int sub = F.tid >> 4, l16 = F.tid & 15;
    float qw[8], kw[8];
#pragma unroll
    for (int e = 0; e < 8; ++e) { qw[e] = A.in[I_QNW][l16 * 8 + e] * 0.08838834764831845f; kw[e] = A.in[I_KNW][l16 * 8 + e]; }
    for (int u = F.vcu; u < NBLK * AH; u += F.G) {
        const int nb = u / AH, h = u % AH;
        float ksum[8];
#pragma unroll
        for (int e = 0; e < 8; ++e) ksum[e] = 0.f;
        for (int i = 0; i < 8; ++i) {
            const int t = nb * BLK + i * 32 + sub; const size_t off = (size_t)t * DA + h * AD + l16 * 8;
            { const v4u w = *(const GAS v4u*)(Q + off); float v[8] = {bflo(w.x), bfhi(w.x), bflo(w.y), bfhi(w.y), bflo(w.z), bfhi(w.z), bflo(w.w), bfhi(w.w)};
              float s = 0.f;
#pragma unroll
              for (int e = 0; e < 8; ++e) s += v[e] * v[e];
              s += __shfl_xor(s, 1); s += __shfl_xor(s, 2); s += __shfl_xor(s, 4); s += __shfl_xor(s, 8);
              const float r = 1.0f / sqrtf(s * (1.0f / AD) + EPS);
              v4u o; o.x = pk2(v[0] * r * qw[0], v[1] * r * qw[1]); o.y = pk2(v[2] * r * qw[2], v[3] * r * qw[3]); o.z = pk2(v[4] * r * qw[4], v[5] * r * qw[5]); o.w = pk2(v[6] * r * qw[6], v[7] * r * qw[7]);
              *(GAS v4u*)(Q + off) = o; }
            { const v4u w = *(const GAS v4u*)(K + off); float v[8] = {bflo(w.x), bfhi(w.x), bflo(w.y), bfhi(w.y), bflo(w.z), bfhi(w.z), bflo(w.w), bfhi(w.w)};
              float s = 0.f;
#pragma unroll
              for (int e = 0; e < 8; ++e) s += v[e] * v[e];
              s += __shfl_xor(s, 1); s += __shfl_xor(s, 2); s += __shfl_xor(s, 4); s += __shfl_xor(s, 8);
              const float r = 1.0f / sqrtf(s * (1.0f / AD) + EPS);
#pragma unroll
              for (int e = 0; e < 8; ++e) { v[e] = v[e] * r * kw[e]; ksum[e] += v[e]; }
              v4u o; o.x = pk2(v[0], v[1]); o.y = pk2(v[2], v[3]); o.z = pk2(v[4], v[5]); o.w = pk2(v[6], v[7]);
              *(GAS v4u*)(K + off) = o; }
        }
#pragma unroll
        for (int e = 0; e < 8; ++e) red[sub * 128 + l16 * 8 + e] = ksum[e];
        __syncthreads();
        if (F.tid < 128) { float s = 0.f;
#pragma unroll 8
            for (int r = 0; r < 32; ++r) s += red[r * 128 + F.tid];
            kbar[((size_t)h * NBLK + nb) * AD + F.tid] = s * (1.0f / BLK); }
        __syncthreads();
    }
}

__device__ __forceinline__ void unpack8(const v4u w, float* v) { v[0] = bflo(w.x); v[1] = bfhi(w.x); v[2] = bflo(w.y); v[3] = bfhi(w.y); v[4] = bflo(w.z); v[5] = bfhi(w.z); v[6] = bflo(w.w); v[7] = bfhi(w.w); }
__device__ __forceinline__ void ffn_act_phase(Frame& F, const Args& A) {
    unsigned char* ws = A.ws;
    const bf16* U = (const bf16*)(ws + WS_UPRE); bf16* ACT = (bf16*)(ws + WS_ACT);
    const float* cw = A.in[I_FCW]; const float* cb = A.in[I_FCB];
    constexpr int CG = DFF / 8;
    const long total = (long)SEQ * CG;
    for (long it = (long)F.vcu * NTHR + F.tid; it < total; it += (long)F.G * NTHR) {
        const int t = (int)(it / CG), c0 = (int)(it % CG) * 8;
        float g[8], up[8];
#pragma unroll
        for (int e = 0; e < 8; ++e) { g[e] = cb[c0 + e]; up[e] = cb[DFF + c0 + e]; }
#pragma unroll
        for (int k = 0; k < 3; ++k) { const int ts = t - 2 + k; if (ts < 0) continue;
            float a[8], b[8]; unpack8(*(const GAS v4u*)(U + (size_t)ts * DFF2 + c0), a); unpack8(*(const GAS v4u*)(U + (size_t)ts * DFF2 + DFF + c0), b);
#pragma unroll
            for (int e = 0; e < 8; ++e) { g[e] += cw[k * DFF2 + c0 + e] * a[e]; up[e] += cw[k * DFF2 + DFF + c0 + e] * b[e]; } }
        float o[8];
#pragma unroll
        for (int e = 0; e < 8; ++e) o[e] = siluf(g[e]) * up[e];
        v4u w; w.x = pk2(o[0], o[1]); w.y = pk2(o[2], o[3]); w.z = pk2(o[4], o[5]); w.w = pk2(o[6], o[7]);
        *(GAS v4u*)(ACT + (size_t)t * DFF + c0) = w;
    }
}

__device__ __forceinline__ int rel_bucket(int n) {
    if (n < 16) return n;
    int v = 16 + (int)(logf((float)n / 16.0f) / 2.0794415416798357f * 16.0f);
    return v < 31 ? v : 31;
}
__global__ void __launch_bounds__(256) naive_attn(const bf16* __restrict__ Q, const bf16* __restrict__ K, const bf16* __restrict__ V, const float* __restrict__ kbar,
                                                  const float* __restrict__ rel, bf16* __restrict__ O) {
    __shared__ float q_s[4][128];
    __shared__ float p_s[4][1024];
    __shared__ int   blk_s[4][4];
    const int w = threadIdx.x >> 6, lane = threadIdx.x & 63;
    const int pair = blockIdx.x * 4 + w, qi = pair / AH, h = pair % AH;
    const int blk = qi / BLK;
    { const unsigned u = *(const unsigned*)(Q + (size_t)qi * DA + h * AD + lane * 2); q_s[w][lane * 2] = bflo(u); q_s[w][lane * 2 + 1] = bfhi(u); }
    __syncthreads();
    float g = -INFINITY;
    if (lane < blk) { float s = 0.f; const float* kb = kbar + ((size_t)h * NBLK + lane) * AD; for (int d = 0; d < AD; ++d) s += q_s[w][d] * kb[d]; g = s; }
    const int nsel = blk < 3 ? blk : 3;
    for (int t = 0; t < nsel; ++t) {
        float bv = g; int bi = lane;
#pragma unroll
        for (int o = 1; o < 64; o <<= 1) { const float ov = __shfl_xor(bv, o); const int oi = __shfl_xor(bi, o); if (ov > bv || (ov == bv && oi < bi)) { bv = ov; bi = oi; } }
        if (lane == 0) blk_s[w][t] = bi;
        if (lane == bi) g = -INFINITY;
    }
    if (lane == 0) blk_s[w][nsel] = blk;
    __syncthreads();
    const int nslot = nsel + 1;
    float mx = -INFINITY;
    for (int s = 0; s < nslot; ++s) {
        const int nb = blk_s[w][s]; const bool own = (s == nsel);
        for (int i = 0; i < 4; ++i) { const int j = lane + 64 * i, kpos = nb * BLK + j; const int dist = qi - kpos;
            float sc = -INFINITY;
            if (dist >= 0) { const bf16* kr = K + (size_t)kpos * DA + h * AD; float a = 0.f;
                for (int d = 0; d < AD; d += 2) { const unsigned u = *(const unsigned*)(kr + d); a += q_s[w][d] * bflo(u) + q_s[w][d + 1] * bfhi(u); }
                sc = a + rel[rel_bucket(dist) * AH + h]; }
            (void)own;
            p_s[w][s * 256 + j] = sc; mx = fmaxf(mx, sc); }
    }
#pragma unroll
    for (int o = 1; o < 64; o <<= 1) mx = fmaxf(mx, __shfl_xor(mx, o));
    float sum = 0.f;
    for (int s = 0; s < nslot; ++s) for (int i = 0; i < 4; ++i) { const int idx = s * 256 + lane + 64 * i; const float e = __expf(p_s[w][idx] - mx); p_s[w][idx] = e; sum += e; }
    sum = wave_sum(sum);
    __syncthreads();
    float o0 = 0.f, o1 = 0.f;
    for (int s = 0; s < nslot; ++s) { const int nb = blk_s[w][s];
        for (int j = 0; j < 256; ++j) { const float p = p_s[w][s * 256 + j]; const unsigned u = *(const unsigned*)(V + (size_t)(nb * BLK + j) * DA + h * AD + lane * 2); o0 += p * bflo(u); o1 += p * bfhi(u); } }
    const float inv = 1.f / sum;
    *(unsigned*)(O + (size_t)qi * DA + h * AD + lane * 2) = pk2(o0 * inv, o1 * inv);
}

__global__ void __launch_bounds__(512) naive_ssd(const bf16* __restrict__ XBC, const bf16* __restrict__ Z, const float* __restrict__ DT, const float* __restrict__ cw, const float* __restrict__ cb,
                                                 const float* __restrict__ alog, const float* __restrict__ dskip, const float* __restrict__ nw, bf16* __restrict__ YG) {
    __shared__ float bc_s[256];
    __shared__ float red_s[8];
    const int g = blockIdx.x, tid = threadIdx.x, head = g * 8 + (tid >> 6), ch = g * 512 + tid;
    const float Aneg = -__expf(alog[head]), Dh = dskip[head], nwc = nw[ch];
    float hst[128];
#pragma unroll
    for (int n = 0; n < 128; ++n) hst[n] = 0.f;
    const int bcch = (tid < 128) ? (DI + g * NST + tid) : (DI + NG * NST + g * NST + (tid - 128));
    float wx[4], wb[4]; float bx = cb[ch], bb = 0.f;
#pragma unroll
    for (int k = 0; k < 4; ++k) wx[k] = cw[k * DXBC + ch];
    if (tid < 256) { bb = cb[bcch];
#pragma unroll
        for (int k = 0; k < 4; ++k) wb[k] = cw[k * DXBC + bcch]; }
    for (int t = 0; t < SEQ; ++t) {
        float xa = bx, ba = bb;
#pragma unroll
        for (int k = 0; k < 4; ++k) { const int ts = t - 3 + k; if (ts >= 0) { xa += wx[k] * bf2f(XBC[(size_t)ts * DXBC + ch]); if (tid < 256) ba += wb[k] * bf2f(XBC[(size_t)ts * DXBC + bcch]); } }
        const float xv = siluf(xa);
        __syncthreads();
        if (tid < 256) bc_s[tid] = siluf(ba);
        __syncthreads();
        const float dtv = DT[(size_t)t * NHS + head], dA = __expf(dtv * Aneg), dtx = dtv * xv;
        float y = 0.f;
#pragma unroll
        for (int n = 0; n < 128; ++n) { hst[n] = hst[n] * dA + dtx * bc_s[n]; y += bc_s[128 + n] * hst[n]; }
        y += Dh * xv;
        const float zv = bf2f(Z[(size_t)t * DI + ch]);
        const float gv = y * siluf(zv);
        float sq = wave_sum(gv * gv);
        if ((tid & 63) == 0) red_s[tid >> 6] = sq;
        __syncthreads();
        float tot = 0.f;
#pragma unroll
        for (int i = 0; i < 8; ++i) tot += red_s[i];
        const float r = 1.0f / sqrtf(tot * (1.0f / 512.f) + EPS);
        YG[(size_t)t * DI + ch] = (bf16)f2bf(gv * r * nwc);
    }
}

__global__ void __launch_bounds__(NTHR, 2) mk_fwd(Args args) {
    extern __shared__ __attribute__((aligned(16))) unsigned char lds[];
    Frame F;
    F.lds = (LAS unsigned char*)lds;
    volatile LAS unsigned* MISC = (volatile LAS unsigned*)(F.lds + MISC_OFF);
    F.tid = threadIdx.x; F.lane = F.tid & 63; F.wave = __builtin_amdgcn_readfirstlane(F.tid >> 6);
    F.G = gridDim.x; { const int bx = blockIdx.x; F.vcu = (F.G % 8 == 0) ? (bx % 8) * (F.G / 8) + bx / 8 : bx; }
    unsigned char* ws = args.ws;
    gu32* ctl = (gu32*)(ws + WS_CTL);
    for (int u = F.tid; u < (LDS_BYTES - LDSCTL_OFF) / 4; u += NTHR) ((LAS unsigned*)(F.lds + LDSCTL_OFF))[u] = 0u;
    __syncthreads();
    const int lo = args.ph_lo, hi = args.ph_hi;
    const bool multi = (hi - lo) > 1;
    XcdBarrier bar; bar.bar = (unsigned*)(ctl + CW_BAR) + args.li * XCD_BAR_WORDS; bar.x = 0; bar.st = nullptr;
    if (multi) bar = xcd_barrier_post((unsigned*)(ctl + CW_BAR) + args.li * XCD_BAR_WORDS, MISC + 8);
#define IN(k) (lo <= (k) && (k) < hi)
#define SEAM(k) do { if (IN(k) && IN((k) + 1)) xcd_barrier(bar); } while (0)

    if (IN(0)) { p0_prologue(F, args); SEAM(0); }
    if (IN(1)) {
        pg8::Gemm g{(const bf16*)(ws + WS_XB), (const bf16*)(ws + WS_WIN), SEQ, NIN, DM}; pg8::StaticOrder S; S.init(SEQ, NIN, F.G, (int)blockIdx.x);
        pg8::EpiInProj E{(bf16*)(ws + WS_Z), (bf16*)(ws + WS_XBC), (bf16*)(ws + WS_Q), (bf16*)(ws + WS_K), (bf16*)(ws + WS_V), (bf16*)(ws + WS_GT), (const float*)(ws + WS_R1), args.in[I_BG]};
        pg8::gemm_phase<pg8::EpiInProj, pg8::StaticOrder, true, true>(F.lds + RING_OFF, g, S, E);
        dt_phase(F, args);
        SEAM(1);
    }
    if (IN(2)) { attn_prep_phase(F, args); SEAM(2); }
    if (IN(3)) { SEAM(3); }
    if (IN(4)) { SEAM(4); }
    if (IN(5)) {
        { pg8::Gemm g{(const bf16*)(ws + WS_YG), (const bf16*)(ws + WS_WSS), SEQ, DM, DI}; pg8::StaticOrder S; S.init(SEQ, DM, F.G, (int)blockIdx.x);
          pg8::EpiGateF32 E{args.out, (const bf16*)(ws + WS_GT), 0};
          pg8::gemm_phase<pg8::EpiGateF32, pg8::StaticOrder, true, true>(F.lds + RING_OFF, g, S, E); }
        { pg8::Gemm g{(const bf16*)(ws + WS_Q), (const bf16*)(ws + WS_WAT), SEQ, DM, DA}; pg8::StaticOrder S; S.init(SEQ, DM, F.G, (int)blockIdx.x);
          pg8::EpiGateAddBf16 E{args.out, (const bf16*)(ws + WS_GT), DM, (bf16*)(ws + WS_XB)};
          pg8::gemm_phase<pg8::EpiGateAddBf16, pg8::StaticOrder, true, true>(F.lds + RING_OFF, g, S, E); }
        SEAM(5);
    }
    if (IN(6)) {
        pg8::Gemm g{(const bf16*)(ws + WS_XB), (const bf16*)(ws + WS_WOUT), SEQ, DM, DM}; pg8::StaticOrder S; S.init(SEQ, DM, F.G, (int)blockIdx.x);
        pg8::EpiResid1 E{args.in[I_X], args.out, (bf16*)(ws + WS_K), (float*)(ws + WS_SS2)};
        pg8::gemm_phase<pg8::EpiResid1, pg8::StaticOrder, true, true>(F.lds + RING_OFF, g, S, E);
        SEAM(6);
    }
    if (IN(7)) {
        pg8::Gemm g{(const bf16*)(ws + WS_K), (const bf16*)(ws + WS_WUP), SEQ, DFF2, DM}; pg8::StaticOrder S; S.init(SEQ, DFF2, F.G, (int)blockIdx.x);
        pg8::EpiUpPre E{(bf16*)(ws + WS_UPRE), (const float*)(ws + WS_SS2)};
        pg8::gemm_phase<pg8::EpiUpPre, pg8::StaticOrder, true, true>(F.lds + RING_OFF, g, S, E);
        SEAM(7);
    }
    if (IN(8)) { ffn_act_phase(F, args); SEAM(8); }
    if (IN(9)) {
        pg8::Gemm g{(const bf16*)(ws + WS_ACT), (const bf16*)(ws + WS_WDN), SEQ, DM, DFF}; pg8::StaticOrder S; S.init(SEQ, DM, F.G, (int)blockIdx.x);
        pg8::EpiResid2 E{args.out};
        pg8::gemm_phase<pg8::EpiResid2, pg8::StaticOrder, true, true>(F.lds + RING_OFF, g, S, E);
    }
#undef IN
#undef SEAM
}

extern "C" void kernel_launch(void* const* d_in, const int* in_sizes, int n_in, void* d_out, int out_size, void* d_ws, size_t ws_size, hipStream_t stream) {
    static int grid = 0;
    if (grid == 0) {
        if (n_in != N_INPUTS || in_sizes[0] != SEQ * DM || out_size != SEQ * DM || ws_size < WS_END) {
            fprintf(stderr, "kernel_launch: unexpected shapes: n_in %d in0 %d out %d ws %zu (need %zu)\n", n_in, n_in > 0 ? in_sizes[0] : -1, out_size, ws_size, (size_t)WS_END); grid = -1; return; }
        int dev = 0, cus = 0;
        if (hipGetDevice(&dev) != hipSuccess || hipDeviceGetAttribute(&cus, hipDeviceAttributeMultiprocessorCount, dev) != hipSuccess) { grid = -1; return; }
        if (hipFuncSetAttribute((const void*)mk_fwd, hipFuncAttributeMaxDynamicSharedMemorySize, LDS_BYTES) != hipSuccess) { fprintf(stderr, "kernel_launch: hipFuncSetAttribute failed\n"); grid = -1; return; }
        (void)hipGetLastError();
        grid = cus;
    }
    if (grid < 0) return;
    (void)hipMemsetAsync((char*)d_ws + WS_CTL, 0, CTL_ZERO_BYTES, stream);
    Args a{};
    for (int i = 0; i < N_INPUTS; ++i) a.in[i] = (const float*)d_in[i];
    a.out = (float*)d_out; a.ws = (unsigned char*)d_ws;
    unsigned char* ws = (unsigned char*)d_ws;
    auto launch = [&](int lo, int hi, int li) { a.ph_lo = lo; a.ph_hi = hi; a.li = li; a.pad = 0; hipLaunchKernelGGL(mk_fwd, dim3(grid), dim3(NTHR), LDS_BYTES, stream, a); };
#if MK_VARIANT == 1
    launch(0, 1, 0); launch(1, 2, 0); launch(2, 3, 0);
    naive_attn<<<SEQ * AH / 4, 256, 0, stream>>>((const bf16*)(ws + WS_Q), (const bf16*)(ws + WS_K), (const bf16*)(ws + WS_V), (const float*)(ws + WS_KBAR), a.in[I_REL], (bf16*)(ws + WS_Q));
    naive_ssd<<<NG, 512, 0, stream>>>((const bf16*)(ws + WS_XBC), (const bf16*)(ws + WS_Z), (const float*)(ws + WS_DT), a.in[I_SCW], a.in[I_SCB], a.in[I_ALOG], a.in[I_SD], a.in[I_SNW], (bf16*)(ws + WS_YG));
    launch(5, 6, 0); launch(6, 7, 0); launch(7, 8, 0); launch(8, 9, 0); launch(9, 10, 0);
#endif
}
```

```cpp
#define MK_VARIANT 4
#define DIAG_SCALE 100000.0f
#define DIAG_WHICH 0
#include <hip/hip_runtime.h>
#include <cstdio>
#include <cstdint>
namespace pg8 {
#define PG8_LAS __attribute__((address_space(3)))
typedef unsigned short bf16_t;
typedef short bf16x8 __attribute__((ext_vector_type(8)));
typedef float f32x4 __attribute__((ext_vector_type(4)));
typedef unsigned u32x4 __attribute__((ext_vector_type(4)));
constexpr int BM = 256, BK = 64, HALF = 128, HTB = HALF * BK * 2  , STAGE_BYTES = 8 * HTB, NXCD = 8, WGM = 8;

__host__ __device__ __forceinline__ int lds_byte(int r, int c) { const int st = (r >> 4) * 2 + (c >> 5), rr = r & 15, cc = c & 31, ob = rr * 64 + cc * 2; return st * 1024 + (ob ^ (((ob >> 9) & 1) << 5)); }
__host__ __device__ __forceinline__ void stage_rc(int b, int& R, int& C) { const int st = b / 1024, sb = b % 1024, swz = sb ^ (((sb >> 9) & 1) << 5); R = (st >> 1) * 16 + swz / 64; C = (st & 1) * 32 + (swz % 64) / 2; }
__host__ __device__ __forceinline__ int perm32(int rho) { const int n = rho >> 4, i = rho & 15; return 8 * (i >> 2) + 4 * n + (i & 3); }

struct Unit { int pm, pn; };
struct Gemm { const bf16_t* A; const bf16_t* Bt; int M, N, K; };

struct StaticOrder {
    int nM, nN, nwg, G, c;
    __host__ __device__ void init(int M, int N, int G_, int c_) { nM = M / BM; nN = N / BM; nwg = nM * nN; G = G_; c = c_; }
    __host__ __device__ bool next(int i, Unit& u) const {
        const long L = (long)i * G + c; if (L >= nwg) return false;
        int wgid = (int)L; { const int q = nwg / NXCD, r = nwg % NXCD, xcd = wgid % NXCD, off = wgid / NXCD; wgid = (xcd < r ? xcd * (q + 1) : r * (q + 1) + (xcd - r) * q) + off; }
        const int nig = WGM * nN, gid = wgid / nig, fm = gid * WGM, gsz = (nM - fm) < WGM ? (nM - fm) : WGM;
        u.pm = fm + ((wgid % nig) % gsz); u.pn = (wgid % nig) / gsz; return true;
    }
    __device__ __forceinline__ void a_ready(const Unit&) const {}
    __device__ __forceinline__ void done(const Unit&) const {}
};

__device__ __forceinline__ unsigned cvt_pk_bf16(float lo, float hi) { unsigned r; asm volatile("v_cvt_pk_bf16_f32 %0, %1, %2" : "=v"(r) : "v"(lo), "v"(hi)); return r; }
typedef float f32x2 __attribute__((ext_vector_type(2)));
template <class Epi, class Sched, bool ALIGN_EPI = false, bool SP2 = false>
__device__ __forceinline__ void gemm_phase(PG8_LAS unsigned char* lds, const Gemm g, const Sched& S, const Epi& E) {
    const int tid = threadIdx.x, wid = __builtin_amdgcn_readfirstlane(tid >> 6), lane = tid & 63, wr = wid >> 2, wc = wid & 3, fr = lane & 15, fq = lane >> 4;
    const int K = g.K, nt = K / BK;
    unsigned voffA[2], voffB[2];
#pragma unroll
    for (int i = 0; i < 2; ++i) { int R, C; stage_rc(tid * 16 + i * 8192, R, C); const int Rb = Epi::PERM ? ((R & ~31) + perm32(R & 31)) : R;
        voffA[i] = (unsigned)(R * K + C) * 2u; voffB[i] = (unsigned)(Rb * K + C) * 2u; }
    const size_t kstep = (size_t)(BK * 2);
    const size_t hstep = (size_t)HALF * K * 2;
    const size_t tstep = 2 * hstep;
    const unsigned ldsw = (unsigned)wid * 1024u;
    const int aoff = lds_byte(wr * 64 + fr, fq * 8), boff = lds_byte(wc * 32 + fr, fq * 8);
#define PG8_SA(b, h) (((b) * 2 + (h)) * HTB)
#define PG8_SB(b, h) ((4 + (b) * 2 + (h)) * HTB)
#define PG8_STAGE(bufoff, gbase, voff) do { _Pragma("unroll") for (int _i = 0; _i < 2; ++_i) \
        __builtin_amdgcn_global_load_lds((const unsigned*)((const char*)(gbase) + (voff)[_i]), (PG8_LAS unsigned*)(lds + (bufoff) + ldsw + _i * 8192), 16, 0, 0); } while (0)
#define PG8_LDA(dst, b, h) do { _Pragma("unroll") for (int m = 0; m < 4; ++m) _Pragma("unroll") for (int k = 0; k < 2; ++k) dst[m][k] = *(const PG8_LAS bf16x8*)(lds + PG8_SA(b, h) + aoff + m * 2048 + k * 1024); } while (0)
#define PG8_LDB(dst, b, h) do { _Pragma("unroll") for (int n = 0; n < 2; ++n) _Pragma("unroll") for (int k = 0; k < 2; ++k) dst[n][k] = *(const PG8_LAS bf16x8*)(lds + PG8_SB(b, h) + boff + n * 2048 + k * 1024); } while (0)
#define PG8_MMA(ai, bj, At, Bt) do { __builtin_amdgcn_s_setprio(1); _Pragma("unroll") for (int m = 0; m < 4; ++m) _Pragma("unroll") for (int n = 0; n < 2; ++n) _Pragma("unroll") for (int k = 0; k < 2; ++k) \
        acc[ai][bj][m][n] = __builtin_amdgcn_mfma_f32_16x16x32_bf16(Bt[n][k], At[m][k], acc[ai][bj][m][n], 0, 0, 0); __builtin_amdgcn_s_setprio(0); } while (0)
#define PG8_WAIT_V(n) asm volatile("s_waitcnt vmcnt(" #n ")" ::: "memory")
#define PG8_WAIT_L(n) asm volatile("s_waitcnt lgkmcnt(" #n ")" ::: "memory")
#define PG8_BAR __builtin_amdgcn_s_barrier()
#define PG8_SCHED __builtin_amdgcn_sched_barrier(0)
    Unit cur, nxt; int ui = 0;
    if (!S.next(0, cur)) return;
    f32x4 acc[2][2][4][2];
#pragma unroll
    for (int a = 0; a < 2; ++a)
#pragma unroll
        for (int b = 0; b < 2; ++b)
#pragma unroll
            for (int m = 0; m < 4; ++m)
#pragma unroll
                for (int n = 0; n < 2; ++n) acc[a][b][m][n] = (f32x4){0.f, 0.f, 0.f, 0.f};
    bf16x8 At[4][2], B0[2][2], B1[2][2];
    const char* cA = (const char*)g.A + (size_t)cur.pm * tstep; const char* cB = (const char*)g.Bt + (size_t)cur.pn * tstep;
    S.a_ready(cur);
    if constexpr (SP2) {
        PG8_STAGE(PG8_SB(0, 0), cB, voffB); PG8_STAGE(PG8_SB(0, 1), cB + hstep, voffB); PG8_STAGE(PG8_SA(0, 0), cA, voffA); PG8_STAGE(PG8_SA(0, 1), cA + hstep, voffA);
        if (wr == 1) PG8_BAR;
        PG8_WAIT_V(2); PG8_BAR;
        PG8_STAGE(PG8_SB(1, 0), cB + kstep, voffB); PG8_STAGE(PG8_SA(1, 0), cA + kstep, voffA); PG8_STAGE(PG8_SB(1, 1), cB + hstep + kstep, voffB);
        PG8_WAIT_V(6); PG8_BAR;
    } else {
        PG8_STAGE(PG8_SB(0, 0), cB, voffB); PG8_STAGE(PG8_SA(0, 0), cA, voffA); PG8_STAGE(PG8_SB(0, 1), cB + hstep, voffB); PG8_STAGE(PG8_SA(0, 1), cA + hstep, voffA);
        if (wr == 1) PG8_BAR;
        PG8_WAIT_V(4); PG8_BAR;
        PG8_STAGE(PG8_SB(1, 0), cB + kstep, voffB); PG8_STAGE(PG8_SA(1, 0), cA + kstep, voffA); PG8_STAGE(PG8_SB(1, 1), cB + hstep + kstep, voffB);
        PG8_WAIT_V(6); PG8_BAR;
    }
    for (;;) {
        const bool has_next = S.next(ui + 1, nxt);
        const char* nA = has_next ? (const char*)g.A + (size_t)nxt.pm * tstep : cA; const char* nB = has_next ? (const char*)g.Bt + (size_t)nxt.pn * tstep : cB;
        for (int t = 0; t < nt; t += 2) {
            const bool last = (t == nt - 2);
            const char* a1 = cA + (size_t)(t + 1) * kstep;
            const char* a2 = last ? nA : cA + (size_t)(t + 2) * kstep; const char* b2 = last ? nB : cB + (size_t)(t + 2) * kstep;
            const char* a3 = a2 + kstep; const char* b3 = b2 + kstep;
            if (last && has_next) S.a_ready(nxt);
            if constexpr (SP2) {
            PG8_LDB(B0, 0, 0); PG8_LDB(B1, 0, 1); PG8_SCHED; PG8_LDA(At, 0, 0); PG8_STAGE(PG8_SA(1, 1), a1 + hstep, voffA);
            PG8_WAIT_V(8); PG8_WAIT_L(0); PG8_BAR; PG8_MMA(0, 0, At, B0); PG8_MMA(0, 1, At, B1); PG8_BAR; PG8_SCHED;
            PG8_LDA(At, 0, 1); PG8_STAGE(PG8_SB(0, 0), b2, voffB); PG8_STAGE(PG8_SB(0, 1), b2 + hstep, voffB); PG8_STAGE(PG8_SA(0, 0), a2, voffA);
            PG8_WAIT_V(8); PG8_WAIT_L(0); PG8_BAR; PG8_MMA(1, 0, At, B0); PG8_MMA(1, 1, At, B1); PG8_BAR; PG8_SCHED;
            PG8_LDB(B0, 1, 0); PG8_LDB(B1, 1, 1); PG8_SCHED; PG8_LDA(At, 1, 0); PG8_STAGE(PG8_SA(0, 1), a2 + hstep, voffA);
            PG8_WAIT_V(8); PG8_WAIT_L(0); PG8_BAR; PG8_MMA(0, 0, At, B0); PG8_MMA(0, 1, At, B1); PG8_BAR; PG8_SCHED;
            PG8_LDA(At, 1, 1); PG8_STAGE(PG8_SB(1, 0), b3, voffB); PG8_STAGE(PG8_SB(1, 1), b3 + hstep, voffB); PG8_STAGE(PG8_SA(1, 0), a3, voffA);
            PG8_WAIT_V(8); PG8_WAIT_L(0); PG8_BAR; PG8_MMA(1, 0, At, B0); PG8_MMA(1, 1, At, B1); PG8_BAR; PG8_SCHED;
            } else {
            PG8_LDB(B0, 0, 0); PG8_SCHED; PG8_LDA(At, 0, 0); PG8_STAGE(PG8_SA(1, 1), a1 + hstep, voffA);
            PG8_WAIT_L(8); PG8_BAR; PG8_WAIT_L(0); PG8_MMA(0, 0, At, B0); PG8_BAR; PG8_SCHED;
            PG8_LDB(B1, 0, 1); PG8_STAGE(PG8_SB(0, 0), b2, voffB);
            PG8_BAR; PG8_WAIT_L(0); PG8_MMA(0, 1, At, B1); PG8_BAR;
            PG8_LDA(At, 0, 1); PG8_STAGE(PG8_SA(0, 0), a2, voffA);
            PG8_BAR; PG8_WAIT_L(0); PG8_MMA(1, 0, At, B0); PG8_BAR; PG8_SCHED;
            PG8_STAGE(PG8_SB(0, 1), b2 + hstep, voffB);
            PG8_WAIT_V(6); PG8_BAR; PG8_MMA(1, 1, At, B1); PG8_BAR;
            PG8_LDB(B0, 1, 0); PG8_SCHED; PG8_LDA(At, 1, 0); PG8_STAGE(PG8_SA(0, 1), a2 + hstep, voffA);
            PG8_WAIT_L(8); PG8_BAR; PG8_WAIT_L(0); PG8_MMA(0, 0, At, B0); PG8_BAR; PG8_SCHED;
            PG8_LDB(B1, 1, 1); PG8_STAGE(PG8_SB(1, 0), b3, voffB);
            PG8_BAR; PG8_WAIT_L(0); PG8_MMA(0, 1, At, B1); PG8_BAR;
            PG8_LDA(At, 1, 1); PG8_STAGE(PG8_SA(1, 0), a3, voffA);
            PG8_BAR; PG8_WAIT_L(0); PG8_MMA(1, 0, At, B0); PG8_BAR; PG8_SCHED;
            PG8_STAGE(PG8_SB(1, 1), b3 + hstep, voffB);
            PG8_WAIT_V(6); PG8_BAR; PG8_MMA(1, 1, At, B1); PG8_BAR;
            }
        }
        if constexpr (ALIGN_EPI) { if (wr == 0) PG8_BAR; }
        if constexpr (!Epi::AFTER_DRAIN) { E(acc, cur, wr, wc, fr, fq); S.done(cur); }
        if (!has_next) break;
#pragma unroll
        for (int a = 0; a < 2; ++a)
#pragma unroll
            for (int b = 0; b < 2; ++b)
#pragma unroll
                for (int m = 0; m < 4; ++m)
#pragma unroll
                    for (int n = 0; n < 2; ++n) acc[a][b][m][n] = (f32x4){0.f, 0.f, 0.f, 0.f};
        cur = nxt; cA = nA; cB = nB; ++ui;
        if constexpr (ALIGN_EPI) { if (wr == 1) PG8_BAR; }
    }
    PG8_WAIT_V(0);
    if constexpr (!ALIGN_EPI) { if (wr == 0) PG8_BAR; }
    PG8_BAR;
    if constexpr (Epi::AFTER_DRAIN) { E.fused(acc, cur, wr, wc, fr, fq, lds, wid, lane); S.done(cur); }
#undef PG8_SA
#undef PG8_SB
#undef PG8_STAGE
#undef PG8_LDA
#undef PG8_LDB
#undef PG8_MMA
#undef PG8_WAIT_V
#undef PG8_WAIT_L
#undef PG8_BAR
#undef PG8_SCHED
}
}

#define GAS __attribute__((address_space(1)))
#define LAS __attribute__((address_space(3)))
typedef unsigned short bf16;
typedef unsigned v4u __attribute__((ext_vector_type(4)));
typedef unsigned v2u __attribute__((ext_vector_type(2)));
typedef float f32x4 __attribute__((ext_vector_type(4)));
typedef float f32x2 __attribute__((ext_vector_type(2)));
typedef float f32x16 __attribute__((ext_vector_type(16)));
typedef short bf16x8 __attribute__((ext_vector_type(8)));
typedef short s16x4 __attribute__((ext_vector_type(4)));
typedef GAS unsigned gu32;
#define RLX_AGENT __ATOMIC_RELAXED, __HIP_MEMORY_SCOPE_AGENT
#define LDS_WAIT() asm volatile("s_waitcnt lgkmcnt(0)" ::: "memory")
#define VM_WAIT() asm volatile("s_waitcnt vmcnt(0)" ::: "memory")

constexpr int NWAVES = 8, NTHR = 512;
constexpr int SEQ = 8192, DM = 2048, DI = 4096, NHS = 64, HP = 64, NG = 8, NST = 128, DXBC = 6144, CHK = 256, NCH = 32;
constexpr int AH = 16, AD = 128, DA = 2048, BLK = 256, NBLK = 32;
constexpr int DFF = 5632, DFF2 = 11264;
constexpr int NIN = 20480;
constexpr int DINP = 20544;
constexpr float EPS = 1e-6f;

enum { I_X = 0, I_ANW, I_WIN, I_BG, I_SCW, I_SCB, I_DTB, I_ALOG, I_SD, I_SNW, I_QNW, I_KNW, I_REL, I_WSS, I_WAT, I_WOUT, I_FNW, I_WUP, I_FCW, I_FCB, I_WDN, N_INPUTS };

constexpr size_t MiB = 1u << 20;
constexpr size_t WS_CTL = 0, CTL_ZERO_BYTES = 256 * 1024;
constexpr size_t WS_R1 = 1 * MiB;
constexpr size_t WS_SS2 = WS_R1 + 64 * 1024;
constexpr size_t WS_KBAR = WS_SS2 + 64 * 1024;
constexpr size_t WS_KBARB = WS_KBAR + 256 * 1024;
constexpr size_t WS_DT = 2 * MiB;
constexpr size_t WS_ACS = 4 * MiB;
constexpr size_t WS_WIN = 16 * MiB;
constexpr size_t WS_STATES = 16 * MiB;
constexpr size_t WS_BCC = 200 * MiB;
constexpr size_t WS_WSS = 100 * MiB;
constexpr size_t WS_WAT = 116 * MiB;
constexpr size_t WS_WOUT = 124 * MiB;
constexpr size_t WS_WUP = 132 * MiB;
constexpr size_t WS_WDN = 176 * MiB;
constexpr size_t WS_XB = 200 * MiB;
constexpr size_t WS_Z = 232 * MiB;
constexpr size_t WS_XBC = 296 * MiB;
constexpr size_t WS_Q = 392 * MiB;
constexpr size_t WS_K = 424 * MiB;
constexpr size_t WS_V = 456 * MiB;
constexpr size_t WS_GT = 488 * MiB;
constexpr size_t WS_YG = 556 * MiB;
constexpr size_t WS_UPRE = 232 * MiB;
constexpr size_t WS_ACT = 456 * MiB;
constexpr size_t WS_END = 620 * MiB;

constexpr int CW_BAR = 4096;

__device__ __forceinline__ unsigned f2bf(float f) { unsigned u = __builtin_bit_cast(unsigned, f); return (u + 0x7fffu + ((u >> 16) & 1u)) >> 16; }
__device__ __forceinline__ unsigned pk2(float lo, float hi) { return f2bf(lo) | (f2bf(hi) << 16); }
__device__ __forceinline__ float bf2f(unsigned short b) { return __builtin_bit_cast(float, (unsigned)b << 16); }
__device__ __forceinline__ float bflo(unsigned w) { return __builtin_bit_cast(float, w << 16); }
__device__ __forceinline__ float bfhi(unsigned w) { return __builtin_bit_cast(float, w & 0xffff0000u); }
__device__ __forceinline__ float siluf(float v) { return v / (1.f + __expf(-v)); }
__device__ __forceinline__ float sigmf(float v) { return 1.f / (1.f + __expf(-v)); }
__device__ __forceinline__ float wave_sum(float v) {
#pragma unroll
    for (int o = 1; o < 64; o <<= 1) v += __shfl_xor(v, o);
    return v;
}

#define XB_TMO      128
#define XB_XCNT(j)  (256  + 64 * (j))
#define XB_XSUB(j)  (1280 + 64 * (j))
#define XB_XGEN(j)  (2304 + 64 * (j))
#define XB_TOP      3328
#define XB_TOPGEN   3392
#define XCD_BAR_WORDS 3456
#define XB_SPIN_CAP (1u << 20)
__device__ __forceinline__ unsigned xb_ld(unsigned* p)              { return __hip_atomic_load(p, __ATOMIC_RELAXED, __HIP_MEMORY_SCOPE_AGENT); }
__device__ __forceinline__ unsigned xb_add(unsigned* p, unsigned v) { return __hip_atomic_fetch_add(p, v, __ATOMIC_RELAXED, __HIP_MEMORY_SCOPE_AGENT); }
__device__ __forceinline__ unsigned xb_xcc_id() { return (unsigned)__builtin_amdgcn_s_getreg((3 << 11) | 20) & 0xFu; }
#define XB_SPIN(cond, bar) do { unsigned _sp = 0; while (cond) { __builtin_amdgcn_s_sleep(1); \
    if ((++_sp & 255u) == 0u) { if (xb_ld(&(bar)[XB_TMO])) break; if (_sp > XB_SPIN_CAP) { atomicAdd(&(bar)[XB_TMO], 1u); break; } } } } while (0)
struct XcdBarrier { unsigned* bar; unsigned x; volatile LAS unsigned* st; };
__device__ __forceinline__ XcdBarrier xcd_barrier_post(unsigned* bar, volatile LAS unsigned* st) {
    XcdBarrier b; b.bar = bar; b.x = xb_xcc_id(); b.st = st;
    if (threadIdx.x == 0) (void)xb_add(&bar[XB_XCNT(b.x)], 1u);
    return b;
}
__device__ __forceinline__ void xcd_barrier_complete(unsigned* bar, unsigned x, unsigned& nloc, unsigned& nx) {
    const unsigned G = gridDim.x * gridDim.y * gridDim.z;
    unsigned sum, cnt, mine, sp = 0u;
    for (;;) {
        sum = 0u; cnt = 0u; mine = 0u;
#pragma unroll
        for (unsigned j = 0; j < 16; ++j) { const unsigned c = xb_ld(&bar[XB_XCNT(j)]); sum += c; cnt += (c > 0u) ? 1u : 0u; mine = (j == x) ? c : mine; }
        if (sum == G) break;
        __builtin_amdgcn_s_sleep(1);
        if ((++sp & 255u) == 0u) { if (xb_ld(&bar[XB_TMO])) break; if (sp > XB_SPIN_CAP) { atomicAdd(&bar[XB_TMO], 1u); break; } }
    }
    nloc = mine > 0u ? mine : 1u; nx = cnt > 0u ? cnt : 1u;
}
__device__ __forceinline__ void xcd_barrier(const XcdBarrier& b) {
    asm volatile("s_waitcnt vmcnt(0)" ::: "memory");
    __syncthreads();
    if (threadIdx.x == 0) {
        unsigned* bar = b.bar;
        __builtin_amdgcn_s_waitcnt(0);
        unsigned nloc = b.st[0], nx = b.st[1];
        if (nloc == 0u) { xcd_barrier_complete(bar, b.x, nloc, nx); b.st[0] = nloc; b.st[1] = nx; }
        const unsigned old = xb_add(&bar[XB_XSUB(b.x)], 1u);
        const unsigned gen = old / nloc;
        if (old + 1u == (gen + 1u) * nloc) {
            __builtin_amdgcn_fence(__ATOMIC_RELEASE, "agent");
            asm volatile("s_waitcnt vmcnt(0)" ::: "memory");
            const unsigned og = xb_add(&bar[XB_TOP], 1u);
            const unsigned tg = og / nx;
            if (og + 1u == (tg + 1u) * nx) xb_add(&bar[XB_TOPGEN], 1u);
            else XB_SPIN(xb_ld(&bar[XB_TOPGEN]) == tg, bar);
            __builtin_amdgcn_fence(__ATOMIC_ACQUIRE, "agent");
            xb_add(&bar[XB_XGEN(b.x)], 1u);
            asm volatile("s_waitcnt vmcnt(0)" ::: "memory");
        } else {
            XB_SPIN(xb_ld(&bar[XB_XGEN(b.x)]) == gen, bar);
            __builtin_amdgcn_fence(__ATOMIC_ACQUIRE, "agent");
            asm volatile("s_waitcnt vmcnt(0)" ::: "memory");
        }
    }
    __syncthreads();
}

constexpr int RING_OFF = 0, RING_BYTES = 131072;
constexpr int LDSCTL_OFF = RING_BYTES, MISC_OFF = LDSCTL_OFF + 320;
constexpr int LDS_BYTES = 155648;

struct Args { const float* in[N_INPUTS]; float* out; unsigned char* ws; int ph_lo, ph_hi, li, pad; };
static_assert(sizeof(Args) == N_INPUTS * 8 + 8 + 8 + 16, "Args has no padding");

struct Frame {
    LAS unsigned char* lds;
    int tid, lane, wave, vcu, G;
};

__device__ __forceinline__ int map_ident(int n) { return n; }
__device__ __forceinline__ int map_win(int n) { return n < 10240 ? n : (n < 10304 ? 20480 + (n - 10240) : n - 64); }
template <int MAP>
__device__ __forceinline__ void p0_transpose_item(const float* __restrict__ W, int K, int N, bf16* WT, const float* __restrict__ kscale, LAS float* scr, int item, int lane) {
    const int nblk = N / 32, kb = item / nblk, nb = item % nblk, k0 = 64 * kb, n0 = 32 * nb;
#pragma unroll 8
    for (int i = 0; i < 32; ++i) { const int kk = 2 * i + (lane >> 5); float v = W[(size_t)(k0 + kk) * N + n0 + (lane & 31)]; if (kscale) v *= kscale[k0 + kk]; scr[kk * 33 + (lane & 31)] = v; }
    LDS_WAIT(); asm volatile("" ::: "memory");
    const int c = lane & 7;
#pragma unroll
    for (int j = 0; j < 4; ++j) { const int n = (lane >> 3) + 8 * j; const LAS float* s = scr + (8 * c) * 33 + n;
        v4u o; o.x = pk2(s[0 * 33], s[1 * 33]); o.y = pk2(s[2 * 33], s[3 * 33]); o.z = pk2(s[4 * 33], s[5 * 33]); o.w = pk2(s[6 * 33], s[7 * 33]);
        const int nn = n0 + n; const int dr = (MAP == 1) ? map_win(nn) : nn;
        *(GAS v4u*)(WT + (size_t)dr * K + k0 + 8 * c) = o; }
    LDS_WAIT(); asm volatile("" ::: "memory");
}
__device__ __forceinline__ void p0_prologue(Frame& F, const Args& A) {
    LAS float* scr = (LAS float*)(F.lds + RING_OFF + F.wave * 16384);
    const int gw = F.vcu * NWAVES + F.wave, NGW = F.G * NWAVES;
    unsigned char* ws = A.ws;
    constexpr int IT_WIN = (DM / 64) * (DINP / 32), IT_WSS = (DI / 64) * (DM / 32), IT_WAT = (DA / 64) * (DM / 32), IT_WOUT = (DM / 64) * (DM / 32),
                  IT_WUP = (DM / 64) * (DFF2 / 32), IT_WDN = (DFF / 64) * (DM / 32);
    constexpr int NITEMS = IT_WIN + IT_WSS + IT_WAT + IT_WOUT + IT_WUP + IT_WDN;
    for (int it = gw; it < NITEMS; it += NGW) {
        int r = it;
        if (r < IT_WIN) { p0_transpose_item<1>(A.in[I_WIN], DM, DINP, (bf16*)(ws + WS_WIN), A.in[I_ANW], scr, r, F.lane); continue; } r -= IT_WIN;
        if (r < IT_WSS) { p0_transpose_item<0>(A.in[I_WSS], DI, DM, (bf16*)(ws + WS_WSS), nullptr, scr, r, F.lane); continue; } r -= IT_WSS;
        if (r < IT_WAT) { p0_transpose_item<0>(A.in[I_WAT], DA, DM, (bf16*)(ws + WS_WAT), nullptr, scr, r, F.lane); continue; } r -= IT_WAT;
        if (r < IT_WOUT) { p0_transpose_item<0>(A.in[I_WOUT], DM, DM, (bf16*)(ws + WS_WOUT), nullptr, scr, r, F.lane); continue; } r -= IT_WOUT;
        if (r < IT_WUP) { p0_transpose_item<0>(A.in[I_WUP], DM, DFF2, (bf16*)(ws + WS_WUP), A.in[I_FNW], scr, r, F.lane); continue; } r -= IT_WUP;
        p0_transpose_item<0>(A.in[I_WDN], DFF, DM, (bf16*)(ws + WS_WDN), nullptr, scr, r, F.lane);
    }
    float* r1 = (float*)(ws + WS_R1); float* ss2 = (float*)(ws + WS_SS2);
    bf16* xb = (bf16*)(ws + WS_XB);
    for (int m = gw; m < SEQ; m += NGW) {
        const GAS f32x4* xr = (const GAS f32x4*)(A.in[I_X] + (size_t)m * DM) + F.lane;
        f32x4 v[8]; float s = 0.f;
#pragma unroll
        for (int j = 0; j < 8; ++j) { v[j] = xr[64 * j]; s += (v[j].x * v[j].x + v[j].y * v[j].y) + (v[j].z * v[j].z + v[j].w * v[j].w); }
        s = wave_sum(s);
        GAS unsigned long long* o8 = (GAS unsigned long long*)(xb + (size_t)m * DM) + F.lane;
#pragma unroll
        for (int j = 0; j < 8; ++j) o8[64 * j] = (unsigned long long)pk2(v[j].x, v[j].y) | ((unsigned long long)pk2(v[j].z, v[j].w) << 32);
        if (F.lane == 0) { r1[m] = 1.0f / sqrtf(s * (1.0f / DM) + EPS); ss2[m] = 0.f; }
    }
}

namespace pg8 {
struct EpiInProj {
    static constexpr bool PERM = true, AFTER_DRAIN = false;
    bf16_t *z, *xbc, *q, *k, *v, *gt; const float* r1; const float* bg;
    __device__ __forceinline__ void operator()(const f32x4 (&acc)[2][2][4][2], const Unit& u, int wr, int wc, int fr, int fq) const {
        const int pn = u.pn; bf16_t* base; int ldc, colt; bool isg = false;
        if (pn < 16) { base = z; ldc = DI; colt = pn * 256; }
        else if (pn < 40) { base = xbc; ldc = DXBC; colt = (pn - 16) * 256; }
        else if (pn < 48) { base = q; ldc = DA; colt = (pn - 40) * 256; }
        else if (pn < 56) { base = k; ldc = DA; colt = (pn - 48) * 256; }
        else if (pn < 64) { base = v; ldc = DA; colt = (pn - 56) * 256; }
        else { base = gt; ldc = DI; colt = (pn - 64) * 256; isg = true; }
        const int row0 = u.pm * BM + wr * 64 + fr, col0 = colt + wc * 32 + 8 * fq;
        f32x4 bv[2][2];
#pragma unroll
        for (int bj = 0; bj < 2; ++bj)
#pragma unroll
            for (int n = 0; n < 2; ++n) bv[bj][n] = isg ? *(const f32x4*)(bg + col0 + bj * HALF + 4 * n) : (f32x4){0.f, 0.f, 0.f, 0.f};
#pragma unroll
        for (int ai = 0; ai < 2; ++ai)
#pragma unroll
            for (int m = 0; m < 4; ++m) { const int row = row0 + ai * HALF + m * 16; const float rs = r1[row]; bf16_t* rowp = base + (size_t)row * ldc + col0;
#pragma unroll
                for (int bj = 0; bj < 2; ++bj) { f32x4 v0 = acc[ai][bj][m][0] * rs + bv[bj][0], v1 = acc[ai][bj][m][1] * rs + bv[bj][1];
                    if (isg) {
#pragma unroll
                        for (int e = 0; e < 4; ++e) { v0[e] = 1.f / (1.f + __expf(-v0[e])); v1[e] = 1.f / (1.f + __expf(-v1[e])); } }
                    u32x4 w; w.x = cvt_pk_bf16(v0[0], v0[1]); w.y = cvt_pk_bf16(v0[2], v0[3]); w.z = cvt_pk_bf16(v1[0], v1[1]); w.w = cvt_pk_bf16(v1[2], v1[3]);
                    *(u32x4*)(rowp + bj * HALF) = w; } }
    }
};
struct EpiGateF32 {
    static constexpr bool PERM = true, AFTER_DRAIN = false;
    float* T; const bf16_t* gt; int goff;
    __device__ __forceinline__ void operator()(const f32x4 (&acc)[2][2][4][2], const Unit& u, int wr, int wc, int fr, int fq) const {
        const int row0 = u.pm * BM + wr * 64 + fr, col0 = u.pn * BM + wc * 32 + 8 * fq;
#pragma unroll
        for (int ai = 0; ai < 2; ++ai)
#pragma unroll
            for (int m = 0; m < 4; ++m) { const int row = row0 + ai * HALF + m * 16;
#pragma unroll
                for (int bj = 0; bj < 2; ++bj) { const u32x4 g = *(const u32x4*)(gt + (size_t)row * DI + goff + col0 + bj * HALF);
                    f32x4 g0 = {__builtin_bit_cast(float, g.x << 16), __builtin_bit_cast(float, g.x & 0xffff0000u), __builtin_bit_cast(float, g.y << 16), __builtin_bit_cast(float, g.y & 0xffff0000u)};
                    f32x4 g1 = {__builtin_bit_cast(float, g.z << 16), __builtin_bit_cast(float, g.z & 0xffff0000u), __builtin_bit_cast(float, g.w << 16), __builtin_bit_cast(float, g.w & 0xffff0000u)};
                    float* tp = T + (size_t)row * DM + col0 + bj * HALF;
                    *(f32x4*)tp = acc[ai][bj][m][0] * g0; *(f32x4*)(tp + 4) = acc[ai][bj][m][1] * g1; } }
    }
};
struct EpiGateAddBf16 {
    static constexpr bool PERM = true, AFTER_DRAIN = false;
    const float* T; const bf16_t* gt; int goff; bf16_t* O;
    __device__ __forceinline__ void operator()(const f32x4 (&acc)[2][2][4][2], const Unit& u, int wr, int wc, int fr, int fq) const {
        const int row0 = u.pm * BM + wr * 64 + fr, col0 = u.pn * BM + wc * 32 + 8 * fq;
#pragma unroll
        for (int ai = 0; ai < 2; ++ai)
#pragma unroll
            for (int m = 0; m < 4; ++m) { const int row = row0 + ai * HALF + m * 16;
#pragma unroll
                for (int bj = 0; bj < 2; ++bj) { const u32x4 g = *(const u32x4*)(gt + (size_t)row * DI + goff + col0 + bj * HALF);
                    f32x4 g0 = {__builtin_bit_cast(float, g.x << 16), __builtin_bit_cast(float, g.x & 0xffff0000u), __builtin_bit_cast(float, g.y << 16), __builtin_bit_cast(float, g.y & 0xffff0000u)};
                    f32x4 g1 = {__builtin_bit_cast(float, g.z << 16), __builtin_bit_cast(float, g.z & 0xffff0000u), __builtin_bit_cast(float, g.w << 16), __builtin_bit_cast(float, g.w & 0xffff0000u)};
                    const float* tp = T + (size_t)row * DM + col0 + bj * HALF;
                    const f32x4 v0 = *(const f32x4*)tp + acc[ai][bj][m][0] * g0, v1 = *(const f32x4*)(tp + 4) + acc[ai][bj][m][1] * g1;
                    u32x4 w; w.x = cvt_pk_bf16(v0[0], v0[1]); w.y = cvt_pk_bf16(v0[2], v0[3]); w.z = cvt_pk_bf16(v1[0], v1[1]); w.w = cvt_pk_bf16(v1[2], v1[3]);
                    *(u32x4*)(O + (size_t)row * DM + col0 + bj * HALF) = w; } }
    }
};
struct EpiResid1 {
    static constexpr bool PERM = true, AFTER_DRAIN = false;
    const float* X; float* out; bf16_t* xb1; float* ss2;
    __device__ __forceinline__ void operator()(const f32x4 (&acc)[2][2][4][2], const Unit& u, int wr, int wc, int fr, int fq) const {
        const int row0 = u.pm * BM + wr * 64 + fr, col0 = u.pn * BM + wc * 32 + 8 * fq;
#pragma unroll
        for (int ai = 0; ai < 2; ++ai)
#pragma unroll
            for (int m = 0; m < 4; ++m) { const int row = row0 + ai * HALF + m * 16; float sq = 0.f;
#pragma unroll
                for (int bj = 0; bj < 2; ++bj) { const size_t off = (size_t)row * DM + col0 + bj * HALF;
                    const f32x4 v0 = *(const f32x4*)(X + off) + acc[ai][bj][m][0], v1 = *(const f32x4*)(X + off + 4) + acc[ai][bj][m][1];
                    *(f32x4*)(out + off) = v0; *(f32x4*)(out + off + 4) = v1;
                    sq += (v0[0] * v0[0] + v0[1] * v0[1]) + (v0[2] * v0[2] + v0[3] * v0[3]) + (v1[0] * v1[0] + v1[1] * v1[1]) + (v1[2] * v1[2] + v1[3] * v1[3]);
                    u32x4 w; w.x = cvt_pk_bf16(v0[0], v0[1]); w.y = cvt_pk_bf16(v0[2], v0[3]); w.z = cvt_pk_bf16(v1[0], v1[1]); w.w = cvt_pk_bf16(v1[2], v1[3]);
                    *(u32x4*)(xb1 + off) = w; }
                sq += __shfl_xor(sq, 16); sq += __shfl_xor(sq, 32);
                if (fq == 0) atomicAdd(ss2 + row, sq); }
    }
};
struct EpiUpPre {
    static constexpr bool PERM = true, AFTER_DRAIN = false;
    bf16_t* O; const float* ss2;
    __device__ __forceinline__ void operator()(const f32x4 (&acc)[2][2][4][2], const Unit& u, int wr, int wc, int fr, int fq) const {
        const int row0 = u.pm * BM + wr * 64 + fr, col0 = u.pn * BM + wc * 32 + 8 * fq;
#pragma unroll
        for (int ai = 0; ai < 2; ++ai)
#pragma unroll
            for (int m = 0; m < 4; ++m) { const int row = row0 + ai * HALF + m * 16; const float rs = 1.0f / sqrtf(ss2[row] * (1.0f / DM) + EPS);
#pragma unroll
                for (int bj = 0; bj < 2; ++bj) { const f32x4 v0 = acc[ai][bj][m][0] * rs, v1 = acc[ai][bj][m][1] * rs;
                    u32x4 w; w.x = cvt_pk_bf16(v0[0], v0[1]); w.y = cvt_pk_bf16(v0[2], v0[3]); w.z = cvt_pk_bf16(v1[0], v1[1]); w.w = cvt_pk_bf16(v1[2], v1[3]);
                    *(u32x4*)(O + (size_t)row * DFF2 + col0 + bj * HALF) = w; } }
    }
};
struct EpiResid2 {
    static constexpr bool PERM = true, AFTER_DRAIN = false;
    float* out;
    __device__ __forceinline__ void operator()(const f32x4 (&acc)[2][2][4][2], const Unit& u, int wr, int wc, int fr, int fq) const {
        const int row0 = u.pm * BM + wr * 64 + fr, col0 = u.pn * BM + wc * 32 + 8 * fq;
#pragma unroll
        for (int ai = 0; ai < 2; ++ai)
#pragma unroll
            for (int m = 0; m < 4; ++m) { const int row = row0 + ai * HALF + m * 16;
#pragma unroll
                for (int bj = 0; bj < 2; ++bj) { float* p = out + (size_t)row * DM + col0 + bj * HALF;
                    const f32x4 v0 = *(const f32x4*)p + acc[ai][bj][m][0], v1 = *(const f32x4*)(p + 4) + acc[ai][bj][m][1];
                    *(f32x4*)p = v0; *(f32x4*)(p + 4) = v1; } }
    }
};
}

__device__ __forceinline__ float softplusf(float v) { return v > 20.f ? v : log1pf(__expf(v)); }
__device__ __forceinline__ void dt_phase(Frame& F, const Args& A) {
    unsigned char* ws = A.ws;
    const bf16* xb = (const bf16*)(ws + WS_XB); const bf16* wt = (const bf16*)(ws + WS_WIN) + (size_t)NIN * DM;
    const float* r1 = (const float*)(ws + WS_R1); float* dt = (float*)(ws + WS_DT);
    const int gw = F.vcu * NWAVES + F.wave, NGW = F.G * NWAVES;
    for (int m = gw; m < SEQ; m += NGW) {
        const GAS v4u* xr = (const GAS v4u*)(xb + (size_t)m * DM) + F.lane;
        float xv[32];
#pragma unroll
        for (int j = 0; j < 4; ++j) { const v4u w = xr[64 * j];
            xv[8 * j + 0] = bflo(w.x); xv[8 * j + 1] = bfhi(w.x); xv[8 * j + 2] = bflo(w.y); xv[8 * j + 3] = bfhi(w.y);
            xv[8 * j + 4] = bflo(w.z); xv[8 * j + 5] = bfhi(w.z); xv[8 * j + 6] = bflo(w.w); xv[8 * j + 7] = bfhi(w.w); }
        const float rs = r1[m];
        for (int h = 0; h < NHS; ++h) {
            const GAS v4u* wr = (const GAS v4u*)(wt + (size_t)h * DM) + F.lane; float s = 0.f;
#pragma unroll
            for (int j = 0; j < 4; ++j) { const v4u w = wr[64 * j];
                s += xv[8 * j + 0] * bflo(w.x) + xv[8 * j + 1] * bfhi(w.x) + xv[8 * j + 2] * bflo(w.y) + xv[8 * j + 3] * bfhi(w.y)
                   + xv[8 * j + 4] * bflo(w.z) + xv[8 * j + 5] * bfhi(w.z) + xv[8 * j + 6] * bflo(w.w) + xv[8 * j + 7] * bfhi(w.w); }
            s = wave_sum(s);
            if (F.lane == 0) dt[(size_t)m * NHS + h] = softplusf(s * rs + A.in[I_DTB][h]);
        }
    }
}

__device__ __forceinline__ void attn_prep_phase(Frame& F, const Args& A) {
    unsigned char* ws = A.ws;
    bf16* Q = (bf16*)(ws + WS_Q); bf16* K = (bf16*)(ws + WS_K); float* kbar = (float*)(ws + WS_KBAR); bf16* kbarb = (bf16*)(ws + WS_KBARB);
    LAS float* red = (LAS float*)(F.lds + RING_OFF);
    const int sub = F.tid >> 4, l16 = F.tid & 15;
    float qw[8], kw[8];
#pragma unroll
    for (int e = 0; e < 8; ++e) { qw[e] = A.in[I_QNW][l16 * 8 + e] * (0.08838834764831845f * 1.4426950408889634f); kw[e] = A.in[I_KNW][l16 * 8 + e]; }
    for (int u = F.vcu; u < NBLK * AH; u += F.G) {
        const int nb = u / AH, h = u % AH;
        float ksum[8];
#pragma unroll
        for (int e = 0; e < 8; ++e) ksum[e] = 0.f;
        for (int i = 0; i < 8; ++i) {
            const int t = nb * BLK + i * 32 + sub; const size_t off = (size_t)t * DA + h * AD + l16 * 8;
            { const v4u w = *(const GAS v4u*)(Q + off); float v[8] = {bflo(w.x), bfhi(w.x), bflo(w.y), bfhi(w.y), bflo(w.z), bfhi(w.z), bflo(w.w), bfhi(w.w)};
              float s = 0.f;
#pragma unroll
              for (int e = 0; e < 8; ++e) s += v[e] * v[e];
              s += __shfl_xor(s, 1); s += __shfl_xor(s, 2); s += __shfl_xor(s, 4); s += __shfl_xor(s, 8);
              const float r = 1.0f / sqrtf(s * (1.0f / AD) + EPS);
              v4u o; o.x = pk2(v[0] * r * qw[0], v[1] * r * qw[1]); o.y = pk2(v[2] * r * qw[2], v[3] * r * qw[3]); o.z = pk2(v[4] * r * qw[4], v[5] * r * qw[5]); o.w = pk2(v[6] * r * qw[6], v[7] * r * qw[7]);
              *(GAS v4u*)(Q + off) = o; }
            { const v4u w = *(const GAS v4u*)(K + off); float v[8] = {bflo(w.x), bfhi(w.x), bflo(w.y), bfhi(w.y), bflo(w.z), bfhi(w.z), bflo(w.w), bfhi(w.w)};
              float s = 0.f;
#pragma unroll
              for (int e = 0; e < 8; ++e) s += v[e] * v[e];
              s += __shfl_xor(s, 1); s += __shfl_xor(s, 2); s += __shfl_xor(s, 4); s += __shfl_xor(s, 8);
              const float r = 1.0f / sqrtf(s * (1.0f / AD) + EPS);
#pragma unroll
              for (int e = 0; e < 8; ++e) { v[e] = v[e] * r * kw[e]; ksum[e] += v[e]; }
              v4u o; o.x = pk2(v[0], v[1]); o.y = pk2(v[2], v[3]); o.z = pk2(v[4], v[5]); o.w = pk2(v[6], v[7]);
              *(GAS v4u*)(K + off) = o; }
        }
#pragma unroll
        for (int e = 0; e < 8; ++e) red[sub * 128 + l16 * 8 + e] = ksum[e];
        __syncthreads();
        if (F.tid < 128) { float s = 0.f;
#pragma unroll 8
            for (int r = 0; r < 32; ++r) s += red[r * 128 + F.tid];
            kbar[((size_t)h * NBLK + nb) * AD + F.tid] = s * (1.0f / BLK); kbarb[((size_t)h * NBLK + nb) * AD + F.tid] = (bf16)f2bf(s * (1.0f / BLK)); }
        __syncthreads();
    }
}

__device__ __forceinline__ void unpack8(const v4u w, float* v) { v[0] = bflo(w.x); v[1] = bfhi(w.x); v[2] = bflo(w.y); v[3] = bfhi(w.y); v[4] = bflo(w.z); v[5] = bfhi(w.z); v[6] = bflo(w.w); v[7] = bfhi(w.w); }
__device__ __forceinline__ void ffn_act_phase(Frame& F, const Args& A) {
    unsigned char* ws = A.ws;
    const bf16* U = (const bf16*)(ws + WS_UPRE); bf16* ACT = (bf16*)(ws + WS_ACT);
    const float* cw = A.in[I_FCW]; const float* cb = A.in[I_FCB];
    constexpr int CG = DFF / 8;
    const long total = (long)SEQ * CG;
    for (long it = (long)F.vcu * NTHR + F.tid; it < total; it += (long)F.G * NTHR) {
        const int t = (int)(it / CG), c0 = (int)(it % CG) * 8;
        float g[8], up[8];
#pragma unroll
        for (int e = 0; e < 8; ++e) { g[e] = cb[c0 + e]; up[e] = cb[DFF + c0 + e]; }
#pragma unroll
        for (int k = 0; k < 3; ++k) { const int ts = t - 2 + k; if (ts < 0) continue;
            float a[8], b[8]; unpack8(*(const GAS v4u*)(U + (size_t)ts * DFF2 + c0), a); unpack8(*(const GAS v4u*)(U + (size_t)ts * DFF2 + DFF + c0), b);
#pragma unroll
            for (int e = 0; e < 8; ++e) { g[e] += cw[k * DFF2 + c0 + e] * a[e]; up[e] += cw[k * DFF2 + DFF + c0 + e] * b[e]; } }
        float o[8];
#pragma unroll
        for (int e = 0; e < 8; ++e) o[e] = siluf(g[e]) * up[e];
        v4u w; w.x = pk2(o[0], o[1]); w.y = pk2(o[2], o[3]); w.z = pk2(o[4], o[5]); w.w = pk2(o[6], o[7]);
        *(GAS v4u*)(ACT + (size_t)t * DFF + c0) = w;
    }
}

__device__ __forceinline__ int rel_bucket(int n) {
    if (n < 16) return n;
    int v = 16 + (int)(logf((float)n / 16.0f) / 2.0794415416798357f * 16.0f);
    return v < 31 ? v : 31;
}
__global__ void __launch_bounds__(256) naive_attn(const bf16* __restrict__ Q, const bf16* __restrict__ K, const bf16* __restrict__ V, const bf16* __restrict__ kbar,
                                                  const float* __restrict__ rel, bf16* __restrict__ O) {
    __shared__ float q_s[4][128];
    __shared__ float p_s[4][1024];
    __shared__ int   blk_s[4][4];
    const int w = threadIdx.x >> 6, lane = threadIdx.x & 63;
    const int pair = blockIdx.x * 4 + w, qi = pair / AH, h = pair % AH;
    const int blk = qi / BLK;
    { const unsigned u = *(const unsigned*)(Q + (size_t)qi * DA + h * AD + lane * 2); q_s[w][lane * 2] = bflo(u); q_s[w][lane * 2 + 1] = bfhi(u); }
    __syncthreads();
    float g = -INFINITY;
    if (lane < blk) { float s = 0.f; const bf16* kb = kbar + ((size_t)h * NBLK + lane) * AD; for (int d = 0; d < AD; ++d) s += q_s[w][d] * bf2f(kb[d]); g = s; }
    const int nsel = blk < 3 ? blk : 3;
    for (int t = 0; t < nsel; ++t) {
        float bv = g; int bi = lane;
#pragma unroll
        for (int o = 1; o < 64; o <<= 1) { const float ov = __shfl_xor(bv, o); const int oi = __shfl_xor(bi, o); if (ov > bv || (ov == bv && oi < bi)) { bv = ov; bi = oi; } }
        if (lane == 0) blk_s[w][t] = bi;
        if (lane == bi) g = -INFINITY;
    }
    if (lane == 0) blk_s[w][nsel] = blk;
    __syncthreads();
    const int nslot = nsel + 1;
    float mx = -INFINITY;
    for (int s = 0; s < nslot; ++s) {
        const int nb = blk_s[w][s]; const bool own = (s == nsel);
        for (int i = 0; i < 4; ++i) { const int j = lane + 64 * i, kpos = nb * BLK + j; const int dist = qi - kpos;
            float sc = -INFINITY;
            if (dist >= 0) { const bf16* kr = K + (size_t)kpos * DA + h * AD; float a = 0.f;
                for (int d = 0; d < AD; d += 2) { const unsigned u = *(const unsigned*)(kr + d); a += q_s[w][d] * bflo(u) + q_s[w][d + 1] * bfhi(u); }
                sc = a + rel[rel_bucket(dist) * AH + h] * 1.4426950408889634f; }
            (void)own;
            p_s[w][s * 256 + j] = sc; mx = fmaxf(mx, sc); }
    }
#pragma unroll
    for (int o = 1; o < 64; o <<= 1) mx = fmaxf(mx, __shfl_xor(mx, o));
    float sum = 0.f;
    for (int s = 0; s < nslot; ++s) for (int i = 0; i < 4; ++i) { const int idx = s * 256 + lane + 64 * i; const float e = exp2f(p_s[w][idx] - mx); p_s[w][idx] = e; sum += e; }
    sum = wave_sum(sum);
    __syncthreads();
    float o0 = 0.f, o1 = 0.f;
    for (int s = 0; s < nslot; ++s) { const int nb = blk_s[w][s];
        for (int j = 0; j < 256; ++j) { const float p = p_s[w][s * 256 + j]; const unsigned u = *(const unsigned*)(V + (size_t)(nb * BLK + j) * DA + h * AD + lane * 2); o0 += p * bflo(u); o1 += p * bfhi(u); } }
    const float inv = 1.f / sum;
    *(unsigned*)(O + (size_t)qi * DA + h * AD + lane * 2) = pk2(o0 * inv, o1 * inv);
}

__global__ void __launch_bounds__(512) naive_ssd(const bf16* __restrict__ XBC, const bf16* __restrict__ Z, const float* __restrict__ DT, const float* __restrict__ cw, const float* __restrict__ cb,
                                                 const float* __restrict__ alog, const float* __restrict__ dskip, const float* __restrict__ nw, bf16* __restrict__ YG) {
    __shared__ float bc_s[256];
    __shared__ float red_s[8];
    const int g = blockIdx.x, tid = threadIdx.x, head = g * 8 + (tid >> 6), ch = g * 512 + tid;
    const float Aneg = -__expf(alog[head]), Dh = dskip[head], nwc = nw[ch];
    float hst[128];
#pragma unroll
    for (int n = 0; n < 128; ++n) hst[n] = 0.f;
    const int bcch = (tid < 128) ? (DI + g * NST + tid) : (DI + NG * NST + g * NST + (tid - 128));
    float wx[4], wb[4]; float bx = cb[ch], bb = 0.f;
#pragma unroll
    for (int k = 0; k < 4; ++k) wx[k] = cw[k * DXBC + ch];
    if (tid < 256) { bb = cb[bcch];
#pragma unroll
        for (int k = 0; k < 4; ++k) wb[k] = cw[k * DXBC + bcch]; }
    for (int t = 0; t < SEQ; ++t) {
        float xa = bx, ba = bb;
#pragma unroll
        for (int k = 0; k < 4; ++k) { const int ts = t - 3 + k; if (ts >= 0) { xa += wx[k] * bf2f(XBC[(size_t)ts * DXBC + ch]); if (tid < 256) ba += wb[k] * bf2f(XBC[(size_t)ts * DXBC + bcch]); } }
        const float xv = siluf(xa);
        __syncthreads();
        if (tid < 256) bc_s[tid] = siluf(ba);
        __syncthreads();
        const float dtv = DT[(size_t)t * NHS + head], dA = __expf(dtv * Aneg), dtx = dtv * xv;
        float y = 0.f;
#pragma unroll
        for (int n = 0; n < 128; ++n) { hst[n] = hst[n] * dA + dtx * bc_s[n]; y += bc_s[128 + n] * hst[n]; }
        y += Dh * xv;
        const float zv = bf2f(Z[(size_t)t * DI + ch]);
        const float gv = y * siluf(zv);
        float sq = wave_sum(gv * gv);
        if ((tid & 63) == 0) red_s[tid >> 6] = sq;
        __syncthreads();
        float tot = 0.f;
#pragma unroll
        for (int i = 0; i < 8; ++i) tot += red_s[i];
        const float r = 1.0f / sqrtf(tot * (1.0f / 512.f) + EPS);
        YG[(size_t)t * DI + ch] = (bf16)f2bf(gv * r * nwc);
    }
}

namespace att {
constexpr int QBLK = 32, KVBLK = 64, D = 128, LD = DA;
constexpr int SHM_V = KVBLK * D * 2, SHM_K = KVBLK * D * 2;
constexpr int OFF_V = 0, OFF_K = 2 * SHM_V, OFF_WS = 2 * SHM_V + 2 * SHM_K, OFF_LUT = OFF_WS + NWAVES * 64 * 4, OFF_KBAR = OFF_LUT + 512, OFF_QF = OFF_KBAR + 32 * 256, ATT_LDS = OFF_QF + NWAVES * 8192;
constexpr float LOG2E = 1.4426950408889634f;
constexpr float THR2 = 11.5f;
#define KSWZ(row, colB) ((row) * 256 + ((colB) ^ (((row) & 7) << 4)))
#define SBAR() __builtin_amdgcn_sched_barrier(0)
__device__ __forceinline__ int v_st(int k, int c) { const int kk = (k & ~0xC) | ((k & 4) << 1) | ((k & 8) >> 1); return ((kk >> 3) * 4 + (c >> 5)) * 512 + ((kk & 7) * 32 + (c & 31)) * 2; }
__device__ __forceinline__ int v_rd_base(int lane) { return ((lane & 3) << 3) | (((lane >> 2) & 3) << 6) | (((lane >> 4) & 1) << 5) | (((lane >> 5) & 1) << 8); }
constexpr int v_rd_off(int d0, int ks, int half) { return d0 * 512 + ks * 4096 + half * 2048; }
__device__ __forceinline__ int crow(int r, int hi) { return (r & 3) + 8 * (r >> 2) + 4 * hi; }
__device__ __forceinline__ unsigned cvtpk(float lo, float hi) { unsigned r; asm volatile("v_cvt_pk_bf16_f32 %0, %1, %2" : "=v"(r) : "v"(lo), "v"(hi)); return r; }

__device__ __forceinline__ void bias_tile(f32x16& p0, f32x16& p1, int dq, const float* lut) {
    const float NEG = -__builtin_inff();
#pragma unroll
    for (int r = 0; r < 16; ++r) {
        const int c = (r & 3) + 8 * (r >> 2);
        const int d0 = dq - c, d1 = dq - c - 32;
        const float b0 = lut[d0 < 0 ? 0 : (d0 > 127 ? 127 : d0)], b1 = lut[d1 < 0 ? 0 : (d1 > 127 ? 127 : d1)];
        p0[r] += (d0 < 0) ? NEG : b0;
        p1[r] += (d1 < 0) ? NEG : b1;
    }
}
__device__ __forceinline__ void partialSM(f32x16& p0, f32x16& p1, float& m_reg, float& mn, float& alpha) {
    float pmax = p0[0];
#pragma unroll
    for (int r = 1; r < 16; ++r) pmax = fmaxf(pmax, p0[r]);
#pragma unroll
    for (int r = 0; r < 16; ++r) pmax = fmaxf(pmax, p1[r]);
    { auto rr = __builtin_amdgcn_permlane32_swap(__float_as_uint(pmax), __float_as_uint(pmax), false, false);
      pmax = fmaxf(__uint_as_float(rr[0]), __uint_as_float(rr[1])); }
    if (__builtin_expect(__all((pmax - m_reg) <= THR2), 1)) { mn = m_reg; alpha = 1.f; }
    else { mn = fmaxf(m_reg, pmax); alpha = __builtin_amdgcn_exp2f(m_reg - mn); m_reg = mn; }
#pragma unroll
    for (int r = 0; r < 16; ++r) p0[r] = p0[r] - mn;
#pragma unroll
    for (int r = 0; r < 16; ++r) p1[r] = p1[r] - mn;
#pragma unroll
    for (int r = 0; r < 16; ++r) p0[r] = __builtin_amdgcn_exp2f(p0[r]);
}
__device__ __forceinline__ void finishSM(f32x16& p0, f32x16& p1, float alpha, float& l_reg, bf16x8& pa0, bf16x8& pa1, bf16x8& pa2, bf16x8& pa3) {
#pragma unroll
    for (int r = 0; r < 16; ++r) p1[r] = __builtin_amdgcn_exp2f(p1[r]);
    float ps = 0;
#pragma unroll
    for (int r = 0; r < 16; ++r) ps += p0[r];
#pragma unroll
    for (int r = 0; r < 16; ++r) ps += p1[r];
    { auto rr = __builtin_amdgcn_permlane32_swap(__float_as_uint(ps), __float_as_uint(ps), false, false);
      ps = __uint_as_float(rr[0]) + __uint_as_float(rr[1]); }
    l_reg = l_reg * alpha + ps;
#define PK4(P, B_, OUT) do { unsigned a0 = cvtpk(P[B_+0], P[B_+1]), a1 = cvtpk(P[B_+2], P[B_+3]);                          \
        unsigned b0 = cvtpk(P[B_+4], P[B_+5]), b1 = cvtpk(P[B_+6], P[B_+7]);                                             \
        auto r0 = __builtin_amdgcn_permlane32_swap(a0, b0, false, false); auto r1 = __builtin_amdgcn_permlane32_swap(a1, b1, false, false); \
        v4u w = {r0[0], r1[0], r0[1], r1[1]}; OUT = __builtin_bit_cast(bf16x8, w); } while (0)
    PK4(p0, 0, pa0); PK4(p0, 8, pa1); PK4(p1, 0, pa2); PK4(p1, 8, pa3);
}
template <int KB>
__device__ __forceinline__ void qkt(f32x16& p0, f32x16& p1, const char* K_lds, int r32, int hi, const char* qf, bool act, float init) {
    if (!act) { const float NEG = -__builtin_inff();
#pragma unroll
        for (int r = 0; r < 16; ++r) { p0[r] = NEG; p1[r] = NEG; } return; }
#pragma unroll
    for (int r = 0; r < 16; ++r) { p0[r] = init; p1[r] = init; }
    const char* kb[4];
#pragma unroll
    for (int dd = 0; dd < 4; ++dd) kb[dd] = K_lds + KB * SHM_K + KSWZ(r32, (dd * 16 + hi * 8) * 2);
#pragma unroll
    for (int d0 = 0; d0 < 8; ++d0) { const char* a = kb[d0 & 3] + (d0 >> 2) * 128;
        bf16x8 b0 = *reinterpret_cast<const bf16x8*>(a);
        bf16x8 b1 = *reinterpret_cast<const bf16x8*>(a + 32 * 256);
        const bf16x8 q = *reinterpret_cast<const bf16x8*>(qf + d0 * 1024);
        p0 = __builtin_amdgcn_mfma_f32_32x32x16_bf16(b0, q, p0, 0, 0, 0);
        p1 = __builtin_amdgcn_mfma_f32_32x32x16_bf16(b1, q, p1, 0, 0, 0); }
}
__device__ __forceinline__ void qk32(f32x16& p0, const char* tile, int r32, int hi, const char* qf) {
#pragma unroll
    for (int r = 0; r < 16; ++r) p0[r] = 0.f;
#pragma unroll
    for (int d0 = 0; d0 < 8; ++d0) { const char* a = tile + KSWZ(r32, ((d0 & 3) * 16 + hi * 8) * 2) + (d0 >> 2) * 128;
        bf16x8 b0 = *reinterpret_cast<const bf16x8*>(a);
        p0 = __builtin_amdgcn_mfma_f32_32x32x16_bf16(b0, *reinterpret_cast<const bf16x8*>(qf + d0 * 1024), p0, 0, 0, 0); }
}
template <int VB>
__device__ __forceinline__ void pv_tile(f32x16* o, int vb0, bf16x8 pa0, bf16x8 pa1, bf16x8 pa2, bf16x8 pa3, bool act) {
    if (!act) return;
#define TRRD(dst, off) asm volatile("ds_read_b64_tr_b16 %0, %1 offset:%2" : "=&v"(dst) : "v"(vb0), "i"(off) : "memory")
#define PV_D0(d0) do { s16x4 l0, l1, l2, l3, h0, h1, h2, h3; constexpr int b_ = VB * SHM_V + v_rd_off(d0, 0, 0); \
        TRRD(l0, b_); TRRD(h0, b_ + 2048); TRRD(l1, b_ + 4096); TRRD(h1, b_ + 6144); TRRD(l2, b_ + 8192); TRRD(h2, b_ + 10240); TRRD(l3, b_ + 12288); TRRD(h3, b_ + 14336); \
        asm volatile("s_waitcnt lgkmcnt(0)" ::: "memory"); SBAR(); \
        o[d0] = __builtin_amdgcn_mfma_f32_32x32x16_bf16(pa0, (bf16x8){l0[0], l0[1], l0[2], l0[3], h0[0], h0[1], h0[2], h0[3]}, o[d0], 0, 0, 0);   \
        o[d0] = __builtin_amdgcn_mfma_f32_32x32x16_bf16(pa1, (bf16x8){l1[0], l1[1], l1[2], l1[3], h1[0], h1[1], h1[2], h1[3]}, o[d0], 0, 0, 0);   \
        o[d0] = __builtin_amdgcn_mfma_f32_32x32x16_bf16(pa2, (bf16x8){l2[0], l2[1], l2[2], l2[3], h2[0], h2[1], h2[2], h2[3]}, o[d0], 0, 0, 0);   \
        o[d0] = __builtin_amdgcn_mfma_f32_32x32x16_bf16(pa3, (bf16x8){l3[0], l3[1], l3[2], l3[3], h3[0], h3[1], h3[2], h3[3]}, o[d0], 0, 0, 0); } while (0)
    PV_D0(0); PV_D0(1); PV_D0(2); PV_D0(3);
#undef PV_D0
#undef TRRD
}

__device__ __forceinline__ void moba_unit(int h, int b, const bf16* Q, const bf16* __restrict__ K, const bf16* __restrict__ V, bf16* O, const bf16* __restrict__ KBb, const float* __restrict__ rel, char* lds) {
    int tid0 = threadIdx.x; asm volatile("" : "+v"(tid0));
    const int wid = __builtin_amdgcn_readfirstlane(tid0 >> 6), lane = tid0 & 63, r32 = lane & 31, hi = lane >> 5;
    float* lut = (float*)(lds + OFF_LUT);
    char* kbar_t = lds + OFF_KBAR;
    const int NT = 4 * (b + 1);
    const int qlo = b * BLK + wid * QBLK;
    char* qf = lds + OFF_QF + wid * 8192 + lane * 16;
#define LD8(p) (*reinterpret_cast<const bf16x8*>(p))
    { bf16x8 qr[8];
#pragma unroll
      for (int d0 = 0; d0 < 8; ++d0) qr[d0] = LD8(Q + (size_t)(qlo + r32) * LD + h * D + d0 * 16 + hi * 8);
#pragma unroll
      for (int d0 = 0; d0 < 8; ++d0) *(bf16x8*)(qf + d0 * 1024) = qr[d0];
      const int sr0 = tid0 >> 4, sc0 = (tid0 & 15) * 8;
      const bf16x8 kb = LD8(KBb + ((size_t)h * NBLK + sr0) * D + sc0); *(bf16x8*)(kbar_t + KSWZ(sr0, sc0 * 2)) = kb;
      if (tid0 < 128) lut[tid0] = rel[rel_bucket(tid0) * AH + h] * LOG2E; }
    __syncthreads();
    unsigned selmask = 0u;
    if (b > 0) {
        f32x16 g0; qk32(g0, kbar_t, r32, hi, qf);
        float t1v = -__builtin_inff(), t2v = t1v, t3v = t1v; int t1n = 64, t2n = 64, t3n = 64;
#define TOP3_INS(vv, nn) do { const float v_ = (vv); const int n_ = (nn);                                         \
            const bool g1 = v_ > t1v || (v_ == t1v && n_ < t1n), g2 = v_ > t2v || (v_ == t2v && n_ < t2n), g3 = v_ > t3v || (v_ == t3v && n_ < t3n); \
            t3v = g2 ? t2v : (g3 ? v_ : t3v); t3n = g2 ? t2n : (g3 ? n_ : t3n);                                        \
            t2v = g1 ? t1v : (g2 ? v_ : t2v); t2n = g1 ? t1n : (g2 ? n_ : t2n);                                        \
            t1v = g1 ? v_ : t1v; t1n = g1 ? n_ : t1n; } while (0)
#pragma unroll
        for (int r = 0; r < 16; ++r) { const int n = crow(r, hi), on = crow(r, 1 - hi); const float ov = __shfl_xor(g0[r], 32);
            TOP3_INS(n < b ? g0[r] : -__builtin_inff(), n); TOP3_INS(on < b ? ov : -__builtin_inff(), on); }
#undef TOP3_INS
        selmask = ((t1n < 32 ? 1u << t1n : 0u) | (t2n < 32 ? 1u << t2n : 0u) | (t3n < 32 ? 1u << t3n : 0u)) & ((b >= 32) ? 0xffffffffu : ((1u << b) - 1u));
    }
    asm volatile("" : "+v"(selmask));
    int tid = threadIdx.x; asm volatile("" : "+v"(tid));
    char* V_lds = lds + OFF_V; char* K_lds = lds + OFF_K;
    float* ws = (float*)(lds + OFF_WS) + wid * 64; float* li_l = ws, * al_l = ws + 32;
    const int qm = qlo + r32 - 4 * hi;
    const int sr = tid >> 4, sc = (tid & 15) * 8, vst0 = v_st(sr, sc), vst1 = v_st(32 + sr, sc), kws = KSWZ(sr, sc * 2);
    const int vb0 = (int)(uintptr_t)V_lds + v_rd_base(tid & 63);
    const bf16* Kh = K + h * D; const bf16* Vh = V + h * D;
    bf16x8 st_v0, st_v1, st_k0, st_k1;
#define ROW(p, k0, rr) ((p) + (size_t)((k0) + (rr)) * LD + sc)
#define VMW() asm volatile("s_waitcnt vmcnt(0)" ::: "memory")
#define SLOAD_H(k0) do { st_v0 = LD8(ROW(Vh, k0, sr)); st_v1 = LD8(ROW(Vh, k0, 32 + sr)); st_k0 = LD8(ROW(Kh, k0, sr)); st_k1 = LD8(ROW(Kh, k0, 32 + sr)); } while (0)
#define SWRITE_HK(bf) do { *(bf16x8*)(K_lds + (bf) * SHM_K + kws) = st_k0; *(bf16x8*)(K_lds + (bf) * SHM_K + kws + 32 * 256) = st_k1; } while (0)
#define SWRITE_HV(bf) do { *(bf16x8*)(V_lds + (bf) * SHM_V + vst0) = st_v0; *(bf16x8*)(V_lds + (bf) * SHM_V + vst1) = st_v1; } while (0)
#define SWRITE_H(bf) do { SWRITE_HV(bf); SWRITE_HK(bf); } while (0)
    SLOAD_H(0);
    VMW(); SWRITE_HK(0);
    __syncthreads();
    unsigned wsel = selmask;
#pragma unroll
    for (int o = 1; o < 64; o <<= 1) wsel |= (unsigned)__shfl_xor((int)wsel, o);
    wsel = (unsigned)__builtin_amdgcn_readfirstlane((int)wsel);
    const float lut127 = lut[127];
    const float NEGINF = -__builtin_inff();
    float m_reg = -1e30f, l_reg = 0; f32x16 o[4] = {};
#define RESC(a) do { if (__any((a) < 1.f)) { if (hi == 0) al_l[r32] = (a); asm volatile("s_waitcnt lgkmcnt(0)" ::: "memory");              \
                     for (int d_ = 0; d_ < 4; ++d_) for (int r = 0; r < 16; ++r) o[d_][r] *= al_l[crow(r, hi)]; } } while (0)
#define KBASE(t) ((t) * KVBLK)
#define OWN(t) ((t) >= 4 * b)
#define ACT(t) (OWN(t) ? (KBASE(t) <= qlo + QBLK - 1) : (((wsel >> ((t) >> 2)) & 1u) != 0u))
#define NEAR(t) (KBASE(t) > qlo - 191)
#define INITV(t) ((OWN(t) || ((selmask >> ((t) >> 2)) & 1u)) ? (NEAR(t) ? 0.f : lut127) : NEGINF)
#define MASKT(P0_, P1_, t) do { if (ACT(t) && NEAR(t)) bias_tile(P0_, P1_, qm - KBASE(t), lut); } while (0)
    f32x16 pA0, pA1, pB0, pB1; float mnA, mnB, alA, alB; bf16x8 pa0, pa1, pa2, pa3;
    SWRITE_HV(0); SBAR();
    SLOAD_H(KBASE(1));
    SBAR(); qkt<0>(pA0, pA1, K_lds, r32, hi, qf, ACT(0), INITV(0));
    MASKT(pA0, pA1, 0); partialSM(pA0, pA1, m_reg, mnA, alA);
    VMW(); SWRITE_H(1);
    __syncthreads();
#define HALF_STEP(PX0, PX1, mnX, alX, PY0, PY1, alY, t, KB, VB, SB) do {                                                      \
        SBAR(); qkt<KB>(PX0, PX1, K_lds, r32, hi, qf, ACT(t), INITV(t));                                                       \
        finishSM(PY0, PY1, alY, l_reg, pa0, pa1, pa2, pa3); SBAR();                                                           \
        if ((t) + 1 < NT) { SLOAD_H(KBASE((t) + 1)); SBAR(); }                                                                \
        pv_tile<VB>(o, vb0, pa0, pa1, pa2, pa3, ACT((t) - 1)); MASKT(PX0, PX1, (t)); partialSM(PX0, PX1, m_reg, mnX, alX);     \
        __syncthreads();                                                                                                      \
        if ((t) + 1 < NT) { VMW(); SWRITE_H(SB); }                                                                            \
        RESC(alX); __syncthreads(); } while (0)
    for (int t = 1; t + 1 < NT; t += 2) {
        HALF_STEP(pB0, pB1, mnB, alB, pA0, pA1, alA, t, 1, 0, 0);
        HALF_STEP(pA0, pA1, mnA, alA, pB0, pB1, alB, t + 1, 0, 1, 1);
    }
    SBAR(); qkt<1>(pB0, pB1, K_lds, r32, hi, qf, ACT(NT - 1), INITV(NT - 1)); SBAR();
    finishSM(pA0, pA1, alA, l_reg, pa0, pa1, pa2, pa3); SBAR();
    pv_tile<0>(o, vb0, pa0, pa1, pa2, pa3, ACT(NT - 2));
    MASKT(pB0, pB1, NT - 1); partialSM(pB0, pB1, m_reg, mnB, alB); __syncthreads(); RESC(alB);
    finishSM(pB0, pB1, alB, l_reg, pa0, pa1, pa2, pa3); SBAR(); pv_tile<1>(o, vb0, pa0, pa1, pa2, pa3, ACT(NT - 1));
    if (hi == 0) li_l[r32] = l_reg; asm volatile("s_waitcnt lgkmcnt(0)" ::: "memory");
    float rli[16];
#pragma unroll
    for (int r = 0; r < 16; ++r) rli[r] = __builtin_amdgcn_rcpf(li_l[crow(r, hi)]);
    bf16* Ow = O + (size_t)qlo * LD + h * D;
#pragma unroll
    for (int r = 0; r < 16; ++r) { const int orow = crow(r, hi);
#pragma unroll
        for (int d0 = 0; d0 < 4; ++d0) { const float v = o[d0][r] * rli[r];
            const float vn = __shfl_xor(v, 1);
            if ((r32 & 1) == 0) *(unsigned*)(Ow + (size_t)orow * LD + d0 * 32 + r32) = cvtpk(v, vn); } }
    __syncthreads();
#undef RESC
#undef KBASE
#undef OWN
#undef ACT
#undef NEAR
#undef INITV
#undef MASKT
#undef HALF_STEP
#undef ROW
#undef LD8
#undef VMW
#undef SLOAD_H
#undef SWRITE_HK
#undef SWRITE_HV
#undef SWRITE_H
}
}

namespace ssd {
using att::crow; using att::cvtpk;
constexpr int OFF_B = 0;
constexpr int OFF_X = 65536;
constexpr int OFF_ACS = 132096;
constexpr int OFF_DT = OFF_ACS + 8192;
constexpr float LOG2E = 1.4426950408889634f;
__device__ __forceinline__ int v_st64(int k, int c) { const int kk = (k & ~0xC) | ((k & 4) << 1) | ((k & 8) >> 1); return ((kk >> 3) * 2 + (c >> 5)) * 512 + ((kk & 7) * 32 + (c & 31)) * 2; }
constexpr int v_rd_off64(int d0, int ks, int half) { return d0 * 512 + ks * 2048 + half * 1024; }

__device__ __forceinline__ void conv8(const bf16* __restrict__ XBC, int t, int ch0, const float (&w)[4][8], const float (&bs)[8], float (&out)[8]) {
#pragma unroll
    for (int e = 0; e < 8; ++e) out[e] = bs[e];
#pragma unroll
    for (int k = 0; k < 4; ++k) { const int ts = t - 3 + k;
        if (ts >= 0) { float a[8]; unpack8(*(const GAS v4u*)(XBC + (size_t)ts * DXBC + ch0), a);
#pragma unroll
            for (int e = 0; e < 8; ++e) out[e] += w[k][e] * a[e]; } }
#pragma unroll
    for (int e = 0; e < 8; ++e) out[e] = siluf(out[e]);
}
__device__ __forceinline__ void load_convw(const float* __restrict__ cw, const float* __restrict__ cb, int ch0, float (&w)[4][8], float (&bs)[8]) {
#pragma unroll
    for (int k = 0; k < 4; ++k)
#pragma unroll
        for (int e = 0; e < 8; ++e) w[k][e] = cw[k * DXBC + ch0 + e];
#pragma unroll
    for (int e = 0; e < 8; ++e) bs[e] = cb[ch0 + e];
}
__device__ __forceinline__ void conv8_lite(const bf16* __restrict__ XBC, int t, int ch0, const float* __restrict__ cw, const float* __restrict__ cb, float (&out)[8]) {
    { const f32x4 b0 = *(const GAS f32x4*)(cb + ch0), b1 = *(const GAS f32x4*)(cb + ch0 + 4); out[0] = b0[0]; out[1] = b0[1]; out[2] = b0[2]; out[3] = b0[3]; out[4] = b1[0]; out[5] = b1[1]; out[6] = b1[2]; out[7] = b1[3]; }
#pragma unroll
    for (int k = 0; k < 4; ++k) { const int ts = t - 3 + k; const float ok = ts >= 0 ? 1.f : 0.f; const int row = ts >= 0 ? ts : 0;
        float a[8]; unpack8(*(const GAS v4u*)(XBC + (size_t)row * DXBC + ch0), a);
        const f32x4 w0 = *(const GAS f32x4*)(cw + k * DXBC + ch0) * ok, w1 = *(const GAS f32x4*)(cw + k * DXBC + ch0 + 4) * ok;
        out[0] += w0[0] * a[0]; out[1] += w0[1] * a[1]; out[2] += w0[2] * a[2]; out[3] += w0[3] * a[3]; out[4] += w1[0] * a[4]; out[5] += w1[1] * a[5]; out[6] += w1[2] * a[6]; out[7] += w1[3] * a[7]; }
#pragma unroll
    for (int e = 0; e < 8; ++e) out[e] = siluf(out[e]);
}
__device__ __forceinline__ v4u pack8f(const float (&v)[8]) { v4u o; o.x = pk2(v[0], v[1]); o.y = pk2(v[2], v[3]); o.z = pk2(v[4], v[5]); o.w = pk2(v[6], v[7]); return o; }

#define SSD_TRRD(dst, base, off) asm volatile("ds_read_b64_tr_b16 %0, %1 offset:%2" : "=&v"(dst) : "v"(base), "i"(off) : "memory")
#define SSD_F8(l, h) ((bf16x8){l[0], l[1], l[2], l[3], h[0], h[1], h[2], h[3]})

__device__ __forceinline__ void states_unit(int c, int g, const Args& A, char* lds) {
    int tid = threadIdx.x; asm volatile("" : "+v"(tid));
    const int wid = __builtin_amdgcn_readfirstlane(tid >> 6), lane = tid & 63, r32 = lane & 31, hi = lane >> 5;
    unsigned char* ws = A.ws;
    const bf16* XBC = (const bf16*)(ws + WS_XBC); const float* DT = (const float*)(ws + WS_DT); float* ACS = (float*)(ws + WS_ACS); float* ST = (float*)(ws + WS_STATES);
    const float* cw = A.in[I_SCW]; const float* cb = A.in[I_SCB];
    float* acs_s = (float*)(lds + OFF_ACS); float* dt_s = (float*)(lds + OFF_DT);
    bf16* BCC = (bf16*)(ws + WS_BCC); bf16* XC = (bf16*)A.out;
    const int t0 = c * CHK;
    { const int head = g * 8 + wid; const float Aneg = -__expf(A.in[I_ALOG][head]);
      float d[4], a[4];
#pragma unroll
      for (int i = 0; i < 4; ++i) d[i] = DT[(size_t)(t0 + 4 * lane + i) * NHS + head];
      a[0] = d[0] * Aneg; a[1] = a[0] + d[1] * Aneg; a[2] = a[1] + d[2] * Aneg; a[3] = a[2] + d[3] * Aneg;
      float incl = a[3];
#pragma unroll
      for (int o = 1; o < 64; o <<= 1) { const float v = __shfl_up(incl, o); if (lane >= o) incl += v; }
      const float excl = incl - a[3];
#pragma unroll
      for (int i = 0; i < 4; ++i) { const float v = a[i] + excl; acs_s[(4 * lane + i) * 8 + wid] = v; dt_s[(4 * lane + i) * 8 + wid] = d[i]; ACS[(size_t)(t0 + 4 * lane + i) * NHS + head] = v; } }
    { float w[4][8], bs[8]; const int ch0 = DI + g * NST + (tid & 15) * 8; load_convw(cw, cb, ch0, w, bs);
      for (int i = 0; i < 8; ++i) { const int l = (tid >> 4) + 32 * i; float v[8]; conv8(XBC, t0 + l, ch0, w, bs, v); const v4u pk = pack8f(v);
          *(v4u*)(lds + OFF_B + (l >> 6) * 16384 + att::v_st(l & 63, (tid & 15) * 8)) = pk;
          *(GAS v4u*)(BCC + (size_t)(t0 + l) * 2048 + g * NST + (tid & 15) * 8) = pk; } }
    { float w[4][8], bs[8]; const int ch0 = DI + NG * NST + g * NST + (tid & 15) * 8; load_convw(cw, cb, ch0, w, bs);
      for (int i = 0; i < 8; ++i) { const int l = (tid >> 4) + 32 * i; float v[8]; conv8(XBC, t0 + l, ch0, w, bs, v);
          *(GAS v4u*)(BCC + (size_t)(t0 + l) * 2048 + 1024 + g * NST + (tid & 15) * 8) = pack8f(v); } }
    __syncthreads();
    const int mb = wid & 1, nb = wid >> 1;
    const int rdb = att::v_rd_base(lane);
    for (int r = 0; r < 8; ++r) {
        const int head = g * 8 + r; char* xs = lds + OFF_X + (r & 1) * 32768;
        { float w[4][8], bs[8]; const int ch0 = head * HP + (tid & 7) * 8; load_convw(cw, cb, ch0, w, bs);
          const float alast = acs_s[255 * 8 + r];
#pragma unroll
          for (int i = 0; i < 4; ++i) { const int l = (tid >> 3) + 64 * i; float v[8]; conv8(XBC, t0 + l, ch0, w, bs, v);
              const float dtl = dt_s[l * 8 + r], f = __expf(alast - acs_s[l * 8 + r]);
#pragma unroll
              for (int e = 0; e < 8; ++e) v[e] *= dtl;
              *(GAS v4u*)(XC + (size_t)(t0 + l) * DI + ch0) = pack8f(v);
#pragma unroll
              for (int e = 0; e < 8; ++e) v[e] *= f;
              *(v4u*)(xs + i * 8192 + v_st64(l & 63, (tid & 7) * 8)) = pack8f(v); } }
        __syncthreads();
        f32x16 acc = {};
        const int xb = (int)(uintptr_t)xs + rdb, bb = (int)(uintptr_t)(lds + OFF_B) + rdb;
#pragma unroll
        for (int tl = 0; tl < 4; ++tl) {
            const int xbt = xb + tl * 8192 + mb * 512, bbt = bb + tl * 16384 + nb * 512;
#define ST_KS(ks) do { s16x4 al, ah, bl, bh; \
            SSD_TRRD(al, xbt, (ks) * 2048); SSD_TRRD(ah, xbt, (ks) * 2048 + 1024); \
            SSD_TRRD(bl, bbt, (ks) * 4096); SSD_TRRD(bh, bbt, (ks) * 4096 + 2048); \
            asm volatile("s_waitcnt lgkmcnt(0)" ::: "memory"); __builtin_amdgcn_sched_barrier(0); \
            acc = __builtin_amdgcn_mfma_f32_32x32x16_bf16(SSD_F8(al, ah), SSD_F8(bl, bh), acc, 0, 0, 0); } while (0)
            ST_KS(0); ST_KS(1); ST_KS(2); ST_KS(3);
#undef ST_KS
        }
        float* so = ST + (((size_t)c * NHS + head) * HP + mb * 32) * NST + nb * 32 + r32;
#pragma unroll
        for (int q = 0; q < 16; ++q) so[(size_t)crow(q, hi) * NST] = acc[q];
    }
    __syncthreads();
}
__device__ __forceinline__ void ssd_states_phase(Frame& F, const Args& A, char* lds) {
    for (int u = F.vcu; u < NCH * NG; u += F.G) states_unit(u >> 3, u & 7, A, lds);
}

__device__ __forceinline__ void ssd_scan_phase(Frame& F, const Args& A) {
    unsigned char* ws = A.ws;
    float* ST = (float*)(ws + WS_STATES); const float* ACS = (const float*)(ws + WS_ACS);
    constexpr int PER = NHS * HP * NST;
    for (int e4 = F.vcu * NTHR + F.tid; e4 < PER / 4; e4 += F.G * NTHR) {
        const int head = (e4 * 4) / (HP * NST);
        f32x4 h = {0.f, 0.f, 0.f, 0.f};
        f32x4 s[8];
#pragma unroll
        for (int j = 0; j < 8; ++j) s[j] = *(const GAS f32x4*)(ST + (size_t)j * PER + (size_t)e4 * 4);
        for (int c0 = 0; c0 < NCH; c0 += 8) {
#pragma unroll
            for (int j = 0; j < 8; ++j) { const int c = c0 + j;
                *(GAS f32x4*)(ST + (size_t)c * PER + (size_t)e4 * 4) = h;
                const float dec = __expf(ACS[(size_t)(c * CHK + CHK - 1) * NHS + head]);
                h = h * dec + s[j];
                if (c + 8 < NCH) s[j] = *(const GAS f32x4*)(ST + (size_t)(c + 8) * PER + (size_t)e4 * 4); }
        }
    }
}

__device__ __forceinline__ void cb_tile(f32x16& p0, f32x16& p1, const char* Kt, int r32, int hi, const bf16x8* qr) {
#pragma unroll
    for (int r = 0; r < 16; ++r) { p0[r] = 0.f; p1[r] = 0.f; }
#pragma unroll
    for (int d0 = 0; d0 < 8; ++d0) { const char* a = Kt + KSWZ(r32, ((d0 & 3) * 16 + hi * 8) * 2) + (d0 >> 2) * 128;
        const bf16x8 b0 = *reinterpret_cast<const bf16x8*>(a), b1 = *reinterpret_cast<const bf16x8*>(a + 32 * 256);
        p0 = __builtin_amdgcn_mfma_f32_32x32x16_bf16(b0, qr[d0], p0, 0, 0, 0);
        p1 = __builtin_amdgcn_mfma_f32_32x32x16_bf16(b1, qr[d0], p1, 0, 0, 0); }
}
__device__ __forceinline__ void out_unit(int c, int g, const Args& A, char* lds) {
    int tid = threadIdx.x; asm volatile("" : "+v"(tid));
    const int wid = __builtin_amdgcn_readfirstlane(tid >> 6), lane = tid & 63, r32 = lane & 31, hi = lane >> 5;
    unsigned char* ws = A.ws;
    const bf16* Z = (const bf16*)(ws + WS_Z); const float* DT = (const float*)(ws + WS_DT); const float* ACS = (const float*)(ws + WS_ACS);
    const float* HPV = (const float*)(ws + WS_STATES); bf16* YG = (bf16*)(ws + WS_YG);
    const bf16* BCC = (const bf16*)(ws + WS_BCC); const bf16* XC = (const bf16*)A.out;
    float* acs_s = (float*)(lds + OFF_ACS); float* dt_s = (float*)(lds + OFF_DT);
    const int t0 = c * CHK;
    for (int i = tid; i < CHK * 8; i += NTHR) { const int l = i >> 3, r = i & 7; acs_s[i] = ACS[(size_t)(t0 + l) * NHS + g * 8 + r] * LOG2E; dt_s[i] = DT[(size_t)(t0 + l) * NHS + g * 8 + r]; }
    { for (int i = 0; i < 8; ++i) { const int l = (tid >> 4) + 32 * i;
          *(v4u*)(lds + OFF_B + (l >> 6) * 16384 + KSWZ(l & 63, (tid & 15) * 16)) = *(const GAS v4u*)(BCC + (size_t)(t0 + l) * 2048 + g * NST + (tid & 15) * 8); } }
    bf16x8 qr[8];
    { const int l = wid * 32 + r32;
#pragma unroll
      for (int d0 = 0; d0 < 8; ++d0) qr[d0] = *reinterpret_cast<const bf16x8*>(BCC + (size_t)(t0 + l) * 2048 + 1024 + g * NST + d0 * 16 + hi * 8); }
    const int lrow = wid * 32 + r32;
    const int nt = (wid >> 1) + 1;
    const int rdb = att::v_rd_base(lane);
    float ssq[16];
#pragma unroll
    for (int q = 0; q < 16; ++q) ssq[q] = 0.f;
    auto stage_x = [&](int r) {
        const int head = g * 8 + r; char* xs = lds + OFF_X + (r & 1) * 32768;
#pragma unroll
        for (int i = 0; i < 4; ++i) { const int l = (tid >> 3) + 64 * i;
            *(v4u*)(xs + i * 8192 + v_st64(l & 63, (tid & 7) * 8)) = *(const GAS v4u*)(XC + (size_t)(t0 + l) * DI + head * HP + (tid & 7) * 8); } };
    stage_x(0);
    __syncthreads();
    for (int r = 0; r < 8; ++r) {
        const int head = g * 8 + r; const char* xs = lds + OFF_X + (r & 1) * 32768;
        if (r + 1 < 8) stage_x(r + 1);
        const float a2l = acs_s[lrow * 8 + r];
        f32x16 o[2] = {};
        { const float el = __builtin_amdgcn_exp2f(a2l);
          const float* hp = HPV + ((size_t)c * NHS + head) * HP * NST;
#pragma unroll
          for (int d0 = 0; d0 < 8; ++d0) { float cv[8]; unpack8(__builtin_bit_cast(v4u, qr[d0]), cv);
#pragma unroll
              for (int e = 0; e < 8; ++e) cv[e] *= el;
              const bf16x8 af = __builtin_bit_cast(bf16x8, pack8f(cv));
              const float* h0 = hp + (size_t)r32 * NST + d0 * 16 + hi * 8; const float* h1 = h0 + 32 * NST;
              const f32x4 h00 = *(const GAS f32x4*)h0, h01 = *(const GAS f32x4*)(h0 + 4), h10 = *(const GAS f32x4*)h1, h11 = *(const GAS f32x4*)(h1 + 4);
              v4u w0, w1; w0.x = cvtpk(h00[0], h00[1]); w0.y = cvtpk(h00[2], h00[3]); w0.z = cvtpk(h01[0], h01[1]); w0.w = cvtpk(h01[2], h01[3]);
              w1.x = cvtpk(h10[0], h10[1]); w1.y = cvtpk(h10[2], h10[3]); w1.z = cvtpk(h11[0], h11[1]); w1.w = cvtpk(h11[2], h11[3]);
              const bf16x8 b0 = __builtin_bit_cast(bf16x8, w0), b1 = __builtin_bit_cast(bf16x8, w1);
              o[0] = __builtin_amdgcn_mfma_f32_32x32x16_bf16(af, b0, o[0], 0, 0, 0);
              o[1] = __builtin_amdgcn_mfma_f32_32x32x16_bf16(af, b1, o[1], 0, 0, 0); } }
        const float dskip = A.in[I_SD][head] / dt_s[lrow * 8 + r];
        for (int t = 0; t < nt; ++t) {
            f32x16 p0, p1; cb_tile(p0, p1, lds + OFF_B + t * 16384, r32, hi, qr);
            const int dq = lrow - t * 64 - 4 * hi;
#pragma unroll
            for (int q = 0; q < 16; ++q) { const int cc = (q & 3) + 8 * (q >> 2); const int s0 = t * 64 + cc + 4 * hi;
                const float e0 = __builtin_amdgcn_exp2f(a2l - acs_s[s0 * 8 + r]), e1 = __builtin_amdgcn_exp2f(a2l - acs_s[(s0 + 32) * 8 + r]);
                float v0 = p0[q] * e0, v1 = p1[q] * e1;
                v0 = (cc > dq) ? 0.f : v0; v1 = (cc + 32 > dq) ? 0.f : v1;
                v0 += (cc == dq) ? dskip : 0.f; v1 += (cc + 32 == dq) ? dskip : 0.f;
                p0[q] = v0; p1[q] = v1; }
            bf16x8 pa0, pa1, pa2, pa3;
            PK4(p0, 0, pa0); PK4(p0, 8, pa1); PK4(p1, 0, pa2); PK4(p1, 8, pa3);
            const int xb = (int)(uintptr_t)xs + rdb + t * 8192;
#define PV64(d0) do { s16x4 l0, l1, l2, l3, h0, h1, h2, h3; \
            SSD_TRRD(l0, xb, v_rd_off64(d0, 0, 0)); SSD_TRRD(h0, xb, v_rd_off64(d0, 0, 1)); SSD_TRRD(l1, xb, v_rd_off64(d0, 1, 0)); SSD_TRRD(h1, xb, v_rd_off64(d0, 1, 1)); \
            SSD_TRRD(l2, xb, v_rd_off64(d0, 2, 0)); SSD_TRRD(h2, xb, v_rd_off64(d0, 2, 1)); SSD_TRRD(l3, xb, v_rd_off64(d0, 3, 0)); SSD_TRRD(h3, xb, v_rd_off64(d0, 3, 1)); \
            asm volatile("s_waitcnt lgkmcnt(0)" ::: "memory"); __builtin_amdgcn_sched_barrier(0); \
            o[d0] = __builtin_amdgcn_mfma_f32_32x32x16_bf16(pa0, SSD_F8(l0, h0), o[d0], 0, 0, 0); o[d0] = __builtin_amdgcn_mfma_f32_32x32x16_bf16(pa1, SSD_F8(l1, h1), o[d0], 0, 0, 0); \
            o[d0] = __builtin_amdgcn_mfma_f32_32x32x16_bf16(pa2, SSD_F8(l2, h2), o[d0], 0, 0, 0); o[d0] = __builtin_amdgcn_mfma_f32_32x32x16_bf16(pa3, SSD_F8(l3, h3), o[d0], 0, 0, 0); } while (0)
            PV64(0); PV64(1);
#undef PV64
        }
#pragma unroll
        for (int q = 0; q < 16; ++q) { const int l = wid * 32 + crow(q, hi); const size_t off = (size_t)(t0 + l) * DI + head * HP + r32;
#pragma unroll
            for (int d0 = 0; d0 < 2; ++d0) { const float zv = bf2f(Z[off + d0 * 32]); const float v = o[d0][q] * siluf(zv); ssq[q] += v * v;
                const float vn = __shfl_xor(v, 1);
                if ((r32 & 1) == 0) *(unsigned*)(YG + off + d0 * 32) = cvtpk(v, vn); } }
        __syncthreads();
    }
    float* rs_s = (float*)(lds + OFF_X) + wid * 32;
#pragma unroll
    for (int q = 0; q < 16; ++q) { float s = ssq[q]; s += __shfl_xor(s, 1); s += __shfl_xor(s, 2); s += __shfl_xor(s, 4); s += __shfl_xor(s, 8); s += __shfl_xor(s, 16);
        if (r32 == 0) rs_s[crow(q, hi)] = 1.0f / sqrtf(s * (1.0f / 512.f) + EPS); }
    asm volatile("s_waitcnt vmcnt(0) lgkmcnt(0)" ::: "memory");
    { const float* nw = A.in[I_SNW] + g * 512 + lane * 8; float nwv[8];
#pragma unroll
      for (int e = 0; e < 8; ++e) nwv[e] = nw[e];
      for (int rr = 0; rr < 32; ++rr) { const float rsv = rs_s[rr]; bf16* p = YG + (size_t)(t0 + wid * 32 + rr) * DI + g * 512 + lane * 8;
          float v[8]; unpack8(*(const GAS v4u*)p, v);
#pragma unroll
          for (int e = 0; e < 8; ++e) v[e] *= rsv * nwv[e];
          *(GAS v4u*)p = pack8f(v); } }
    __syncthreads();
}
__device__ __forceinline__ void ssd_out_phase(Frame& F, const Args& A, char* lds) {
    for (int u = F.vcu; u < NCH * NG; u += F.G) out_unit(u >> 3, u & 7, A, lds);
}
#undef SSD_TRRD
#undef SSD_F8
}

__device__ __forceinline__ void attn_phase(Frame& F, const Args& A, char* lds_generic) {
    unsigned char* ws = A.ws;
    for (int u = F.vcu; u < AH * 16; u += F.G) {
        const int h = u >> 4, p = u & 15;
        att::moba_unit(h, 31 - p, (const bf16*)(ws + WS_Q), (const bf16*)(ws + WS_K), (const bf16*)(ws + WS_V), (bf16*)(ws + WS_Q), (const bf16*)(ws + WS_KBARB), A.in[I_REL], lds_generic);
        att::moba_unit(h, p, (const bf16*)(ws + WS_Q), (const bf16*)(ws + WS_K), (const bf16*)(ws + WS_V), (bf16*)(ws + WS_Q), (const bf16*)(ws + WS_KBARB), A.in[I_REL], lds_generic);
    }
}

__global__ void diag_cmp(const bf16* __restrict__ a, const bf16* __restrict__ b, size_t n, unsigned* stat) {
    float md = 0.f, mb = 0.f;
    for (size_t i = (size_t)blockIdx.x * blockDim.x + threadIdx.x; i < n; i += (size_t)gridDim.x * blockDim.x) { const float x = bf2f(a[i]), y = bf2f(b[i]); const float d = fabsf(x - y); md = (d > md || d != d) ? d : md; mb = fmaxf(mb, fabsf(y)); }
    if (md != md) md = 1e30f;
    atomicMax(stat, __float_as_uint(md)); atomicMax(stat + 1, __float_as_uint(mb));
    float sd = 0.f, cnt = 0.f;
    for (size_t i = (size_t)blockIdx.x * blockDim.x + threadIdx.x; i < n; i += (size_t)gridDim.x * blockDim.x) { const float d = fabsf(bf2f(a[i]) - bf2f(b[i])); sd += d; cnt += (d > 0.02f) ? 1.f : 0.f; }
    sd = wave_sum(sd); cnt = wave_sum(cnt);
    if ((threadIdx.x & 63) == 0) { atomicAdd((float*)(stat + 2), sd); atomicAdd((float*)(stat + 3), cnt); }
}
__global__ void diag_emit(const unsigned* stat, float* out, float scale, int which) {
    if (threadIdx.x == 0 && blockIdx.x == 0) out[0] = __uint_as_float(stat[which]) * scale;
}

__global__ void __launch_bounds__(NTHR, 2) mk_fwd(Args args) {
    extern __shared__ __attribute__((aligned(16))) unsigned char lds[];
    Frame F;
    F.lds = (LAS unsigned char*)lds;
    volatile LAS unsigned* MISC = (volatile LAS unsigned*)(F.lds + MISC_OFF);
    F.tid = threadIdx.x; F.lane = F.tid & 63; F.wave = __builtin_amdgcn_readfirstlane(F.tid >> 6);
    F.G = gridDim.x; { const int bx = blockIdx.x; F.vcu = (F.G % 8 == 0) ? (bx % 8) * (F.G / 8) + bx / 8 : bx; }
    unsigned char* ws = args.ws;
    gu32* ctl = (gu32*)(ws + WS_CTL);
    for (int u = F.tid; u < (LDS_BYTES - LDSCTL_OFF) / 4; u += NTHR) ((LAS unsigned*)(F.lds + LDSCTL_OFF))[u] = 0u;
    __syncthreads();
    const int lo = args.ph_lo, hi = args.ph_hi;
    const bool multi = (hi - lo) > 1;
    XcdBarrier bar; bar.bar = (unsigned*)(ctl + CW_BAR) + args.li * XCD_BAR_WORDS; bar.x = 0; bar.st = nullptr;
    if (multi) bar = xcd_barrier_post((unsigned*)(ctl + CW_BAR) + args.li * XCD_BAR_WORDS, MISC + 8);
#define IN(k) (lo <= (k) && (k) < hi)
#define SEAM(k) do { if (IN(k) && IN((k) + 1)) xcd_barrier(bar); } while (0)

    if (IN(0)) { p0_prologue(F, args); SEAM(0); }
    if (IN(1)) {
        pg8::Gemm g{(const bf16*)(ws + WS_XB), (const bf16*)(ws + WS_WIN), SEQ, NIN, DM}; pg8::StaticOrder S; S.init(SEQ, NIN, F.G, (int)blockIdx.x);
        pg8::EpiInProj E{(bf16*)(ws + WS_Z), (bf16*)(ws + WS_XBC), (bf16*)(ws + WS_Q), (bf16*)(ws + WS_K), (bf16*)(ws + WS_V), (bf16*)(ws + WS_GT), (const float*)(ws + WS_R1), args.in[I_BG]};
        pg8::gemm_phase<pg8::EpiInProj, pg8::StaticOrder, true, true>(F.lds + RING_OFF, g, S, E);
        dt_phase(F, args);
        SEAM(1);
    }
    if (IN(2)) { attn_prep_phase(F, args); __syncthreads(); ssd::ssd_states_phase(F, args, (char*)lds); SEAM(2); }
    if (IN(3)) { ssd::ssd_scan_phase(F, args); attn_phase(F, args, (char*)lds); SEAM(3); }
    if (IN(4)) { ssd::ssd_out_phase(F, args, (char*)lds); SEAM(4); }
    if (IN(5)) {
        { pg8::Gemm g{(const bf16*)(ws + WS_YG), (const bf16*)(ws + WS_WSS), SEQ, DM, DI}; pg8::StaticOrder S; S.init(SEQ, DM, F.G, (int)blockIdx.x);
          pg8::EpiGateF32 E{args.out, (const bf16*)(ws + WS_GT), 0};
          pg8::gemm_phase<pg8::EpiGateF32, pg8::StaticOrder, true, true>(F.lds + RING_OFF, g, S, E); }
        { pg8::Gemm g{(const bf16*)(ws + WS_Q), (const bf16*)(ws + WS_WAT), SEQ, DM, DA}; pg8::StaticOrder S; S.init(SEQ, DM, F.G, (int)blockIdx.x);
          pg8::EpiGateAddBf16 E{args.out, (const bf16*)(ws + WS_GT), DM, (bf16*)(ws + WS_XB)};
          pg8::gemm_phase<pg8::EpiGateAddBf16, pg8::StaticOrder, true, true>(F.lds + RING_OFF, g, S, E); }
        SEAM(5);
    }
    if (IN(6)) {
        pg8::Gemm g{(const bf16*)(ws + WS_XB), (const bf16*)(ws + WS_WOUT), SEQ, DM, DM}; pg8::StaticOrder S; S.init(SEQ, DM, F.G, (int)blockIdx.x);
        pg8::EpiResid1 E{args.in[I_X], args.out, (bf16*)(ws + WS_K), (float*)(ws + WS_SS2)};
        pg8::gemm_phase<pg8::EpiResid1, pg8::StaticOrder, true, true>(F.lds + RING_OFF, g, S, E);
        SEAM(6);
    }
    if (IN(7)) {
        pg8::Gemm g{(const bf16*)(ws + WS_K), (const bf16*)(ws + WS_WUP), SEQ, DFF2, DM}; pg8::StaticOrder S; S.init(SEQ, DFF2, F.G, (int)blockIdx.x);
        pg8::EpiUpPre E{(bf16*)(ws + WS_UPRE), (const float*)(ws + WS_SS2)};
        pg8::gemm_phase<pg8::EpiUpPre, pg8::StaticOrder, true, true>(F.lds + RING_OFF, g, S, E);
        SEAM(7);
    }
    if (IN(8)) { ffn_act_phase(F, args); SEAM(8); }
    if (IN(9)) {
        pg8::Gemm g{(const bf16*)(ws + WS_ACT), (const bf16*)(ws + WS_WDN), SEQ, DM, DFF}; pg8::StaticOrder S; S.init(SEQ, DM, F.G, (int)blockIdx.x);
        pg8::EpiResid2 E{args.out};
        pg8::gemm_phase<pg8::EpiResid2, pg8::StaticOrder, true, true>(F.lds + RING_OFF, g, S, E);
    }
#undef IN
#undef SEAM
}

extern "C" void kernel_launch(void* const* d_in, const int* in_sizes, int n_in, void* d_out, int out_size, void* d_ws, size_t ws_size, hipStream_t stream) {
    static int grid = 0;
    if (grid == 0) {
        if (n_in != N_INPUTS || in_sizes[0] != SEQ * DM || out_size != SEQ * DM || ws_size < WS_END) {
            fprintf(stderr, "kernel_launch: unexpected shapes: n_in %d in0 %d out %d ws %zu (need %zu)\n", n_in, n_in > 0 ? in_sizes[0] : -1, out_size, ws_size, (size_t)WS_END); grid = -1; return; }
        int dev = 0, cus = 0;
        if (hipGetDevice(&dev) != hipSuccess || hipDeviceGetAttribute(&cus, hipDeviceAttributeMultiprocessorCount, dev) != hipSuccess) { grid = -1; return; }
        if (hipFuncSetAttribute((const void*)mk_fwd, hipFuncAttributeMaxDynamicSharedMemorySize, LDS_BYTES) != hipSuccess) { fprintf(stderr, "kernel_launch: hipFuncSetAttribute failed\n"); grid = -1; return; }
        (void)hipGetLastError();
        grid = cus;
    }
    if (grid < 0) return;
    (void)hipMemsetAsync((char*)d_ws + WS_CTL, 0, CTL_ZERO_BYTES, stream);
    Args a{};
    for (int i = 0; i < N_INPUTS; ++i) a.in[i] = (const float*)d_in[i];
    a.out = (float*)d_out; a.ws = (unsigned char*)d_ws;
    unsigned char* ws = (unsigned char*)d_ws;
    auto launch = [&](int lo, int hi, int li) { a.ph_lo = lo; a.ph_hi = hi; a.li = li; a.pad = 0; hipLaunchKernelGGL(mk_fwd, dim3(grid), dim3(NTHR), LDS_BYTES, stream, a); };
#if MK_VARIANT == 4 || MK_VARIANT == 5
    launch(0, 1, 0); launch(1, 2, 0); launch(2, 3, 0); launch(3, 4, 0); launch(4, 5, 0);
#if MK_VARIANT == 5
    (void)hipMemsetAsync(ws + WS_CTL + 1024, 0, 64, stream);
    naive_ssd<<<NG, 512, 0, stream>>>((const bf16*)(ws + WS_XBC), (const bf16*)(ws + WS_Z), (const float*)(ws + WS_DT), a.in[I_SCW], a.in[I_SCB], a.in[I_ALOG], a.in[I_SD], a.in[I_SNW], (bf16*)d_out);
    diag_cmp<<<1024, 256, 0, stream>>>((const bf16*)(ws + WS_YG), (const bf16*)d_out, (size_t)SEQ * DI, (unsigned*)(ws + WS_CTL + 1024));
#endif
    launch(5, 6, 0); launch(6, 7, 0); launch(7, 8, 0); launch(8, 9, 0); launch(9, 10, 0);
#if MK_VARIANT == 5
    diag_emit<<<1, 64, 0, stream>>>((const unsigned*)(ws + WS_CTL + 1024), (float*)d_out, DIAG_SCALE, DIAG_WHICH);
#endif
#endif
#if MK_VARIANT == 2 || MK_VARIANT == 3
    launch(0, 1, 0); launch(1, 2, 0); launch(2, 3, 0);
#if MK_VARIANT == 3
    (void)hipMemsetAsync(ws + WS_CTL + 1024, 0, 64, stream);
    naive_attn<<<SEQ * AH / 4, 256, 0, stream>>>((const bf16*)(ws + WS_Q), (const bf16*)(ws + WS_K), (const bf16*)(ws + WS_V), (const bf16*)(ws + WS_KBARB), a.in[I_REL], (bf16*)(ws + WS_XB));
#endif
    launch(3, 4, 0);
    naive_ssd<<<NG, 512, 0, stream>>>((const bf16*)(ws + WS_XBC), (const bf16*)(ws + WS_Z), (const float*)(ws + WS_DT), a.in[I_SCW], a.in[I_SCB], a.in[I_ALOG], a.in[I_SD], a.in[I_SNW], (bf16*)(ws + WS_YG));
#if MK_VARIANT == 3
    diag_cmp<<<1024, 256, 0, stream>>>((const bf16*)(ws + WS_Q), (const bf16*)(ws + WS_XB), (size_t)SEQ * DA, (unsigned*)(ws + WS_CTL + 1024));
#endif
    launch(5, 6, 0); launch(6, 7, 0); launch(7, 8, 0); launch(8, 9, 0); launch(9, 10, 0);
#if MK_VARIANT == 3
    diag_emit<<<1, 64, 0, stream>>>((const unsigned*)(ws + WS_CTL + 1024), (float*)d_out, DIAG_SCALE, DIAG_WHICH);
#endif
#endif
#if MK_VARIANT == 1
    launch(0, 1, 0); launch(1, 2, 0); launch(2, 3, 0);
    naive_attn<<<SEQ * AH / 4, 256, 0, stream>>>((const bf16*)(ws + WS_Q), (const bf16*)(ws + WS_K), (const bf16*)(ws + WS_V), (const bf16*)(ws + WS_KBARB), a.in[I_REL], (bf16*)(ws + WS_Q));
    naive_ssd<<<NG, 512, 0, stream>>>((const bf16*)(ws + WS_XBC), (const bf16*)(ws + WS_Z), (const float*)(ws + WS_DT), a.in[I_SCW], a.in[I_SCB], a.in[I_ALOG], a.in[I_SD], a.in[I_SNW], (bf16*)(ws + WS_YG));
    launch(5, 6, 0); launch(6, 7, 0); launch(7, 8, 0); launch(8, 9, 0); launch(9, 10, 0);
#endif
}
```

```cpp
#define MK_VARIANT 6
#define DIAG_SCALE 100000.0f
#define DIAG_WHICH 0
#include <hip/hip_runtime.h>
#include <cstdio>
#include <cstdint>
namespace pg8 {
#define PG8_LAS __attribute__((address_space(3)))
typedef unsigned short bf16_t;
typedef short bf16x8 __attribute__((ext_vector_type(8)));
typedef float f32x4 __attribute__((ext_vector_type(4)));
typedef unsigned u32x4 __attribute__((ext_vector_type(4)));
constexpr int BM = 256, BK = 64, HALF = 128, HTB = HALF * BK * 2  , STAGE_BYTES = 8 * HTB, NXCD = 8, WGM = 8;

__host__ __device__ __forceinline__ int lds_byte(int r, int c) { const int st = (r >> 4) * 2 + (c >> 5), rr = r & 15, cc = c & 31, ob = rr * 64 + cc * 2; return st * 1024 + (ob ^ (((ob >> 9) & 1) << 5)); }
__host__ __device__ __forceinline__ void stage_rc(int b, int& R, int& C) { const int st = b / 1024, sb = b % 1024, swz = sb ^ (((sb >> 9) & 1) << 5); R = (st >> 1) * 16 + swz / 64; C = (st & 1) * 32 + (swz % 64) / 2; }
__host__ __device__ __forceinline__ int perm32(int rho) { const int n = rho >> 4, i = rho & 15; return 8 * (i >> 2) + 4 * n + (i & 3); }

struct Unit { int pm, pn; };
struct Gemm { const bf16_t* A; const bf16_t* Bt; int M, N, K; };

struct StaticOrder {
    int nM, nN, nwg, G, c;
    __host__ __device__ void init(int M, int N, int G_, int c_) { nM = M / BM; nN = N / BM; nwg = nM * nN; G = G_; c = c_; }
    __host__ __device__ bool next(int i, Unit& u) const {
        const long L = (long)i * G + c; if (L >= nwg) return false;
        int wgid = (int)L; { const int q = nwg / NXCD, r = nwg % NXCD, xcd = wgid % NXCD, off = wgid / NXCD; wgid = (xcd < r ? xcd * (q + 1) : r * (q + 1) + (xcd - r) * q) + off; }
        const int nig = WGM * nN, gid = wgid / nig, fm = gid * WGM, gsz = (nM - fm) < WGM ? (nM - fm) : WGM;
        u.pm = fm + ((wgid % nig) % gsz); u.pn = (wgid % nig) / gsz; return true;
    }
    __device__ __forceinline__ void a_ready(const Unit&) const {}
    __device__ __forceinline__ void done(const Unit&) const {}
};

__device__ __forceinline__ unsigned cvt_pk_bf16(float lo, float hi) { unsigned r; asm volatile("v_cvt_pk_bf16_f32 %0, %1, %2" : "=v"(r) : "v"(lo), "v"(hi)); return r; }
typedef float f32x2 __attribute__((ext_vector_type(2)));
template <class Epi, class Sched, bool ALIGN_EPI = false, bool SP2 = false>
__device__ __forceinline__ void gemm_phase(PG8_LAS unsigned char* lds, const Gemm g, const Sched& S, const Epi& E) {
    const int tid = threadIdx.x, wid = __builtin_amdgcn_readfirstlane(tid >> 6), lane = tid & 63, wr = wid >> 2, wc = wid & 3, fr = lane & 15, fq = lane >> 4;
    const int K = g.K, nt = K / BK;
    unsigned voffA[2], voffB[2];
#pragma unroll
    for (int i = 0; i < 2; ++i) { int R, C; stage_rc(tid * 16 + i * 8192, R, C); const int Rb = Epi::PERM ? ((R & ~31) + perm32(R & 31)) : R;
        voffA[i] = (unsigned)(R * K + C) * 2u; voffB[i] = (unsigned)(Rb * K + C) * 2u; }
    const size_t kstep = (size_t)(BK * 2);
    const size_t hstep = (size_t)HALF * K * 2;
    const size_t tstep = 2 * hstep;
    const unsigned ldsw = (unsigned)wid * 1024u;
    const int aoff = lds_byte(wr * 64 + fr, fq * 8), boff = lds_byte(wc * 32 + fr, fq * 8);
#define PG8_SA(b, h) (((b) * 2 + (h)) * HTB)
#define PG8_SB(b, h) ((4 + (b) * 2 + (h)) * HTB)
#define PG8_STAGE(bufoff, gbase, voff) do { _Pragma("unroll") for (int _i = 0; _i < 2; ++_i) \
        __builtin_amdgcn_global_load_lds((const unsigned*)((const char*)(gbase) + (voff)[_i]), (PG8_LAS unsigned*)(lds + (bufoff) + ldsw + _i * 8192), 16, 0, 0); } while (0)
#define PG8_LDA(dst, b, h) do { _Pragma("unroll") for (int m = 0; m < 4; ++m) _Pragma("unroll") for (int k = 0; k < 2; ++k) dst[m][k] = *(const PG8_LAS bf16x8*)(lds + PG8_SA(b, h) + aoff + m * 2048 + k * 1024); } while (0)
#define PG8_LDB(dst, b, h) do { _Pragma("unroll") for (int n = 0; n < 2; ++n) _Pragma("unroll") for (int k = 0; k < 2; ++k) dst[n][k] = *(const PG8_LAS bf16x8*)(lds + PG8_SB(b, h) + boff + n * 2048 + k * 1024); } while (0)
#define PG8_MMA(ai, bj, At, Bt) do { __builtin_amdgcn_s_setprio(1); _Pragma("unroll") for (int m = 0; m < 4; ++m) _Pragma("unroll") for (int n = 0; n < 2; ++n) _Pragma("unroll") for (int k = 0; k < 2; ++k) \
        acc[ai][bj][m][n] = __builtin_amdgcn_mfma_f32_16x16x32_bf16(Bt[n][k], At[m][k], acc[ai][bj][m][n], 0, 0, 0); __builtin_amdgcn_s_setprio(0); } while (0)
#define PG8_WAIT_V(n) asm volatile("s_waitcnt vmcnt(" #n ")" ::: "memory")
#define PG8_WAIT_L(n) asm volatile("s_waitcnt lgkmcnt(" #n ")" ::: "memory")
#define PG8_BAR __builtin_amdgcn_s_barrier()
#define PG8_SCHED __builtin_amdgcn_sched_barrier(0)
    Unit cur, nxt; int ui = 0;
    if (!S.next(0, cur)) return;
    f32x4 acc[2][2][4][2];
#pragma unroll
    for (int a = 0; a < 2; ++a)
#pragma unroll
        for (int b = 0; b < 2; ++b)
#pragma unroll
            for (int m = 0; m < 4; ++m)
#pragma unroll
                for (int n = 0; n < 2; ++n) acc[a][b][m][n] = (f32x4){0.f, 0.f, 0.f, 0.f};
    bf16x8 At[4][2], B0[2][2], B1[2][2];
    const char* cA = (const char*)g.A + (size_t)cur.pm * tstep; const char* cB = (const char*)g.Bt + (size_t)cur.pn * tstep;
    S.a_ready(cur);
    if constexpr (SP2) {
        PG8_STAGE(PG8_SB(0, 0), cB, voffB); PG8_STAGE(PG8_SB(0, 1), cB + hstep, voffB); PG8_STAGE(PG8_SA(0, 0), cA, voffA); PG8_STAGE(PG8_SA(0, 1), cA + hstep, voffA);
        if (wr == 1) PG8_BAR;
        PG8_WAIT_V(2); PG8_BAR;
        PG8_STAGE(PG8_SB(1, 0), cB + kstep, voffB); PG8_STAGE(PG8_SA(1, 0), cA + kstep, voffA); PG8_STAGE(PG8_SB(1, 1), cB + hstep + kstep, voffB);
        PG8_WAIT_V(6); PG8_BAR;
    } else {
        PG8_STAGE(PG8_SB(0, 0), cB, voffB); PG8_STAGE(PG8_SA(0, 0), cA, voffA); PG8_STAGE(PG8_SB(0, 1), cB + hstep, voffB); PG8_STAGE(PG8_SA(0, 1), cA + hstep, voffA);
        if (wr == 1) PG8_BAR;
        PG8_WAIT_V(4); PG8_BAR;
        PG8_STAGE(PG8_SB(1, 0), cB + kstep, voffB); PG8_STAGE(PG8_SA(1, 0), cA + kstep, voffA); PG8_STAGE(PG8_SB(1, 1), cB + hstep + kstep, voffB);
        PG8_WAIT_V(6); PG8_BAR;
    }
    for (;;) {
        const bool has_next = S.next(ui + 1, nxt);
        const char* nA = has_next ? (const char*)g.A + (size_t)nxt.pm * tstep : cA; const char* nB = has_next ? (const char*)g.Bt + (size_t)nxt.pn * tstep : cB;
        for (int t = 0; t < nt; t += 2) {
            const bool last = (t == nt - 2);
            const char* a1 = cA + (size_t)(t + 1) * kstep;
            const char* a2 = last ? nA : cA + (size_t)(t + 2) * kstep; const char* b2 = last ? nB : cB + (size_t)(t + 2) * kstep;
            const char* a3 = a2 + kstep; const char* b3 = b2 + kstep;
            if (last && has_next) S.a_ready(nxt);
            if constexpr (SP2) {
            PG8_LDB(B0, 0, 0); PG8_LDB(B1, 0, 1); PG8_SCHED; PG8_LDA(At, 0, 0); PG8_STAGE(PG8_SA(1, 1), a1 + hstep, voffA);
            PG8_WAIT_V(8); PG8_WAIT_L(0); PG8_BAR; PG8_MMA(0, 0, At, B0); PG8_MMA(0, 1, At, B1); PG8_BAR; PG8_SCHED;
            PG8_LDA(At, 0, 1); PG8_STAGE(PG8_SB(0, 0), b2, voffB); PG8_STAGE(PG8_SB(0, 1), b2 + hstep, voffB); PG8_STAGE(PG8_SA(0, 0), a2, voffA);
            PG8_WAIT_V(8); PG8_WAIT_L(0); PG8_BAR; PG8_MMA(1, 0, At, B0); PG8_MMA(1, 1, At, B1); PG8_BAR; PG8_SCHED;
            PG8_LDB(B0, 1, 0); PG8_LDB(B1, 1, 1); PG8_SCHED; PG8_LDA(At, 1, 0); PG8_STAGE(PG8_SA(0, 1), a2 + hstep, voffA);
            PG8_WAIT_V(8); PG8_WAIT_L(0); PG8_BAR; PG8_MMA(0, 0, At, B0); PG8_MMA(0, 1, At, B1); PG8_BAR; PG8_SCHED;
            PG8_LDA(At, 1, 1); PG8_STAGE(PG8_SB(1, 0), b3, voffB); PG8_STAGE(PG8_SB(1, 1), b3 + hstep, voffB); PG8_STAGE(PG8_SA(1, 0), a3, voffA);
            PG8_WAIT_V(8); PG8_WAIT_L(0); PG8_BAR; PG8_MMA(1, 0, At, B0); PG8_MMA(1, 1, At, B1); PG8_BAR; PG8_SCHED;
            } else {
            PG8_LDB(B0, 0, 0); PG8_SCHED; PG8_LDA(At, 0, 0); PG8_STAGE(PG8_SA(1, 1), a1 + hstep, voffA);
            PG8_WAIT_L(8); PG8_BAR; PG8_WAIT_L(0); PG8_MMA(0, 0, At, B0); PG8_BAR; PG8_SCHED;
            PG8_LDB(B1, 0, 1); PG8_STAGE(PG8_SB(0, 0), b2, voffB);
            PG8_BAR; PG8_WAIT_L(0); PG8_MMA(0, 1, At, B1); PG8_BAR;
            PG8_LDA(At, 0, 1); PG8_STAGE(PG8_SA(0, 0), a2, voffA);
            PG8_BAR; PG8_WAIT_L(0); PG8_MMA(1, 0, At, B0); PG8_BAR; PG8_SCHED;
            PG8_STAGE(PG8_SB(0, 1), b2 + hstep, voffB);
            PG8_WAIT_V(6); PG8_BAR; PG8_MMA(1, 1, At, B1); PG8_BAR;
            PG8_LDB(B0, 1, 0); PG8_SCHED; PG8_LDA(At, 1, 0); PG8_STAGE(PG8_SA(0, 1), a2 + hstep, voffA);
            PG8_WAIT_L(8); PG8_BAR; PG8_WAIT_L(0); PG8_MMA(0, 0, At, B0); PG8_BAR; PG8_SCHED;
            PG8_LDB(B1, 1, 1); PG8_STAGE(PG8_SB(1, 0), b3, voffB);
            PG8_BAR; PG8_WAIT_L(0); PG8_MMA(0, 1, At, B1); PG8_BAR;
            PG8_LDA(At, 1, 1); PG8_STAGE(PG8_SA(1, 0), a3, voffA);
            PG8_BAR; PG8_WAIT_L(0); PG8_MMA(1, 0, At, B0); PG8_BAR; PG8_SCHED;
            PG8_STAGE(PG8_SB(1, 1), b3 + hstep, voffB);
            PG8_WAIT_V(6); PG8_BAR; PG8_MMA(1, 1, At, B1); PG8_BAR;
            }
        }
        if constexpr (ALIGN_EPI) { if (wr == 0) PG8_BAR; }
        if constexpr (!Epi::AFTER_DRAIN) { E(acc, cur, wr, wc, fr, fq); S.done(cur); }
        if (!has_next) break;
#pragma unroll
        for (int a = 0; a < 2; ++a)
#pragma unroll
            for (int b = 0; b < 2; ++b)
#pragma unroll
                for (int m = 0; m < 4; ++m)
#pragma unroll
                    for (int n = 0; n < 2; ++n) acc[a][b][m][n] = (f32x4){0.f, 0.f, 0.f, 0.f};
        cur = nxt; cA = nA; cB = nB; ++ui;
        if constexpr (ALIGN_EPI) { if (wr == 1) PG8_BAR; }
    }
    PG8_WAIT_V(0);
    if constexpr (!ALIGN_EPI) { if (wr == 0) PG8_BAR; }
    PG8_BAR;
    if constexpr (Epi::AFTER_DRAIN) { E.fused(acc, cur, wr, wc, fr, fq, lds, wid, lane); S.done(cur); }
#undef PG8_SA
#undef PG8_SB
#undef PG8_STAGE
#undef PG8_LDA
#undef PG8_LDB
#undef PG8_MMA
#undef PG8_WAIT_V
#undef PG8_WAIT_L
#undef PG8_BAR
#undef PG8_SCHED
}
}

#define GAS __attribute__((address_space(1)))
#define LAS __attribute__((address_space(3)))
typedef unsigned short bf16;
typedef unsigned v4u __attribute__((ext_vector_type(4)));
typedef unsigned v2u __attribute__((ext_vector_type(2)));
typedef float f32x4 __attribute__((ext_vector_type(4)));
typedef float f32x2 __attribute__((ext_vector_type(2)));
typedef float f32x16 __attribute__((ext_vector_type(16)));
typedef short bf16x8 __attribute__((ext_vector_type(8)));
typedef short s16x4 __attribute__((ext_vector_type(4)));
typedef GAS unsigned gu32;
#define RLX_AGENT __ATOMIC_RELAXED, __HIP_MEMORY_SCOPE_AGENT
#define LDS_WAIT() asm volatile("s_waitcnt lgkmcnt(0)" ::: "memory")
#define VM_WAIT() asm volatile("s_waitcnt vmcnt(0)" ::: "memory")

constexpr int NWAVES = 8, NTHR = 512;
constexpr int SEQ = 8192, DM = 2048, DI = 4096, NHS = 64, HP = 64, NG = 8, NST = 128, DXBC = 6144, CHK = 256, NCH = 32;
constexpr int AH = 16, AD = 128, DA = 2048, BLK = 256, NBLK = 32;
constexpr int DFF = 5632, DFF2 = 11264;
constexpr int NIN = 20480;
constexpr int DINP = 20544;
constexpr float EPS = 1e-6f;

enum { I_X = 0, I_ANW, I_WIN, I_BG, I_SCW, I_SCB, I_DTB, I_ALOG, I_SD, I_SNW, I_QNW, I_KNW, I_REL, I_WSS, I_WAT, I_WOUT, I_FNW, I_WUP, I_FCW, I_FCB, I_WDN, N_INPUTS };

constexpr size_t MiB = 1u << 20;
constexpr size_t WS_CTL = 0, CTL_ZERO_BYTES = 256 * 1024;
constexpr size_t WS_R1 = 1 * MiB;
constexpr size_t WS_SS2 = WS_R1 + 64 * 1024;
constexpr size_t WS_KBAR = WS_SS2 + 64 * 1024;
constexpr size_t WS_KBARB = WS_KBAR + 256 * 1024;
constexpr size_t WS_DT = 2 * MiB;
constexpr size_t WS_ACS = 4 * MiB;
constexpr size_t WS_WIN = 16 * MiB;
constexpr size_t WS_STATES = 16 * MiB;
constexpr size_t WS_BCC = 200 * MiB;
constexpr size_t WS_WSS = 100 * MiB;
constexpr size_t WS_WAT = 116 * MiB;
constexpr size_t WS_WOUT = 124 * MiB;
constexpr size_t WS_WUP = 132 * MiB;
constexpr size_t WS_WDN = 176 * MiB;
constexpr size_t WS_XB = 200 * MiB;
constexpr size_t WS_Z = 232 * MiB;
constexpr size_t WS_XBC = 296 * MiB;
constexpr size_t WS_Q = 392 * MiB;
constexpr size_t WS_K = 424 * MiB;
constexpr size_t WS_V = 456 * MiB;
constexpr size_t WS_GT = 488 * MiB;
constexpr size_t WS_YG = 556 * MiB;
constexpr size_t WS_UPRE = 232 * MiB;
constexpr size_t WS_ACT = 456 * MiB;
constexpr size_t WS_END = 620 * MiB;

constexpr int CW_BAR = 4096;

__device__ __forceinline__ unsigned f2bf(float f) { unsigned u = __builtin_bit_cast(unsigned, f); return (u + 0x7fffu + ((u >> 16) & 1u)) >> 16; }
__device__ __forceinline__ unsigned pk2(float lo, float hi) { return f2bf(lo) | (f2bf(hi) << 16); }
__device__ __forceinline__ float bf2f(unsigned short b) { return __builtin_bit_cast(float, (unsigned)b << 16); }
__device__ __forceinline__ float bflo(unsigned w) { return __builtin_bit_cast(float, w << 16); }
__device__ __forceinline__ float bfhi(unsigned w) { return __builtin_bit_cast(float, w & 0xffff0000u); }
__device__ __forceinline__ float siluf(float v) { return v / (1.f + __expf(-v)); }
__device__ __forceinline__ float sigmf(float v) { return 1.f / (1.f + __expf(-v)); }
__device__ __forceinline__ float wave_sum(float v) {
#pragma unroll
    for (int o = 1; o < 64; o <<= 1) v += __shfl_xor(v, o);
    return v;
}

#define XB_TMO      128
#define XB_XCNT(j)  (256  + 64 * (j))
#define XB_XSUB(j)  (1280 + 64 * (j))
#define XB_XGEN(j)  (2304 + 64 * (j))
#define XB_TOP      3328
#define XB_TOPGEN   3392
#define XCD_BAR_WORDS 3456
#define XB_SPIN_CAP (1u << 20)
__device__ __forceinline__ unsigned xb_ld(unsigned* p)              { return __hip_atomic_load(p, __ATOMIC_RELAXED, __HIP_MEMORY_SCOPE_AGENT); }
__device__ __forceinline__ unsigned xb_add(unsigned* p, unsigned v) { return __hip_atomic_fetch_add(p, v, __ATOMIC_RELAXED, __HIP_MEMORY_SCOPE_AGENT); }
__device__ __forceinline__ unsigned xb_xcc_id() { return (unsigned)__builtin_amdgcn_s_getreg((3 << 11) | 20) & 0xFu; }
#define XB_SPIN(cond, bar) do { unsigned _sp = 0; while (cond) { __builtin_amdgcn_s_sleep(1); \
    if ((++_sp & 255u) == 0u) { if (xb_ld(&(bar)[XB_TMO])) break; if (_sp > XB_SPIN_CAP) { atomicAdd(&(bar)[XB_TMO], 1u); break; } } } } while (0)
struct XcdBarrier { unsigned* bar; unsigned x; volatile LAS unsigned* st; };
__device__ __forceinline__ XcdBarrier xcd_barrier_post(unsigned* bar, volatile LAS unsigned* st) {
    XcdBarrier b; b.bar = bar; b.x = xb_xcc_id(); b.st = st;
    if (threadIdx.x == 0) (void)xb_add(&bar[XB_XCNT(b.x)], 1u);
    return b;
}
__device__ __forceinline__ void xcd_barrier_complete(unsigned* bar, unsigned x, unsigned& nloc, unsigned& nx) {
    const unsigned G = gridDim.x * gridDim.y * gridDim.z;
    unsigned sum, cnt, mine, sp = 0u;
    for (;;) {
        sum = 0u; cnt = 0u; mine = 0u;
#pragma unroll
        for (unsigned j = 0; j < 16; ++j) { const unsigned c = xb_ld(&bar[XB_XCNT(j)]); sum += c; cnt += (c > 0u) ? 1u : 0u; mine = (j == x) ? c : mine; }
        if (sum == G) break;
        __builtin_amdgcn_s_sleep(1);
        if ((++sp & 255u) == 0u) { if (xb_ld(&bar[XB_TMO])) break; if (sp > XB_SPIN_CAP) { atomicAdd(&bar[XB_TMO], 1u); break; } }
    }
    nloc = mine > 0u ? mine : 1u; nx = cnt > 0u ? cnt : 1u;
}
__device__ __forceinline__ void xcd_barrier(const XcdBarrier& b) {
    asm volatile("s_waitcnt vmcnt(0)" ::: "memory");
    __syncthreads();
    if (threadIdx.x == 0) {
        unsigned* bar = b.bar;
        __builtin_amdgcn_s_waitcnt(0);
        unsigned nloc = b.st[0], nx = b.st[1];
        if (nloc == 0u) { xcd_barrier_complete(bar, b.x, nloc, nx); b.st[0] = nloc; b.st[1] = nx; }
        const unsigned old = xb_add(&bar[XB_XSUB(b.x)], 1u);
        const unsigned gen = old / nloc;
        if (old + 1u == (gen + 1u) * nloc) {
            __builtin_amdgcn_fence(__ATOMIC_RELEASE, "agent");
            asm volatile("s_waitcnt vmcnt(0)" ::: "memory");
            const unsigned og = xb_add(&bar[XB_TOP], 1u);
            const unsigned tg = og / nx;
            if (og + 1u == (tg + 1u) * nx) xb_add(&bar[XB_TOPGEN], 1u);
            else XB_SPIN(xb_ld(&bar[XB_TOPGEN]) == tg, bar);
            __builtin_amdgcn_fence(__ATOMIC_ACQUIRE, "agent");
            xb_add(&bar[XB_XGEN(b.x)], 1u);
            asm volatile("s_waitcnt vmcnt(0)" ::: "memory");
        } else {
            XB_SPIN(xb_ld(&bar[XB_XGEN(b.x)]) == gen, bar);
            __builtin_amdgcn_fence(__ATOMIC_ACQUIRE, "agent");
            asm volatile("s_waitcnt vmcnt(0)" ::: "memory");
        }
    }
    __syncthreads();
}

constexpr int RING_OFF = 0, RING_BYTES = 131072;
constexpr int LDS_BYTES = 155648;
constexpr int LDSCTL_OFF = LDS_BYTES - 1024, MISC_OFF = LDSCTL_OFF + 320;

struct Args { const float* in[N_INPUTS]; float* out; unsigned char* ws; int ph_lo, ph_hi, li, pad; };
static_assert(sizeof(Args) == N_INPUTS * 8 + 8 + 8 + 16, "Args has no padding");

struct Frame {
    LAS unsigned char* lds;
    int tid, lane, wave, vcu, G;
};

__device__ __forceinline__ int map_ident(int n) { return n; }
__device__ __forceinline__ int map_win(int n) { return n < 10240 ? n : (n < 10304 ? 20480 + (n - 10240) : n - 64); }
template <int MAP>
__device__ __forceinline__ void p0_transpose_item(const float* __restrict__ W, int K, int N, bf16* WT, const float* __restrict__ kscale, LAS float* scr, int item, int lane) {
    const int nblk = N / 32, kb = item / nblk, nb = item % nblk, k0 = 64 * kb, n0 = 32 * nb;
#pragma unroll 8
    for (int i = 0; i < 32; ++i) { const int kk = 2 * i + (lane >> 5); float v = W[(size_t)(k0 + kk) * N + n0 + (lane & 31)]; if (kscale) v *= kscale[k0 + kk]; scr[kk * 33 + (lane & 31)] = v; }
    LDS_WAIT(); asm volatile("" ::: "memory");
    const int c = lane & 7;
#pragma unroll
    for (int j = 0; j < 4; ++j) { const int n = (lane >> 3) + 8 * j; const LAS float* s = scr + (8 * c) * 33 + n;
        v4u o; o.x = pk2(s[0 * 33], s[1 * 33]); o.y = pk2(s[2 * 33], s[3 * 33]); o.z = pk2(s[4 * 33], s[5 * 33]); o.w = pk2(s[6 * 33], s[7 * 33]);
        const int nn = n0 + n; const int dr = (MAP == 1) ? map_win(nn) : nn;
        *(GAS v4u*)(WT + (size_t)dr * K + k0 + 8 * c) = o; }
    LDS_WAIT(); asm volatile("" ::: "memory");
}
__device__ __forceinline__ void p0_prologue(Frame& F, const Args& A) {
    LAS float* scr = (LAS float*)(F.lds + RING_OFF + F.wave * 16384);
    const int gw = F.vcu * NWAVES + F.wave, NGW = F.G * NWAVES;
    unsigned char* ws = A.ws;
    constexpr int IT_WIN = (DM / 64) * (DINP / 32), IT_WSS = (DI / 64) * (DM / 32), IT_WAT = (DA / 64) * (DM / 32), IT_WOUT = (DM / 64) * (DM / 32),
                  IT_WUP = (DM / 64) * (DFF2 / 32), IT_WDN = (DFF / 64) * (DM / 32);
    constexpr int NITEMS = IT_WIN + IT_WSS + IT_WAT + IT_WOUT + IT_WUP + IT_WDN;
    for (int it = gw; it < NITEMS; it += NGW) {
        int r = it;
        if (r < IT_WIN) { p0_transpose_item<1>(A.in[I_WIN], DM, DINP, (bf16*)(ws + WS_WIN), A.in[I_ANW], scr, r, F.lane); continue; } r -= IT_WIN;
        if (r < IT_WSS) { p0_transpose_item<0>(A.in[I_WSS], DI, DM, (bf16*)(ws + WS_WSS), nullptr, scr, r, F.lane); continue; } r -= IT_WSS;
        if (r < IT_WAT) { p0_transpose_item<0>(A.in[I_WAT], DA, DM, (bf16*)(ws + WS_WAT), nullptr, scr, r, F.lane); continue; } r -= IT_WAT;
        if (r < IT_WOUT) { p0_transpose_item<0>(A.in[I_WOUT], DM, DM, (bf16*)(ws + WS_WOUT), nullptr, scr, r, F.lane); continue; } r -= IT_WOUT;
        if (r < IT_WUP) { p0_transpose_item<0>(A.in[I_WUP], DM, DFF2, (bf16*)(ws + WS_WUP), A.in[I_FNW], scr, r, F.lane); continue; } r -= IT_WUP;
        p0_transpose_item<0>(A.in[I_WDN], DFF, DM, (bf16*)(ws + WS_WDN), nullptr, scr, r, F.lane);
    }
    float* r1 = (float*)(ws + WS_R1); float* ss2 = (float*)(ws + WS_SS2);
    bf16* xb = (bf16*)(ws + WS_XB);
    for (int m = gw; m < SEQ; m += NGW) {
        const GAS f32x4* xr = (const GAS f32x4*)(A.in[I_X] + (size_t)m * DM) + F.lane;
        f32x4 v[8]; float s = 0.f;
#pragma unroll
        for (int j = 0; j < 8; ++j) { v[j] = xr[64 * j]; s += (v[j].x * v[j].x + v[j].y * v[j].y) + (v[j].z * v[j].z + v[j].w * v[j].w); }
        s = wave_sum(s);
        GAS unsigned long long* o8 = (GAS unsigned long long*)(xb + (size_t)m * DM) + F.lane;
#pragma unroll
        for (int j = 0; j < 8; ++j) o8[64 * j] = (unsigned long long)pk2(v[j].x, v[j].y) | ((unsigned long long)pk2(v[j].z, v[j].w) << 32);
        if (F.lane == 0) { r1[m] = 1.0f / sqrtf(s * (1.0f / DM) + EPS); ss2[m] = 0.f; }
    }
}

namespace pg8 {
struct EpiInProj {
    static constexpr bool PERM = true, AFTER_DRAIN = false;
    bf16_t *z, *xbc, *q, *k, *v, *gt; const float* r1; const float* bg;
    __device__ __forceinline__ void operator()(const f32x4 (&acc)[2][2][4][2], const Unit& u, int wr, int wc, int fr, int fq) const {
        const int pn = u.pn; bf16_t* base; int ldc, colt; bool isg = false;
        if (pn < 16) { base = z; ldc = DI; colt = pn * 256; }
        else if (pn < 40) { base = xbc; ldc = DXBC; colt = (pn - 16) * 256; }
        else if (pn < 48) { base = q; ldc = DA; colt = (pn - 40) * 256; }
        else if (pn < 56) { base = k; ldc = DA; colt = (pn - 48) * 256; }
        else if (pn < 64) { base = v; ldc = DA; colt = (pn - 56) * 256; }
        else { base = gt; ldc = DI; colt = (pn - 64) * 256; isg = true; }
        const int row0 = u.pm * BM + wr * 64 + fr, col0 = colt + wc * 32 + 8 * fq;
        f32x4 bv[2][2];
#pragma unroll
        for (int bj = 0; bj < 2; ++bj)
#pragma unroll
            for (int n = 0; n < 2; ++n) bv[bj][n] = isg ? *(const f32x4*)(bg + col0 + bj * HALF + 4 * n) : (f32x4){0.f, 0.f, 0.f, 0.f};
#pragma unroll
        for (int ai = 0; ai < 2; ++ai)
#pragma unroll
            for (int m = 0; m < 4; ++m) { const int row = row0 + ai * HALF + m * 16; const float rs = r1[row]; bf16_t* rowp = base + (size_t)row * ldc + col0;
#pragma unroll
                for (int bj = 0; bj < 2; ++bj) { f32x4 v0 = acc[ai][bj][m][0] * rs + bv[bj][0], v1 = acc[ai][bj][m][1] * rs + bv[bj][1];
                    if (isg) {
#pragma unroll
                        for (int e = 0; e < 4; ++e) { v0[e] = 1.f / (1.f + __expf(-v0[e])); v1[e] = 1.f / (1.f + __expf(-v1[e])); } }
                    u32x4 w; w.x = cvt_pk_bf16(v0[0], v0[1]); w.y = cvt_pk_bf16(v0[2], v0[3]); w.z = cvt_pk_bf16(v1[0], v1[1]); w.w = cvt_pk_bf16(v1[2], v1[3]);
                    *(u32x4*)(rowp + bj * HALF) = w; } }
    }
};
struct EpiGateF32 {
    static constexpr bool PERM = true, AFTER_DRAIN = false;
    float* T; const bf16_t* gt; int goff;
    __device__ __forceinline__ void operator()(const f32x4 (&acc)[2][2][4][2], const Unit& u, int wr, int wc, int fr, int fq) const {
        const int row0 = u.pm * BM + wr * 64 + fr, col0 = u.pn * BM + wc * 32 + 8 * fq;
#pragma unroll
        for (int ai = 0; ai < 2; ++ai)
#pragma unroll
            for (int m = 0; m < 4; ++m) { const int row = row0 + ai * HALF + m * 16;
#pragma unroll
                for (int bj = 0; bj < 2; ++bj) { const u32x4 g = *(const u32x4*)(gt + (size_t)row * DI + goff + col0 + bj * HALF);
                    f32x4 g0 = {__builtin_bit_cast(float, g.x << 16), __builtin_bit_cast(float, g.x & 0xffff0000u), __builtin_bit_cast(float, g.y << 16), __builtin_bit_cast(float, g.y & 0xffff0000u)};
                    f32x4 g1 = {__builtin_bit_cast(float, g.z << 16), __builtin_bit_cast(float, g.z & 0xffff0000u), __builtin_bit_cast(float, g.w << 16), __builtin_bit_cast(float, g.w & 0xffff0000u)};
                    float* tp = T + (size_t)row * DM + col0 + bj * HALF;
                    *(f32x4*)tp = acc[ai][bj][m][0] * g0; *(f32x4*)(tp + 4) = acc[ai][bj][m][1] * g1; } }
    }
};
struct EpiGateAddBf16 {
    static constexpr bool PERM = true, AFTER_DRAIN = false;
    const float* T; const bf16_t* gt; int goff; bf16_t* O;
    __device__ __forceinline__ void operator()(const f32x4 (&acc)[2][2][4][2], const Unit& u, int wr, int wc, int fr, int fq) const {
        const int row0 = u.pm * BM + wr * 64 + fr, col0 = u.pn * BM + wc * 32 + 8 * fq;
#pragma unroll
        for (int ai = 0; ai < 2; ++ai)
#pragma unroll
            for (int m = 0; m < 4; ++m) { const int row = row0 + ai * HALF + m * 16;
#pragma unroll
                for (int bj = 0; bj < 2; ++bj) { const u32x4 g = *(const u32x4*)(gt + (size_t)row * DI + goff + col0 + bj * HALF);
                    f32x4 g0 = {__builtin_bit_cast(float, g.x << 16), __builtin_bit_cast(float, g.x & 0xffff0000u), __builtin_bit_cast(float, g.y << 16), __builtin_bit_cast(float, g.y & 0xffff0000u)};
                    f32x4 g1 = {__builtin_bit_cast(float, g.z << 16), __builtin_bit_cast(float, g.z & 0xffff0000u), __builtin_bit_cast(float, g.w << 16), __builtin_bit_cast(float, g.w & 0xffff0000u)};
                    const float* tp = T + (size_t)row * DM + col0 + bj * HALF;
                    const f32x4 v0 = *(const f32x4*)tp + acc[ai][bj][m][0] * g0, v1 = *(const f32x4*)(tp + 4) + acc[ai][bj][m][1] * g1;
                    u32x4 w; w.x = cvt_pk_bf16(v0[0], v0[1]); w.y = cvt_pk_bf16(v0[2], v0[3]); w.z = cvt_pk_bf16(v1[0], v1[1]); w.w = cvt_pk_bf16(v1[2], v1[3]);
                    *(u32x4*)(O + (size_t)row * DM + col0 + bj * HALF) = w; } }
    }
};
struct EpiResid1 {
    static constexpr bool PERM = true, AFTER_DRAIN = false;
    const float* X; float* out; bf16_t* xb1; float* ss2;
    __device__ __forceinline__ void operator()(const f32x4 (&acc)[2][2][4][2], const Unit& u, int wr, int wc, int fr, int fq) const {
        const int row0 = u.pm * BM + wr * 64 + fr, col0 = u.pn * BM + wc * 32 + 8 * fq;
#pragma unroll
        for (int ai = 0; ai < 2; ++ai)
#pragma unroll
            for (int m = 0; m < 4; ++m) { const int row = row0 + ai * HALF + m * 16; float sq = 0.f;
#pragma unroll
                for (int bj = 0; bj < 2; ++bj) { const size_t off = (size_t)row * DM + col0 + bj * HALF;
                    const f32x4 v0 = *(const f32x4*)(X + off) + acc[ai][bj][m][0], v1 = *(const f32x4*)(X + off + 4) + acc[ai][bj][m][1];
                    *(f32x4*)(out + off) = v0; *(f32x4*)(out + off + 4) = v1;
                    sq += (v0[0] * v0[0] + v0[1] * v0[1]) + (v0[2] * v0[2] + v0[3] * v0[3]) + (v1[0] * v1[0] + v1[1] * v1[1]) + (v1[2] * v1[2] + v1[3] * v1[3]);
                    u32x4 w; w.x = cvt_pk_bf16(v0[0], v0[1]); w.y = cvt_pk_bf16(v0[2], v0[3]); w.z = cvt_pk_bf16(v1[0], v1[1]); w.w = cvt_pk_bf16(v1[2], v1[3]);
                    *(u32x4*)(xb1 + off) = w; }
                sq += __shfl_xor(sq, 16); sq += __shfl_xor(sq, 32);
                if (fq == 0) atomicAdd(ss2 + row, sq); }
    }
};
struct EpiUpPre {
    static constexpr bool PERM = true, AFTER_DRAIN = false;
    bf16_t* O; const float* ss2;
    __device__ __forceinline__ void operator()(const f32x4 (&acc)[2][2][4][2], const Unit& u, int wr, int wc, int fr, int fq) const {
        const int row0 = u.pm * BM + wr * 64 + fr, col0 = u.pn * BM + wc * 32 + 8 * fq;
#pragma unroll
        for (int ai = 0; ai < 2; ++ai)
#pragma unroll
            for (int m = 0; m < 4; ++m) { const int row = row0 + ai * HALF + m * 16; const float rs = 1.0f / sqrtf(ss2[row] * (1.0f / DM) + EPS);
#pragma unroll
                for (int bj = 0; bj < 2; ++bj) { const f32x4 v0 = acc[ai][bj][m][0] * rs, v1 = acc[ai][bj][m][1] * rs;
                    u32x4 w; w.x = cvt_pk_bf16(v0[0], v0[1]); w.y = cvt_pk_bf16(v0[2], v0[3]); w.z = cvt_pk_bf16(v1[0], v1[1]); w.w = cvt_pk_bf16(v1[2], v1[3]);
                    *(u32x4*)(O + (size_t)row * DFF2 + col0 + bj * HALF) = w; } }
    }
};
struct EpiResid2 {
    static constexpr bool PERM = true, AFTER_DRAIN = false;
    float* out;
    __device__ __forceinline__ void operator()(const f32x4 (&acc)[2][2][4][2], const Unit& u, int wr, int wc, int fr, int fq) const {
        const int row0 = u.pm * BM + wr * 64 + fr, col0 = u.pn * BM + wc * 32 + 8 * fq;
#pragma unroll
        for (int ai = 0; ai < 2; ++ai)
#pragma unroll
            for (int m = 0; m < 4; ++m) { const int row = row0 + ai * HALF + m * 16;
#pragma unroll
                for (int bj = 0; bj < 2; ++bj) { float* p = out + (size_t)row * DM + col0 + bj * HALF;
                    const f32x4 v0 = *(const f32x4*)p + acc[ai][bj][m][0], v1 = *(const f32x4*)(p + 4) + acc[ai][bj][m][1];
                    *(f32x4*)p = v0; *(f32x4*)(p + 4) = v1; } }
    }
};
}

__device__ __forceinline__ float softplusf(float v) { return v > 20.f ? v : log1pf(__expf(v)); }
__device__ __forceinline__ void dt_phase(Frame& F, const Args& A) {
    unsigned char* ws = A.ws;
    const bf16* xb = (const bf16*)(ws + WS_XB); const bf16* wt = (const bf16*)(ws + WS_WIN) + (size_t)NIN * DM;
    const float* r1 = (const float*)(ws + WS_R1); float* dt = (float*)(ws + WS_DT);
    const int gw = F.vcu * NWAVES + F.wave, NGW = F.G * NWAVES;
    for (int m = gw; m < SEQ; m += NGW) {
        const GAS v4u* xr = (const GAS v4u*)(xb + (size_t)m * DM) + F.lane;
        float xv[32];
#pragma unroll
        for (int j = 0; j < 4; ++j) { const v4u w = xr[64 * j];
            xv[8 * j + 0] = bflo(w.x); xv[8 * j + 1] = bfhi(w.x); xv[8 * j + 2] = bflo(w.y); xv[8 * j + 3] = bfhi(w.y);
            xv[8 * j + 4] = bflo(w.z); xv[8 * j + 5] = bfhi(w.z); xv[8 * j + 6] = bflo(w.w); xv[8 * j + 7] = bfhi(w.w); }
        const float rs = r1[m];
        for (int h = 0; h < NHS; ++h) {
            const GAS v4u* wr = (const GAS v4u*)(wt + (size_t)h * DM) + F.lane; float s = 0.f;
#pragma unroll
            for (int j = 0; j < 4; ++j) { const v4u w = wr[64 * j];
                s += xv[8 * j + 0] * bflo(w.x) + xv[8 * j + 1] * bfhi(w.x) + xv[8 * j + 2] * bflo(w.y) + xv[8 * j + 3] * bfhi(w.y)
                   + xv[8 * j + 4] * bflo(w.z) + xv[8 * j + 5] * bfhi(w.z) + xv[8 * j + 6] * bflo(w.w) + xv[8 * j + 7] * bfhi(w.w); }
            s = wave_sum(s);
            if (F.lane == 0) dt[(size_t)m * NHS + h] = softplusf(s * rs + A.in[I_DTB][h]);
        }
    }
}

__device__ __forceinline__ void attn_prep_phase(Frame& F, const Args& A) {
    unsigned char* ws = A.ws;
    bf16* Q = (bf16*)(ws + WS_Q); bf16* K = (bf16*)(ws + WS_K); float* kbar = (float*)(ws + WS_KBAR); bf16* kbarb = (bf16*)(ws + WS_KBARB);
    LAS float* red = (LAS float*)(F.lds + RING_OFF);
    const int sub = F.tid >> 4, l16 = F.tid & 15;
    float qw[8], kw[8];
#pragma unroll
    for (int e = 0; e < 8; ++e) { qw[e] = A.in[I_QNW][l16 * 8 + e] * (0.08838834764831845f * 1.4426950408889634f); kw[e] = A.in[I_KNW][l16 * 8 + e]; }
    for (int u = F.vcu; u < NBLK * AH; u += F.G) {
        const int nb = u / AH, h = u % AH;
        float ksum[8];
#pragma unroll
        for (int e = 0; e < 8; ++e) ksum[e] = 0.f;
        for (int i = 0; i < 8; ++i) {
            const int t = nb * BLK + i * 32 + sub; const size_t off = (size_t)t * DA + h * AD + l16 * 8;
            { const v4u w = *(const GAS v4u*)(Q + off); float v[8] = {bflo(w.x), bfhi(w.x), bflo(w.y), bfhi(w.y), bflo(w.z), bfhi(w.z), bflo(w.w), bfhi(w.w)};
              float s = 0.f;
#pragma unroll
              for (int e = 0; e < 8; ++e) s += v[e] * v[e];
              s += __shfl_xor(s, 1); s += __shfl_xor(s, 2); s += __shfl_xor(s, 4); s += __shfl_xor(s, 8);
              const float r = 1.0f / sqrtf(s * (1.0f / AD) + EPS);
              v4u o; o.x = pk2(v[0] * r * qw[0], v[1] * r * qw[1]); o.y = pk2(v[2] * r * qw[2], v[3] * r * qw[3]); o.z = pk2(v[4] * r * qw[4], v[5] * r * qw[5]); o.w = pk2(v[6] * r * qw[6], v[7] * r * qw[7]);
              *(GAS v4u*)(Q + off) = o; }
            { const v4u w = *(const GAS v4u*)(K + off); float v[8] = {bflo(w.x), bfhi(w.x), bflo(w.y), bfhi(w.y), bflo(w.z), bfhi(w.z), bflo(w.w), bfhi(w.w)};
              float s = 0.f;
#pragma unroll
              for (int e = 0; e < 8; ++e) s += v[e] * v[e];
              s += __shfl_xor(s, 1); s += __shfl_xor(s, 2); s += __shfl_xor(s, 4); s += __shfl_xor(s, 8);
              const float r = 1.0f / sqrtf(s * (1.0f / AD) + EPS);
#pragma unroll
              for (int e = 0; e < 8; ++e) { v[e] = v[e] * r * kw[e]; ksum[e] += v[e]; }
              v4u o; o.x = pk2(v[0], v[1]); o.y = pk2(v[2], v[3]); o.z = pk2(v[4], v[5]); o.w = pk2(v[6], v[7]);
              *(GAS v4u*)(K + off) = o; }
        }
#pragma unroll
        for (int e = 0; e < 8; ++e) red[sub * 128 + l16 * 8 + e] = ksum[e];
        __syncthreads();
        if (F.tid < 128) { float s = 0.f;
#pragma unroll 8
            for (int r = 0; r < 32; ++r) s += red[r * 128 + F.tid];
            kbar[((size_t)h * NBLK + nb) * AD + F.tid] = s * (1.0f / BLK); kbarb[((size_t)h * NBLK + nb) * AD + F.tid] = (bf16)f2bf(s * (1.0f / BLK)); }
        __syncthreads();
    }
}

__device__ __forceinline__ void unpack8(const v4u w, float* v) { v[0] = bflo(w.x); v[1] = bfhi(w.x); v[2] = bflo(w.y); v[3] = bfhi(w.y); v[4] = bflo(w.z); v[5] = bfhi(w.z); v[6] = bflo(w.w); v[7] = bfhi(w.w); }
__device__ __forceinline__ void ffn_act_phase(Frame& F, const Args& A) {
    unsigned char* ws = A.ws;
    const bf16* U = (const bf16*)(ws + WS_UPRE); bf16* ACT = (bf16*)(ws + WS_ACT);
    const float* cw = A.in[I_FCW]; const float* cb = A.in[I_FCB];
    constexpr int CG = DFF / 8;
    const long total = (long)SEQ * CG;
    for (long it = (long)F.vcu * NTHR + F.tid; it < total; it += (long)F.G * NTHR) {
        const int t = (int)(it / CG), c0 = (int)(it % CG) * 8;
        float g[8], up[8];
#pragma unroll
        for (int e = 0; e < 8; ++e) { g[e] = cb[c0 + e]; up[e] = cb[DFF + c0 + e]; }
#pragma unroll
        for (int k = 0; k < 3; ++k) { const int ts = t - 2 + k; if (ts < 0) continue;
            float a[8], b[8]; unpack8(*(const GAS v4u*)(U + (size_t)ts * DFF2 + c0), a); unpack8(*(const GAS v4u*)(U + (size_t)ts * DFF2 + DFF + c0), b);
#pragma unroll
            for (int e = 0; e < 8; ++e) { g[e] += cw[k * DFF2 + c0 + e] * a[e]; up[e] += cw[k * DFF2 + DFF + c0 + e] * b[e]; } }
        float o[8];
#pragma unroll
        for (int e = 0; e < 8; ++e) o[e] = siluf(g[e]) * up[e];
        v4u w; w.x = pk2(o[0], o[1]); w.y = pk2(o[2], o[3]); w.z = pk2(o[4], o[5]); w.w = pk2(o[6], o[7]);
        *(GAS v4u*)(ACT + (size_t)t * DFF + c0) = w;
    }
}

__device__ __forceinline__ int rel_bucket(int n) {
    if (n < 16) return n;
    int v = 16 + (int)(logf((float)n / 16.0f) / 2.0794415416798357f * 16.0f);
    return v < 31 ? v : 31;
}
__global__ void __launch_bounds__(256) naive_attn(const bf16* __restrict__ Q, const bf16* __restrict__ K, const bf16* __restrict__ V, const bf16* __restrict__ kbar,
                                                  const float* __restrict__ rel, bf16* __restrict__ O) {
    __shared__ float q_s[4][128];
    __shared__ float p_s[4][1024];
    __shared__ int   blk_s[4][4];
    const int w = threadIdx.x >> 6, lane = threadIdx.x & 63;
    const int pair = blockIdx.x * 4 + w, qi = pair / AH, h = pair % AH;
    const int blk = qi / BLK;
    { const unsigned u = *(const unsigned*)(Q + (size_t)qi * DA + h * AD + lane * 2); q_s[w][lane * 2] = bflo(u); q_s[w][lane * 2 + 1] = bfhi(u); }
    __syncthreads();
    float g = -INFINITY;
    if (lane < blk) { float s = 0.f; const bf16* kb = kbar + ((size_t)h * NBLK + lane) * AD; for (int d = 0; d < AD; ++d) s += q_s[w][d] * bf2f(kb[d]); g = s; }
    const int nsel = blk < 3 ? blk : 3;
    for (int t = 0; t < nsel; ++t) {
        float bv = g; int bi = lane;
#pragma unroll
        for (int o = 1; o < 64; o <<= 1) { const float ov = __shfl_xor(bv, o); const int oi = __shfl_xor(bi, o); if (ov > bv || (ov == bv && oi < bi)) { bv = ov; bi = oi; } }
        if (lane == 0) blk_s[w][t] = bi;
        if (lane == bi) g = -INFINITY;
    }
    if (lane == 0) blk_s[w][nsel] = blk;
    __syncthreads();
    const int nslot = nsel + 1;
    float mx = -INFINITY;
    for (int s = 0; s < nslot; ++s) {
        const int nb = blk_s[w][s]; const bool own = (s == nsel);
        for (int i = 0; i < 4; ++i) { const int j = lane + 64 * i, kpos = nb * BLK + j; const int dist = qi - kpos;
            float sc = -INFINITY;
            if (dist >= 0) { const bf16* kr = K + (size_t)kpos * DA + h * AD; float a = 0.f;
                for (int d = 0; d < AD; d += 2) { const unsigned u = *(const unsigned*)(kr + d); a += q_s[w][d] * bflo(u) + q_s[w][d + 1] * bfhi(u); }
                sc = a + rel[rel_bucket(dist) * AH + h] * 1.4426950408889634f; }
            (void)own;
            p_s[w][s * 256 + j] = sc; mx = fmaxf(mx, sc); }
    }
#pragma unroll
    for (int o = 1; o < 64; o <<= 1) mx = fmaxf(mx, __shfl_xor(mx, o));
    float sum = 0.f;
    for (int s = 0; s < nslot; ++s) for (int i = 0; i < 4; ++i) { const int idx = s * 256 + lane + 64 * i; const float e = exp2f(p_s[w][idx] - mx); p_s[w][idx] = e; sum += e; }
    sum = wave_sum(sum);
    __syncthreads();
    float o0 = 0.f, o1 = 0.f;
    for (int s = 0; s < nslot; ++s) { const int nb = blk_s[w][s];
        for (int j = 0; j < 256; ++j) { const float p = p_s[w][s * 256 + j]; const unsigned u = *(const unsigned*)(V + (size_t)(nb * BLK + j) * DA + h * AD + lane * 2); o0 += p * bflo(u); o1 += p * bfhi(u); } }
    const float inv = 1.f / sum;
    *(unsigned*)(O + (size_t)qi * DA + h * AD + lane * 2) = pk2(o0 * inv, o1 * inv);
}

__global__ void __launch_bounds__(512) naive_ssd(const bf16* __restrict__ XBC, const bf16* __restrict__ Z, const float* __restrict__ DT, const float* __restrict__ cw, const float* __restrict__ cb,
                                                 const float* __restrict__ alog, const float* __restrict__ dskip, const float* __restrict__ nw, bf16* __restrict__ YG) {
    __shared__ float bc_s[256];
    __shared__ float red_s[8];
    const int g = blockIdx.x, tid = threadIdx.x, head = g * 8 + (tid >> 6), ch = g * 512 + tid;
    const float Aneg = -__expf(alog[head]), Dh = dskip[head], nwc = nw[ch];
    float hst[128];
#pragma unroll
    for (int n = 0; n < 128; ++n) hst[n] = 0.f;
    const int bcch = (tid < 128) ? (DI + g * NST + tid) : (DI + NG * NST + g * NST + (tid - 128));
    float wx[4], wb[4]; float bx = cb[ch], bb = 0.f;
#pragma unroll
    for (int k = 0; k < 4; ++k) wx[k] = cw[k * DXBC + ch];
    if (tid < 256) { bb = cb[bcch];
#pragma unroll
        for (int k = 0; k < 4; ++k) wb[k] = cw[k * DXBC + bcch]; }
    for (int t = 0; t < SEQ; ++t) {
        float xa = bx, ba = bb;
#pragma unroll
        for (int k = 0; k < 4; ++k) { const int ts = t - 3 + k; if (ts >= 0) { xa += wx[k] * bf2f(XBC[(size_t)ts * DXBC + ch]); if (tid < 256) ba += wb[k] * bf2f(XBC[(size_t)ts * DXBC + bcch]); } }
        const float xv = siluf(xa);
        __syncthreads();
        if (tid < 256) bc_s[tid] = siluf(ba);
        __syncthreads();
        const float dtv = DT[(size_t)t * NHS + head], dA = __expf(dtv * Aneg), dtx = dtv * xv;
        float y = 0.f;
#pragma unroll
        for (int n = 0; n < 128; ++n) { hst[n] = hst[n] * dA + dtx * bc_s[n]; y += bc_s[128 + n] * hst[n]; }
        y += Dh * xv;
        const float zv = bf2f(Z[(size_t)t * DI + ch]);
        const float gv = y * siluf(zv);
        float sq = wave_sum(gv * gv);
        if ((tid & 63) == 0) red_s[tid >> 6] = sq;
        __syncthreads();
        float tot = 0.f;
#pragma unroll
        for (int i = 0; i < 8; ++i) tot += red_s[i];
        const float r = 1.0f / sqrtf(tot * (1.0f / 512.f) + EPS);
        YG[(size_t)t * DI + ch] = (bf16)f2bf(gv * r * nwc);
    }
}

namespace att {
constexpr int QBLK = 32, KVBLK = 64, D = 128, LD = DA;
constexpr int SHM_V = KVBLK * D * 2, SHM_K = KVBLK * D * 2;
constexpr int OFF_V = 0, OFF_K = 2 * SHM_V, OFF_WS = 2 * SHM_V + 2 * SHM_K, OFF_LUT = OFF_WS + NWAVES * 64 * 4, OFF_KBAR = OFF_LUT + 512, OFF_QF = OFF_KBAR + 32 * 256, ATT_LDS = OFF_QF + NWAVES * 8192;
static_assert(ATT_LDS <= LDSCTL_OFF, "attention LDS scratch overlaps the control words");
constexpr float LOG2E = 1.4426950408889634f;
constexpr float THR2 = 11.5f;
#define KSWZ(row, colB) ((row) * 256 + ((colB) ^ (((row) & 7) << 4)))
#define SBAR() __builtin_amdgcn_sched_barrier(0)
__device__ __forceinline__ int v_st(int k, int c) { const int kk = (k & ~0xC) | ((k & 4) << 1) | ((k & 8) >> 1); return ((kk >> 3) * 4 + (c >> 5)) * 512 + ((kk & 7) * 32 + (c & 31)) * 2; }
__device__ __forceinline__ int v_rd_base(int lane) { return ((lane & 3) << 3) | (((lane >> 2) & 3) << 6) | (((lane >> 4) & 1) << 5) | (((lane >> 5) & 1) << 8); }
constexpr int v_rd_off(int d0, int ks, int half) { return d0 * 512 + ks * 4096 + half * 2048; }
__device__ __forceinline__ int crow(int r, int hi) { return (r & 3) + 8 * (r >> 2) + 4 * hi; }
__device__ __forceinline__ unsigned cvtpk(float lo, float hi) { unsigned r; asm volatile("v_cvt_pk_bf16_f32 %0, %1, %2" : "=v"(r) : "v"(lo), "v"(hi)); return r; }

__device__ __forceinline__ void bias_tile(f32x16& p0, f32x16& p1, int dq, const float* lut) {
    const float NEG = -__builtin_inff();
#pragma unroll
    for (int r = 0; r < 16; ++r) {
        const int c = (r & 3) + 8 * (r >> 2);
        const int d0 = dq - c, d1 = dq - c - 32;
        const float b0 = lut[d0 < 0 ? 0 : (d0 > 127 ? 127 : d0)], b1 = lut[d1 < 0 ? 0 : (d1 > 127 ? 127 : d1)];
        p0[r] += (d0 < 0) ? NEG : b0;
        p1[r] += (d1 < 0) ? NEG : b1;
    }
}
__device__ __forceinline__ void partialSM(f32x16& p0, f32x16& p1, float& m_reg, float& mn, float& alpha) {
    float pmax = p0[0];
#pragma unroll
    for (int r = 1; r < 16; ++r) pmax = fmaxf(pmax, p0[r]);
#pragma unroll
    for (int r = 0; r < 16; ++r) pmax = fmaxf(pmax, p1[r]);
    { auto rr = __builtin_amdgcn_permlane32_swap(__float_as_uint(pmax), __float_as_uint(pmax), false, false);
      pmax = fmaxf(__uint_as_float(rr[0]), __uint_as_float(rr[1])); }
    if (__builtin_expect(__all((pmax - m_reg) <= THR2), 1)) { mn = m_reg; alpha = 1.f; }
    else { mn = fmaxf(m_reg, pmax); alpha = __builtin_amdgcn_exp2f(m_reg - mn); m_reg = mn; }
#pragma unroll
    for (int r = 0; r < 16; ++r) p0[r] = p0[r] - mn;
#pragma unroll
    for (int r = 0; r < 16; ++r) p1[r] = p1[r] - mn;
#pragma unroll
    for (int r = 0; r < 16; ++r) p0[r] = __builtin_amdgcn_exp2f(p0[r]);
}
__device__ __forceinline__ void finishSM(f32x16& p0, f32x16& p1, float alpha, float& l_reg, bf16x8& pa0, bf16x8& pa1, bf16x8& pa2, bf16x8& pa3) {
#pragma unroll
    for (int r = 0; r < 16; ++r) p1[r] = __builtin_amdgcn_exp2f(p1[r]);
    float ps = 0;
#pragma unroll
    for (int r = 0; r < 16; ++r) ps += p0[r];
#pragma unroll
    for (int r = 0; r < 16; ++r) ps += p1[r];
    { auto rr = __builtin_amdgcn_permlane32_swap(__float_as_uint(ps), __float_as_uint(ps), false, false);
      ps = __uint_as_float(rr[0]) + __uint_as_float(rr[1]); }
    l_reg = l_reg * alpha + ps;
#define PK4(P, B_, OUT) do { unsigned a0 = cvtpk(P[B_+0], P[B_+1]), a1 = cvtpk(P[B_+2], P[B_+3]);                          \
        unsigned b0 = cvtpk(P[B_+4], P[B_+5]), b1 = cvtpk(P[B_+6], P[B_+7]);                                             \
        auto r0 = __builtin_amdgcn_permlane32_swap(a0, b0, false, false); auto r1 = __builtin_amdgcn_permlane32_swap(a1, b1, false, false); \
        v4u w = {r0[0], r1[0], r0[1], r1[1]}; OUT = __builtin_bit_cast(bf16x8, w); } while (0)
    PK4(p0, 0, pa0); PK4(p0, 8, pa1); PK4(p1, 0, pa2); PK4(p1, 8, pa3);
}
template <int KB>
__device__ __forceinline__ void qkt(f32x16& p0, f32x16& p1, const char* K_lds, int r32, int hi, const char* qf, bool act, float init) {
    if (!act) { const float NEG = -__builtin_inff();
#pragma unroll
        for (int r = 0; r < 16; ++r) { p0[r] = NEG; p1[r] = NEG; } return; }
#pragma unroll
    for (int r = 0; r < 16; ++r) { p0[r] = init; p1[r] = init; }
    const char* kb[4];
#pragma unroll
    for (int dd = 0; dd < 4; ++dd) kb[dd] = K_lds + KB * SHM_K + KSWZ(r32, (dd * 16 + hi * 8) * 2);
#pragma unroll
    for (int d0 = 0; d0 < 8; ++d0) { const char* a = kb[d0 & 3] + (d0 >> 2) * 128;
        bf16x8 b0 = *reinterpret_cast<const bf16x8*>(a);
        bf16x8 b1 = *reinterpret_cast<const bf16x8*>(a + 32 * 256);
        const bf16x8 q = *reinterpret_cast<const bf16x8*>(qf + d0 * 1024);
        p0 = __builtin_amdgcn_mfma_f32_32x32x16_bf16(b0, q, p0, 0, 0, 0);
        p1 = __builtin_amdgcn_mfma_f32_32x32x16_bf16(b1, q, p1, 0, 0, 0); }
}
__device__ __forceinline__ void qk32(f32x16& p0, const char* tile, int r32, int hi, const char* qf) {
#pragma unroll
    for (int r = 0; r < 16; ++r) p0[r] = 0.f;
#pragma unroll
    for (int d0 = 0; d0 < 8; ++d0) { const char* a = tile + KSWZ(r32, ((d0 & 3) * 16 + hi * 8) * 2) + (d0 >> 2) * 128;
        bf16x8 b0 = *reinterpret_cast<const bf16x8*>(a);
        p0 = __builtin_amdgcn_mfma_f32_32x32x16_bf16(b0, *reinterpret_cast<const bf16x8*>(qf + d0 * 1024), p0, 0, 0, 0); }
}
template <int VB>
__device__ __forceinline__ void pv_tile(f32x16* o, int vb0, bf16x8 pa0, bf16x8 pa1, bf16x8 pa2, bf16x8 pa3, bool act) {
    if (!act) return;
#define TRRD(dst, off) asm volatile("ds_read_b64_tr_b16 %0, %1 offset:%2" : "=&v"(dst) : "v"(vb0), "i"(off) : "memory")
#define PV_D0(d0) do { s16x4 l0, l1, l2, l3, h0, h1, h2, h3; constexpr int b_ = VB * SHM_V + v_rd_off(d0, 0, 0); \
        TRRD(l0, b_); TRRD(h0, b_ + 2048); TRRD(l1, b_ + 4096); TRRD(h1, b_ + 6144); TRRD(l2, b_ + 8192); TRRD(h2, b_ + 10240); TRRD(l3, b_ + 12288); TRRD(h3, b_ + 14336); \
        asm volatile("s_waitcnt lgkmcnt(0)" ::: "memory"); SBAR(); \
        o[d0] = __builtin_amdgcn_mfma_f32_32x32x16_bf16(pa0, (bf16x8){l0[0], l0[1], l0[2], l0[3], h0[0], h0[1], h0[2], h0[3]}, o[d0], 0, 0, 0);   \
        o[d0] = __builtin_amdgcn_mfma_f32_32x32x16_bf16(pa1, (bf16x8){l1[0], l1[1], l1[2], l1[3], h1[0], h1[1], h1[2], h1[3]}, o[d0], 0, 0, 0);   \
        o[d0] = __builtin_amdgcn_mfma_f32_32x32x16_bf16(pa2, (bf16x8){l2[0], l2[1], l2[2], l2[3], h2[0], h2[1], h2[2], h2[3]}, o[d0], 0, 0, 0);   \
        o[d0] = __builtin_amdgcn_mfma_f32_32x32x16_bf16(pa3, (bf16x8){l3[0], l3[1], l3[2], l3[3], h3[0], h3[1], h3[2], h3[3]}, o[d0], 0, 0, 0); } while (0)
    PV_D0(0); PV_D0(1); PV_D0(2); PV_D0(3);
#undef PV_D0
#undef TRRD
}

__device__ __forceinline__ void moba_unit(int h, int b, const bf16* Q, const bf16* __restrict__ K, const bf16* __restrict__ V, bf16* O, const bf16* __restrict__ KBb, const float* __restrict__ rel, char* lds) {
    int tid0 = threadIdx.x; asm volatile("" : "+v"(tid0));
    const int wid = __builtin_amdgcn_readfirstlane(tid0 >> 6), lane = tid0 & 63, r32 = lane & 31, hi = lane >> 5;
    float* lut = (float*)(lds + OFF_LUT);
    char* kbar_t = lds + OFF_KBAR;
    const int NT = 4 * (b + 1);
    const int qlo = b * BLK + wid * QBLK;
    char* qf = lds + OFF_QF + wid * 8192 + lane * 16;
#define LD8(p) (*reinterpret_cast<const bf16x8*>(p))
    { bf16x8 qr[8];
#pragma unroll
      for (int d0 = 0; d0 < 8; ++d0) qr[d0] = LD8(Q + (size_t)(qlo + r32) * LD + h * D + d0 * 16 + hi * 8);
#pragma unroll
      for (int d0 = 0; d0 < 8; ++d0) *(bf16x8*)(qf + d0 * 1024) = qr[d0];
      const int sr0 = tid0 >> 4, sc0 = (tid0 & 15) * 8;
      const bf16x8 kb = LD8(KBb + ((size_t)h * NBLK + sr0) * D + sc0); *(bf16x8*)(kbar_t + KSWZ(sr0, sc0 * 2)) = kb;
      if (tid0 < 128) lut[tid0] = rel[rel_bucket(tid0) * AH + h] * LOG2E; }
    __syncthreads();
    unsigned selmask = 0u;
    if (b > 0) {
        f32x16 g0; qk32(g0, kbar_t, r32, hi, qf);
        float t1v = -__builtin_inff(), t2v = t1v, t3v = t1v; int t1n = 64, t2n = 64, t3n = 64;
#define TOP3_INS(vv, nn) do { const float v_ = (vv); const int n_ = (nn);                                         \
            const bool g1 = v_ > t1v || (v_ == t1v && n_ < t1n), g2 = v_ > t2v || (v_ == t2v && n_ < t2n), g3 = v_ > t3v || (v_ == t3v && n_ < t3n); \
            t3v = g2 ? t2v : (g3 ? v_ : t3v); t3n = g2 ? t2n : (g3 ? n_ : t3n);                                        \
            t2v = g1 ? t1v : (g2 ? v_ : t2v); t2n = g1 ? t1n : (g2 ? n_ : t2n);                                        \
            t1v = g1 ? v_ : t1v; t1n = g1 ? n_ : t1n; } while (0)
#pragma unroll
        for (int r = 0; r < 16; ++r) { const int n = crow(r, hi), on = crow(r, 1 - hi); const float ov = __shfl_xor(g0[r], 32);
            TOP3_INS(n < b ? g0[r] : -__builtin_inff(), n); TOP3_INS(on < b ? ov : -__builtin_inff(), on); }
#undef TOP3_INS
        selmask = ((t1n < 32 ? 1u << t1n : 0u) | (t2n < 32 ? 1u << t2n : 0u) | (t3n < 32 ? 1u << t3n : 0u)) & ((b >= 32) ? 0xffffffffu : ((1u << b) - 1u));
    }
    asm volatile("" : "+v"(selmask));
    int tid = threadIdx.x; asm volatile("" : "+v"(tid));
    char* V_lds = lds + OFF_V; char* K_lds = lds + OFF_K;
    float* ws = (float*)(lds + OFF_WS) + wid * 64; float* li_l = ws, * al_l = ws + 32;
    const int qm = qlo + r32 - 4 * hi;
    const int sr = tid >> 4, sc = (tid & 15) * 8, vst0 = v_st(sr, sc), vst1 = v_st(32 + sr, sc), kws = KSWZ(sr, sc * 2);
    const int vb0 = (int)(uintptr_t)V_lds + v_rd_base(tid & 63);
    const bf16* Kh = K + h * D; const bf16* Vh = V + h * D;
    bf16x8 st_v0, st_v1, st_k0, st_k1;
#define ROW(p, k0, rr) ((p) + (size_t)((k0) + (rr)) * LD + sc)
#define VMW() asm volatile("s_waitcnt vmcnt(0)" ::: "memory")
#define SLOAD_H(k0) do { st_v0 = LD8(ROW(Vh, k0, sr)); st_v1 = LD8(ROW(Vh, k0, 32 + sr)); st_k0 = LD8(ROW(Kh, k0, sr)); st_k1 = LD8(ROW(Kh, k0, 32 + sr)); } while (0)
#define SWRITE_HK(bf) do { *(bf16x8*)(K_lds + (bf) * SHM_K + kws) = st_k0; *(bf16x8*)(K_lds + (bf) * SHM_K + kws + 32 * 256) = st_k1; } while (0)
#define SWRITE_HV(bf) do { *(bf16x8*)(V_lds + (bf) * SHM_V + vst0) = st_v0; *(bf16x8*)(V_lds + (bf) * SHM_V + vst1) = st_v1; } while (0)
#define SWRITE_H(bf) do { SWRITE_HV(bf); SWRITE_HK(bf); } while (0)
    SLOAD_H(0);
    VMW(); SWRITE_HK(0);
    __syncthreads();
    unsigned wsel = selmask;
#pragma unroll
    for (int o = 1; o < 64; o <<= 1) wsel |= (unsigned)__shfl_xor((int)wsel, o);
    wsel = (unsigned)__builtin_amdgcn_readfirstlane((int)wsel);
    const float lut127 = lut[127];
    const float NEGINF = -__builtin_inff();
    float m_reg = -1e30f, l_reg = 0; f32x16 o[4] = {};
#define RESC(a) do { if (__any((a) < 1.f)) { if (hi == 0) al_l[r32] = (a); asm volatile("s_waitcnt lgkmcnt(0)" ::: "memory");              \
                     for (int d_ = 0; d_ < 4; ++d_) for (int r = 0; r < 16; ++r) o[d_][r] *= al_l[crow(r, hi)]; } } while (0)
#define KBASE(t) ((t) * KVBLK)
#define OWN(t) ((t) >= 4 * b)
#define ACT(t) (OWN(t) ? (KBASE(t) <= qlo + QBLK - 1) : (((wsel >> ((t) >> 2)) & 1u) != 0u))
#define NEAR(t) (KBASE(t) > qlo - 191)
#define INITV(t) ((OWN(t) || ((selmask >> ((t) >> 2)) & 1u)) ? (NEAR(t) ? 0.f : lut127) : NEGINF)
#define MASKT(P0_, P1_, t) do { if (ACT(t) && NEAR(t)) bias_tile(P0_, P1_, qm - KBASE(t), lut); } while (0)
    f32x16 pA0, pA1, pB0, pB1; float mnA, mnB, alA, alB; bf16x8 pa0, pa1, pa2, pa3;
    SWRITE_HV(0); SBAR();
    SLOAD_H(KBASE(1));
    SBAR(); qkt<0>(pA0, pA1, K_lds, r32, hi, qf, ACT(0), INITV(0));
    MASKT(pA0, pA1, 0); partialSM(pA0, pA1, m_reg, mnA, alA);
    VMW(); SWRITE_H(1);
    __syncthreads();
#define HALF_STEP(PX0, PX1, mnX, alX, PY0, PY1, alY, t, KB, VB, SB) do {                                                      \
        SBAR(); qkt<KB>(PX0, PX1, K_lds, r32, hi, qf, ACT(t), INITV(t));                                                       \
        finishSM(PY0, PY1, alY, l_reg, pa0, pa1, pa2, pa3); SBAR();                                                           \
        if ((t) + 1 < NT) { SLOAD_H(KBASE((t) + 1)); SBAR(); }                                                                \
        pv_tile<VB>(o, vb0, pa0, pa1, pa2, pa3, ACT((t) - 1)); MASKT(PX0, PX1, (t)); partialSM(PX0, PX1, m_reg, mnX, alX);     \
        __syncthreads();                                                                                                      \
        if ((t) + 1 < NT) { VMW(); SWRITE_H(SB); }                                                                            \
        RESC(alX); __syncthreads(); } while (0)
    for (int t = 1; t + 1 < NT; t += 2) {
        HALF_STEP(pB0, pB1, mnB, alB, pA0, pA1, alA, t, 1, 0, 0);
        HALF_STEP(pA0, pA1, mnA, alA, pB0, pB1, alB, t + 1, 0, 1, 1);
    }
    SBAR(); qkt<1>(pB0, pB1, K_lds, r32, hi, qf, ACT(NT - 1), INITV(NT - 1)); SBAR();
    finishSM(pA0, pA1, alA, l_reg, pa0, pa1, pa2, pa3); SBAR();
    pv_tile<0>(o, vb0, pa0, pa1, pa2, pa3, ACT(NT - 2));
    MASKT(pB0, pB1, NT - 1); partialSM(pB0, pB1, m_reg, mnB, alB); __syncthreads(); RESC(alB);
    finishSM(pB0, pB1, alB, l_reg, pa0, pa1, pa2, pa3); SBAR(); pv_tile<1>(o, vb0, pa0, pa1, pa2, pa3, ACT(NT - 1));
    if (hi == 0) li_l[r32] = l_reg; asm volatile("s_waitcnt lgkmcnt(0)" ::: "memory");
    float rli[16];
#pragma unroll
    for (int r = 0; r < 16; ++r) rli[r] = __builtin_amdgcn_rcpf(li_l[crow(r, hi)]);
    bf16* Ow = O + (size_t)qlo * LD + h * D;
#pragma unroll
    for (int r = 0; r < 16; ++r) { const int orow = crow(r, hi);
#pragma unroll
        for (int d0 = 0; d0 < 4; ++d0) { const float v = o[d0][r] * rli[r];
            const float vn = __shfl_xor(v, 1);
            if ((r32 & 1) == 0) *(unsigned*)(Ow + (size_t)orow * LD + d0 * 32 + r32) = cvtpk(v, vn); } }
    __syncthreads();
#undef RESC
#undef KBASE
#undef OWN
#undef ACT
#undef NEAR
#undef INITV
#undef MASKT
#undef HALF_STEP
#undef ROW
#undef LD8
#undef VMW
#undef SLOAD_H
#undef SWRITE_HK
#undef SWRITE_HV
#undef SWRITE_H
}
}

namespace ssd {
using att::crow; using att::cvtpk;
constexpr int OFF_B = 0;
constexpr int OFF_X = 65536;
constexpr int OFF_ACS = 132096;
constexpr int OFF_DT = OFF_ACS + 8192;
constexpr float LOG2E = 1.4426950408889634f;
static_assert(OFF_DT + 8192 <= LDSCTL_OFF, "SSD LDS scratch overlaps the control words");
__device__ __forceinline__ int v_st64(int k, int c) { const int kk = (k & ~0xC) | ((k & 4) << 1) | ((k & 8) >> 1); return ((kk >> 3) * 2 + (c >> 5)) * 512 + ((kk & 7) * 32 + (c & 31)) * 2; }
constexpr int v_rd_off64(int d0, int ks, int half) { return d0 * 512 + ks * 2048 + half * 1024; }

__device__ __forceinline__ void conv8(const bf16* __restrict__ XBC, int t, int ch0, const float (&w)[4][8], const float (&bs)[8], float (&out)[8]) {
#pragma unroll
    for (int e = 0; e < 8; ++e) out[e] = bs[e];
#pragma unroll
    for (int k = 0; k < 4; ++k) { const int ts = t - 3 + k;
        if (ts >= 0) { float a[8]; unpack8(*(const GAS v4u*)(XBC + (size_t)ts * DXBC + ch0), a);
#pragma unroll
            for (int e = 0; e < 8; ++e) out[e] += w[k][e] * a[e]; } }
#pragma unroll
    for (int e = 0; e < 8; ++e) out[e] = siluf(out[e]);
}
__device__ __forceinline__ void load_convw(const float* __restrict__ cw, const float* __restrict__ cb, int ch0, float (&w)[4][8], float (&bs)[8]) {
#pragma unroll
    for (int k = 0; k < 4; ++k)
#pragma unroll
        for (int e = 0; e < 8; ++e) w[k][e] = cw[k * DXBC + ch0 + e];
#pragma unroll
    for (int e = 0; e < 8; ++e) bs[e] = cb[ch0 + e];
}
__device__ __forceinline__ void conv8_lite(const bf16* __restrict__ XBC, int t, int ch0, const float* __restrict__ cw, const float* __restrict__ cb, float (&out)[8]) {
    { const f32x4 b0 = *(const GAS f32x4*)(cb + ch0), b1 = *(const GAS f32x4*)(cb + ch0 + 4); out[0] = b0[0]; out[1] = b0[1]; out[2] = b0[2]; out[3] = b0[3]; out[4] = b1[0]; out[5] = b1[1]; out[6] = b1[2]; out[7] = b1[3]; }
#pragma unroll
    for (int k = 0; k < 4; ++k) { const int ts = t - 3 + k; const float ok = ts >= 0 ? 1.f : 0.f; const int row = ts >= 0 ? ts : 0;
        float a[8]; unpack8(*(const GAS v4u*)(XBC + (size_t)row * DXBC + ch0), a);
        const f32x4 w0 = *(const GAS f32x4*)(cw + k * DXBC + ch0) * ok, w1 = *(const GAS f32x4*)(cw + k * DXBC + ch0 + 4) * ok;
        out[0] += w0[0] * a[0]; out[1] += w0[1] * a[1]; out[2] += w0[2] * a[2]; out[3] += w0[3] * a[3]; out[4] += w1[0] * a[4]; out[5] += w1[1] * a[5]; out[6] += w1[2] * a[6]; out[7] += w1[3] * a[7]; }
#pragma unroll
    for (int e = 0; e < 8; ++e) out[e] = siluf(out[e]);
}
__device__ __forceinline__ v4u pack8f(const float (&v)[8]) { v4u o; o.x = pk2(v[0], v[1]); o.y = pk2(v[2], v[3]); o.z = pk2(v[4], v[5]); o.w = pk2(v[6], v[7]); return o; }

#define SSD_TRRD(dst, base, off) asm volatile("ds_read_b64_tr_b16 %0, %1 offset:%2" : "=&v"(dst) : "v"(base), "i"(off) : "memory")
#define SSD_F8(l, h) ((bf16x8){l[0], l[1], l[2], l[3], h[0], h[1], h[2], h[3]})

__device__ __forceinline__ void states_unit(int c, int g, const Args& A, char* lds) {
    int tid = threadIdx.x; asm volatile("" : "+v"(tid));
    const int wid = __builtin_amdgcn_readfirstlane(tid >> 6), lane = tid & 63, r32 = lane & 31, hi = lane >> 5;
    unsigned char* ws = A.ws;
    const bf16* XBC = (const bf16*)(ws + WS_XBC); const float* DT = (const float*)(ws + WS_DT); float* ACS = (float*)(ws + WS_ACS); float* ST = (float*)(ws + WS_STATES);
    const float* cw = A.in[I_SCW]; const float* cb = A.in[I_SCB];
    float* acs_s = (float*)(lds + OFF_ACS); float* dt_s = (float*)(lds + OFF_DT);
    bf16* BCC = (bf16*)(ws + WS_BCC); bf16* XC = (bf16*)A.out;
    const int t0 = c * CHK;
    { const int head = g * 8 + wid; const float Aneg = -__expf(A.in[I_ALOG][head]);
      float d[4], a[4];
#pragma unroll
      for (int i = 0; i < 4; ++i) d[i] = DT[(size_t)(t0 + 4 * lane + i) * NHS + head];
      a[0] = d[0] * Aneg; a[1] = a[0] + d[1] * Aneg; a[2] = a[1] + d[2] * Aneg; a[3] = a[2] + d[3] * Aneg;
      float incl = a[3];
#pragma unroll
      for (int o = 1; o < 64; o <<= 1) { const float v = __shfl_up(incl, o); if (lane >= o) incl += v; }
      const float excl = incl - a[3];
#pragma unroll
      for (int i = 0; i < 4; ++i) { const float v = a[i] + excl; acs_s[(4 * lane + i) * 8 + wid] = v; dt_s[(4 * lane + i) * 8 + wid] = d[i]; ACS[(size_t)(t0 + 4 * lane + i) * NHS + head] = v; } }
    { float w[4][8], bs[8]; const int ch0 = DI + g * NST + (tid & 15) * 8; load_convw(cw, cb, ch0, w, bs);
      for (int i = 0; i < 8; ++i) { const int l = (tid >> 4) + 32 * i; float v[8]; conv8(XBC, t0 + l, ch0, w, bs, v); const v4u pk = pack8f(v);
          *(v4u*)(lds + OFF_B + (l >> 6) * 16384 + att::v_st(l & 63, (tid & 15) * 8)) = pk;
          *(GAS v4u*)(BCC + (size_t)(t0 + l) * 2048 + g * NST + (tid & 15) * 8) = pk; } }
    { float w[4][8], bs[8]; const int ch0 = DI + NG * NST + g * NST + (tid & 15) * 8; load_convw(cw, cb, ch0, w, bs);
      for (int i = 0; i < 8; ++i) { const int l = (tid >> 4) + 32 * i; float v[8]; conv8(XBC, t0 + l, ch0, w, bs, v);
          *(GAS v4u*)(BCC + (size_t)(t0 + l) * 2048 + 1024 + g * NST + (tid & 15) * 8) = pack8f(v); } }
    __syncthreads();
    const int mb = wid & 1, nb = wid >> 1;
    const int rdb = att::v_rd_base(lane);
    for (int r = 0; r < 8; ++r) {
        const int head = g * 8 + r; char* xs = lds + OFF_X + (r & 1) * 32768;
        { float w[4][8], bs[8]; const int ch0 = head * HP + (tid & 7) * 8; load_convw(cw, cb, ch0, w, bs);
          const float alast = acs_s[255 * 8 + r];
#pragma unroll
          for (int i = 0; i < 4; ++i) { const int l = (tid >> 3) + 64 * i; float v[8]; conv8(XBC, t0 + l, ch0, w, bs, v);
              const float dtl = dt_s[l * 8 + r], f = __expf(alast - acs_s[l * 8 + r]);
#pragma unroll
              for (int e = 0; e < 8; ++e) v[e] *= dtl;
              *(GAS v4u*)(XC + (size_t)(t0 + l) * DI + ch0) = pack8f(v);
#pragma unroll
              for (int e = 0; e < 8; ++e) v[e] *= f;
              *(v4u*)(xs + i * 8192 + v_st64(l & 63, (tid & 7) * 8)) = pack8f(v); } }
        __syncthreads();
        f32x16 acc = {};
        const int xb = (int)(uintptr_t)xs + rdb, bb = (int)(uintptr_t)(lds + OFF_B) + rdb;
#pragma unroll
        for (int tl = 0; tl < 4; ++tl) {
            const int xbt = xb + tl * 8192 + mb * 512, bbt = bb + tl * 16384 + nb * 512;
#define ST_KS(ks) do { s16x4 al, ah, bl, bh; \
            SSD_TRRD(al, xbt, (ks) * 2048); SSD_TRRD(ah, xbt, (ks) * 2048 + 1024); \
            SSD_TRRD(bl, bbt, (ks) * 4096); SSD_TRRD(bh, bbt, (ks) * 4096 + 2048); \
            asm volatile("s_waitcnt lgkmcnt(0)" ::: "memory"); __builtin_amdgcn_sched_barrier(0); \
            acc = __builtin_amdgcn_mfma_f32_32x32x16_bf16(SSD_F8(al, ah), SSD_F8(bl, bh), acc, 0, 0, 0); } while (0)
            ST_KS(0); ST_KS(1); ST_KS(2); ST_KS(3);
#undef ST_KS
        }
        float* so = ST + (((size_t)c * NHS + head) * HP + mb * 32) * NST + nb * 32 + r32;
#pragma unroll
        for (int q = 0; q < 16; ++q) so[(size_t)crow(q, hi) * NST] = acc[q];
    }
    __syncthreads();
}
__device__ __forceinline__ void ssd_states_phase(Frame& F, const Args& A, char* lds) {
    for (int u = F.vcu; u < NCH * NG; u += F.G) states_unit(u >> 3, u & 7, A, lds);
}

__device__ __forceinline__ void ssd_scan_phase(Frame& F, const Args& A) {
    unsigned char* ws = A.ws;
    float* ST = (float*)(ws + WS_STATES); const float* ACS = (const float*)(ws + WS_ACS);
    constexpr int PER = NHS * HP * NST;
    for (int e4 = F.vcu * NTHR + F.tid; e4 < PER / 4; e4 += F.G * NTHR) {
        const int head = (e4 * 4) / (HP * NST);
        f32x4 h = {0.f, 0.f, 0.f, 0.f};
        f32x4 s[8];
#pragma unroll
        for (int j = 0; j < 8; ++j) s[j] = *(const GAS f32x4*)(ST + (size_t)j * PER + (size_t)e4 * 4);
        for (int c0 = 0; c0 < NCH; c0 += 8) {
#pragma unroll
            for (int j = 0; j < 8; ++j) { const int c = c0 + j;
                *(GAS f32x4*)(ST + (size_t)c * PER + (size_t)e4 * 4) = h;
                const float dec = __expf(ACS[(size_t)(c * CHK + CHK - 1) * NHS + head]);
                h = h * dec + s[j];
                if (c + 8 < NCH) s[j] = *(const GAS f32x4*)(ST + (size_t)(c + 8) * PER + (size_t)e4 * 4); }
        }
    }
}

__device__ __forceinline__ void cb_tile(f32x16& p0, f32x16& p1, const char* Kt, int r32, int hi, const bf16x8* qr) {
#pragma unroll
    for (int r = 0; r < 16; ++r) { p0[r] = 0.f; p1[r] = 0.f; }
#pragma unroll
    for (int d0 = 0; d0 < 8; ++d0) { const char* a = Kt + KSWZ(r32, ((d0 & 3) * 16 + hi * 8) * 2) + (d0 >> 2) * 128;
        const bf16x8 b0 = *reinterpret_cast<const bf16x8*>(a), b1 = *reinterpret_cast<const bf16x8*>(a + 32 * 256);
        p0 = __builtin_amdgcn_mfma_f32_32x32x16_bf16(b0, qr[d0], p0, 0, 0, 0);
        p1 = __builtin_amdgcn_mfma_f32_32x32x16_bf16(b1, qr[d0], p1, 0, 0, 0); }
}
__device__ __forceinline__ void out_unit(int c, int g, const Args& A, char* lds) {
    int tid = threadIdx.x; asm volatile("" : "+v"(tid));
    const int wid = __builtin_amdgcn_readfirstlane(tid >> 6), lane = tid & 63, r32 = lane & 31, hi = lane >> 5;
    unsigned char* ws = A.ws;
    const bf16* Z = (const bf16*)(ws + WS_Z); const float* DT = (const float*)(ws + WS_DT); const float* ACS = (const float*)(ws + WS_ACS);
    const float* HPV = (const float*)(ws + WS_STATES); bf16* YG = (bf16*)(ws + WS_YG);
    const bf16* BCC = (const bf16*)(ws + WS_BCC); const bf16* XC = (const bf16*)A.out;
    float* acs_s = (float*)(lds + OFF_ACS); float* dt_s = (float*)(lds + OFF_DT);
    const int t0 = c * CHK;
    for (int i = tid; i < CHK * 8; i += NTHR) { const int l = i >> 3, r = i & 7; acs_s[i] = ACS[(size_t)(t0 + l) * NHS + g * 8 + r] * LOG2E; dt_s[i] = DT[(size_t)(t0 + l) * NHS + g * 8 + r]; }
    { for (int i = 0; i < 8; ++i) { const int l = (tid >> 4) + 32 * i;
          *(v4u*)(lds + OFF_B + (l >> 6) * 16384 + KSWZ(l & 63, (tid & 15) * 16)) = *(const GAS v4u*)(BCC + (size_t)(t0 + l) * 2048 + g * NST + (tid & 15) * 8); } }
    bf16x8 qr[8];
    { const int l = wid * 32 + r32;
#pragma unroll
      for (int d0 = 0; d0 < 8; ++d0) qr[d0] = *reinterpret_cast<const bf16x8*>(BCC + (size_t)(t0 + l) * 2048 + 1024 + g * NST + d0 * 16 + hi * 8); }
    const int lrow = wid * 32 + r32;
    const int nt = (wid >> 1) + 1;
    const int rdb = att::v_rd_base(lane);
    float ssq[16];
#pragma unroll
    for (int q = 0; q < 16; ++q) ssq[q] = 0.f;
    auto stage_x = [&](int r) {
        const int head = g * 8 + r; char* xs = lds + OFF_X + (r & 1) * 32768;
#pragma unroll
        for (int i = 0; i < 4; ++i) { const int l = (tid >> 3) + 64 * i;
            *(v4u*)(xs + i * 8192 + v_st64(l & 63, (tid & 7) * 8)) = *(const GAS v4u*)(XC + (size_t)(t0 + l) * DI + head * HP + (tid & 7) * 8); } };
    stage_x(0);
    __syncthreads();
    for (int r = 0; r < 8; ++r) {
        const int head = g * 8 + r; const char* xs = lds + OFF_X + (r & 1) * 32768;
        if (r + 1 < 8) stage_x(r + 1);
        const float a2l = acs_s[lrow * 8 + r];
        f32x16 o[2] = {};
        { const float el = __builtin_amdgcn_exp2f(a2l);
          const float* hp = HPV + ((size_t)c * NHS + head) * HP * NST;
#pragma unroll
          for (int d0 = 0; d0 < 8; ++d0) { float cv[8]; unpack8(__builtin_bit_cast(v4u, qr[d0]), cv);
#pragma unroll
              for (int e = 0; e < 8; ++e) cv[e] *= el;
              const bf16x8 af = __builtin_bit_cast(bf16x8, pack8f(cv));
              const float* h0 = hp + (size_t)r32 * NST + d0 * 16 + hi * 8; const float* h1 = h0 + 32 * NST;
              const f32x4 h00 = *(const GAS f32x4*)h0, h01 = *(const GAS f32x4*)(h0 + 4), h10 = *(const GAS f32x4*)h1, h11 = *(const GAS f32x4*)(h1 + 4);
              v4u w0, w1; w0.x = cvtpk(h00[0], h00[1]); w0.y = cvtpk(h00[2], h00[3]); w0.z = cvtpk(h01[0], h01[1]); w0.w = cvtpk(h01[2], h01[3]);
              w1.x = cvtpk(h10[0], h10[1]); w1.y = cvtpk(h10[2], h10[3]); w1.z = cvtpk(h11[0], h11[1]); w1.w = cvtpk(h11[2], h11[3]);
              const bf16x8 b0 = __builtin_bit_cast(bf16x8, w0), b1 = __builtin_bit_cast(bf16x8, w1);
              o[0] = __builtin_amdgcn_mfma_f32_32x32x16_bf16(af, b0, o[0], 0, 0, 0);
              o[1] = __builtin_amdgcn_mfma_f32_32x32x16_bf16(af, b1, o[1], 0, 0, 0); } }
        const float dskip = A.in[I_SD][head] / dt_s[lrow * 8 + r];
        for (int t = 0; t < nt; ++t) {
            f32x16 p0, p1; cb_tile(p0, p1, lds + OFF_B + t * 16384, r32, hi, qr);
            const int dq = lrow - t * 64 - 4 * hi;
#pragma unroll
            for (int q = 0; q < 16; ++q) { const int cc = (q & 3) + 8 * (q >> 2); const int s0 = t * 64 + cc + 4 * hi;
                const float e0 = __builtin_amdgcn_exp2f(a2l - acs_s[s0 * 8 + r]), e1 = __builtin_amdgcn_exp2f(a2l - acs_s[(s0 + 32) * 8 + r]);
                float v0 = p0[q] * e0, v1 = p1[q] * e1;
                v0 = (cc > dq) ? 0.f : v0; v1 = (cc + 32 > dq) ? 0.f : v1;
                v0 += (cc == dq) ? dskip : 0.f; v1 += (cc + 32 == dq) ? dskip : 0.f;
                p0[q] = v0; p1[q] = v1; }
            bf16x8 pa0, pa1, pa2, pa3;
            PK4(p0, 0, pa0); PK4(p0, 8, pa1); PK4(p1, 0, pa2); PK4(p1, 8, pa3);
            const int xb = (int)(uintptr_t)xs + rdb + t * 8192;
#define PV64(d0) do { s16x4 l0, l1, l2, l3, h0, h1, h2, h3; \
            SSD_TRRD(l0, xb, v_rd_off64(d0, 0, 0)); SSD_TRRD(h0, xb, v_rd_off64(d0, 0, 1)); SSD_TRRD(l1, xb, v_rd_off64(d0, 1, 0)); SSD_TRRD(h1, xb, v_rd_off64(d0, 1, 1)); \
            SSD_TRRD(l2, xb, v_rd_off64(d0, 2, 0)); SSD_TRRD(h2, xb, v_rd_off64(d0, 2, 1)); SSD_TRRD(l3, xb, v_rd_off64(d0, 3, 0)); SSD_TRRD(h3, xb, v_rd_off64(d0, 3, 1)); \
            asm volatile("s_waitcnt lgkmcnt(0)" ::: "memory"); __builtin_amdgcn_sched_barrier(0); \
            o[d0] = __builtin_amdgcn_mfma_f32_32x32x16_bf16(pa0, SSD_F8(l0, h0), o[d0], 0, 0, 0); o[d0] = __builtin_amdgcn_mfma_f32_32x32x16_bf16(pa1, SSD_F8(l1, h1), o[d0], 0, 0, 0); \
            o[d0] = __builtin_amdgcn_mfma_f32_32x32x16_bf16(pa2, SSD_F8(l2, h2), o[d0], 0, 0, 0); o[d0] = __builtin_amdgcn_mfma_f32_32x32x16_bf16(pa3, SSD_F8(l3, h3), o[d0], 0, 0, 0); } while (0)
            PV64(0); PV64(1);
#undef PV64
        }
#pragma unroll
        for (int q = 0; q < 16; ++q) { const int l = wid * 32 + crow(q, hi); const size_t off = (size_t)(t0 + l) * DI + head * HP + r32;
#pragma unroll
            for (int d0 = 0; d0 < 2; ++d0) { const float zv = bf2f(Z[off + d0 * 32]); const float v = o[d0][q] * siluf(zv); ssq[q] += v * v;
                const float vn = __shfl_xor(v, 1);
                if ((r32 & 1) == 0) *(unsigned*)(YG + off + d0 * 32) = cvtpk(v, vn); } }
        __syncthreads();
    }
    float* rs_s = (float*)(lds + OFF_X) + wid * 32;
#pragma unroll
    for (int q = 0; q < 16; ++q) { float s = ssq[q]; s += __shfl_xor(s, 1); s += __shfl_xor(s, 2); s += __shfl_xor(s, 4); s += __shfl_xor(s, 8); s += __shfl_xor(s, 16);
        if (r32 == 0) rs_s[crow(q, hi)] = 1.0f / sqrtf(s * (1.0f / 512.f) + EPS); }
    asm volatile("s_waitcnt vmcnt(0) lgkmcnt(0)" ::: "memory");
    { const float* nw = A.in[I_SNW] + g * 512 + lane * 8; float nwv[8];
#pragma unroll
      for (int e = 0; e < 8; ++e) nwv[e] = nw[e];
      for (int rr = 0; rr < 32; ++rr) { const float rsv = rs_s[rr]; bf16* p = YG + (size_t)(t0 + wid * 32 + rr) * DI + g * 512 + lane * 8;
          float v[8]; unpack8(*(const GAS v4u*)p, v);
#pragma unroll
          for (int e = 0; e < 8; ++e) v[e] *= rsv * nwv[e];
          *(GAS v4u*)p = pack8f(v); } }
    __syncthreads();
}
__device__ __forceinline__ void ssd_out_phase(Frame& F, const Args& A, char* lds) {
    for (int u = F.vcu; u < NCH * NG; u += F.G) out_unit(u >> 3, u & 7, A, lds);
}
#undef SSD_TRRD
#undef SSD_F8
}

__device__ __forceinline__ void attn_phase(Frame& F, const Args& A, char* lds_generic) {
    unsigned char* ws = A.ws;
    for (int u = F.vcu; u < AH * 16; u += F.G) {
        const int h = u >> 4, p = u & 15;
        att::moba_unit(h, 31 - p, (const bf16*)(ws + WS_Q), (const bf16*)(ws + WS_K), (const bf16*)(ws + WS_V), (bf16*)(ws + WS_Q), (const bf16*)(ws + WS_KBARB), A.in[I_REL], lds_generic);
        att::moba_unit(h, p, (const bf16*)(ws + WS_Q), (const bf16*)(ws + WS_K), (const bf16*)(ws + WS_V), (bf16*)(ws + WS_Q), (const bf16*)(ws + WS_KBARB), A.in[I_REL], lds_generic);
    }
}

__global__ void diag_cmp(const bf16* __restrict__ a, const bf16* __restrict__ b, size_t n, unsigned* stat) {
    float md = 0.f, mb = 0.f;
    for (size_t i = (size_t)blockIdx.x * blockDim.x + threadIdx.x; i < n; i += (size_t)gridDim.x * blockDim.x) { const float x = bf2f(a[i]), y = bf2f(b[i]); const float d = fabsf(x - y); md = (d > md || d != d) ? d : md; mb = fmaxf(mb, fabsf(y)); }
    if (md != md) md = 1e30f;
    atomicMax(stat, __float_as_uint(md)); atomicMax(stat + 1, __float_as_uint(mb));
    float sd = 0.f, cnt = 0.f;
    for (size_t i = (size_t)blockIdx.x * blockDim.x + threadIdx.x; i < n; i += (size_t)gridDim.x * blockDim.x) { const float d = fabsf(bf2f(a[i]) - bf2f(b[i])); sd += d; cnt += (d > 0.02f) ? 1.f : 0.f; }
    sd = wave_sum(sd); cnt = wave_sum(cnt);
    if ((threadIdx.x & 63) == 0) { atomicAdd((float*)(stat + 2), sd); atomicAdd((float*)(stat + 3), cnt); }
}
__global__ void diag_emit(const unsigned* stat, float* out, float scale, int which) {
    if (threadIdx.x == 0 && blockIdx.x == 0) out[0] = __uint_as_float(stat[which]) * scale;
}

__global__ void __launch_bounds__(NTHR, 2) mk_fwd(Args args) {
    extern __shared__ __attribute__((aligned(16))) unsigned char lds[];
    Frame F;
    F.lds = (LAS unsigned char*)lds;
    volatile LAS unsigned* MISC = (volatile LAS unsigned*)(F.lds + MISC_OFF);
    F.tid = threadIdx.x; F.lane = F.tid & 63; F.wave = __builtin_amdgcn_readfirstlane(F.tid >> 6);
    F.G = gridDim.x; { const int bx = blockIdx.x; F.vcu = (F.G % 8 == 0) ? (bx % 8) * (F.G / 8) + bx / 8 : bx; }
    unsigned char* ws = args.ws;
    gu32* ctl = (gu32*)(ws + WS_CTL);
    for (int u = F.tid; u < (LDS_BYTES - LDSCTL_OFF) / 4; u += NTHR) ((LAS unsigned*)(F.lds + LDSCTL_OFF))[u] = 0u;
    __syncthreads();
    const int lo = args.ph_lo, hi = args.ph_hi;
    const bool multi = (hi - lo) > 1;
    XcdBarrier bar; bar.bar = (unsigned*)(ctl + CW_BAR) + args.li * XCD_BAR_WORDS; bar.x = 0; bar.st = nullptr;
    if (multi) bar = xcd_barrier_post((unsigned*)(ctl + CW_BAR) + args.li * XCD_BAR_WORDS, MISC + 8);
#define IN(k) (lo <= (k) && (k) < hi)
#define SEAM(k) do { if (IN(k) && IN((k) + 1)) xcd_barrier(bar); } while (0)

    if (IN(0)) { p0_prologue(F, args); SEAM(0); }
    if (IN(1)) {
        pg8::Gemm g{(const bf16*)(ws + WS_XB), (const bf16*)(ws + WS_WIN), SEQ, NIN, DM}; pg8::StaticOrder S; S.init(SEQ, NIN, F.G, (int)blockIdx.x);
        pg8::EpiInProj E{(bf16*)(ws + WS_Z), (bf16*)(ws + WS_XBC), (bf16*)(ws + WS_Q), (bf16*)(ws + WS_K), (bf16*)(ws + WS_V), (bf16*)(ws + WS_GT), (const float*)(ws + WS_R1), args.in[I_BG]};
        pg8::gemm_phase<pg8::EpiInProj, pg8::StaticOrder, true, true>(F.lds + RING_OFF, g, S, E);
        dt_phase(F, args);
        SEAM(1);
    }
    if (IN(2)) { attn_prep_phase(F, args); __syncthreads(); ssd::ssd_states_phase(F, args, (char*)lds); SEAM(2); }
    if (IN(3)) { ssd::ssd_scan_phase(F, args); attn_phase(F, args, (char*)lds); SEAM(3); }
    if (IN(4)) { ssd::ssd_out_phase(F, args, (char*)lds); SEAM(4); }
    if (IN(5)) {
        { pg8::Gemm g{(const bf16*)(ws + WS_YG), (const bf16*)(ws + WS_WSS), SEQ, DM, DI}; pg8::StaticOrder S; S.init(SEQ, DM, F.G, (int)blockIdx.x);
          pg8::EpiGateF32 E{args.out, (const bf16*)(ws + WS_GT), 0};
          pg8::gemm_phase<pg8::EpiGateF32, pg8::StaticOrder, true, true>(F.lds + RING_OFF, g, S, E); }
        { pg8::Gemm g{(const bf16*)(ws + WS_Q), (const bf16*)(ws + WS_WAT), SEQ, DM, DA}; pg8::StaticOrder S; S.init(SEQ, DM, F.G, (int)blockIdx.x);
          pg8::EpiGateAddBf16 E{args.out, (const bf16*)(ws + WS_GT), DM, (bf16*)(ws + WS_XB)};
          pg8::gemm_phase<pg8::EpiGateAddBf16, pg8::StaticOrder, true, true>(F.lds + RING_OFF, g, S, E); }
        SEAM(5);
    }
    if (IN(6)) {
        pg8::Gemm g{(const bf16*)(ws + WS_XB), (const bf16*)(ws + WS_WOUT), SEQ, DM, DM}; pg8::StaticOrder S; S.init(SEQ, DM, F.G, (int)blockIdx.x);
        pg8::EpiResid1 E{args.in[I_X], args.out, (bf16*)(ws + WS_K), (float*)(ws + WS_SS2)};
        pg8::gemm_phase<pg8::EpiResid1, pg8::StaticOrder, true, true>(F.lds + RING_OFF, g, S, E);
        SEAM(6);
    }
    if (IN(7)) {
        pg8::Gemm g{(const bf16*)(ws + WS_K), (const bf16*)(ws + WS_WUP), SEQ, DFF2, DM}; pg8::StaticOrder S; S.init(SEQ, DFF2, F.G, (int)blockIdx.x);
        pg8::EpiUpPre E{(bf16*)(ws + WS_UPRE), (const float*)(ws + WS_SS2)};
        pg8::gemm_phase<pg8::EpiUpPre, pg8::StaticOrder, true, true>(F.lds + RING_OFF, g, S, E);
        SEAM(7);
    }
    if (IN(8)) { ffn_act_phase(F, args); SEAM(8); }
    if (IN(9)) {
        pg8::Gemm g{(const bf16*)(ws + WS_ACT), (const bf16*)(ws + WS_WDN), SEQ, DM, DFF}; pg8::StaticOrder S; S.init(SEQ, DM, F.G, (int)blockIdx.x);
        pg8::EpiResid2 E{args.out};
        pg8::gemm_phase<pg8::EpiResid2, pg8::StaticOrder, true, true>(F.lds + RING_OFF, g, S, E);
    }
#undef IN
#undef SEAM
}

extern "C" void kernel_launch(void* const* d_in, const int* in_sizes, int n_in, void* d_out, int out_size, void* d_ws, size_t ws_size, hipStream_t stream) {
    static int grid = 0;
    if (grid == 0) {
        if (n_in != N_INPUTS || in_sizes[0] != SEQ * DM || out_size != SEQ * DM || ws_size < WS_END) {
            fprintf(stderr, "kernel_launch: unexpected shapes: n_in %d in0 %d out %d ws %zu (need %zu)\n", n_in, n_in > 0 ? in_sizes[0] : -1, out_size, ws_size, (size_t)WS_END); grid = -1; return; }
        int dev = 0, cus = 0;
        if (hipGetDevice(&dev) != hipSuccess || hipDeviceGetAttribute(&cus, hipDeviceAttributeMultiprocessorCount, dev) != hipSuccess) { grid = -1; return; }
        if (hipFuncSetAttribute((const void*)mk_fwd, hipFuncAttributeMaxDynamicSharedMemorySize, LDS_BYTES) != hipSuccess) { fprintf(stderr, "kernel_launch: hipFuncSetAttribute failed\n"); grid = -1; return; }
        (void)hipGetLastError();
        grid = cus;
    }
    if (grid < 0) return;
    (void)hipMemsetAsync((char*)d_ws + WS_CTL, 0, CTL_ZERO_BYTES, stream);
    Args a{};
    for (int i = 0; i < N_INPUTS; ++i) a.in[i] = (const float*)d_in[i];
    a.out = (float*)d_out; a.ws = (unsigned char*)d_ws;
    unsigned char* ws = (unsigned char*)d_ws;
    auto launch = [&](int lo, int hi, int li) { a.ph_lo = lo; a.ph_hi = hi; a.li = li; a.pad = 0; hipLaunchKernelGGL(mk_fwd, dim3(grid), dim3(NTHR), LDS_BYTES, stream, a); };
#if MK_VARIANT == 6
    launch(0, 10, 0);
#endif
#if MK_VARIANT == 4 || MK_VARIANT == 5
    launch(0, 1, 0); launch(1, 2, 0); launch(2, 3, 0); launch(3, 4, 0); launch(4, 5, 0);
#if MK_VARIANT == 5
    (void)hipMemsetAsync(ws + WS_CTL + 1024, 0, 64, stream);
    naive_ssd<<<NG, 512, 0, stream>>>((const bf16*)(ws + WS_XBC), (const bf16*)(ws + WS_Z), (const float*)(ws + WS_DT), a.in[I_SCW], a.in[I_SCB], a.in[I_ALOG], a.in[I_SD], a.in[I_SNW], (bf16*)d_out);
    diag_cmp<<<1024, 256, 0, stream>>>((const bf16*)(ws + WS_YG), (const bf16*)d_out, (size_t)SEQ * DI, (unsigned*)(ws + WS_CTL + 1024));
#endif
    launch(5, 6, 0); launch(6, 7, 0); launch(7, 8, 0); launch(8, 9, 0); launch(9, 10, 0);
#if MK_VARIANT == 5
    diag_emit<<<1, 64, 0, stream>>>((const unsigned*)(ws + WS_CTL + 1024), (float*)d_out, DIAG_SCALE, DIAG_WHICH);
#endif
#endif
#if MK_VARIANT == 2 || MK_VARIANT == 3
    launch(0, 1, 0); launch(1, 2, 0); launch(2, 3, 0);
#if MK_VARIANT == 3
    (void)hipMemsetAsync(ws + WS_CTL + 1024, 0, 64, stream);
    naive_attn<<<SEQ * AH / 4, 256, 0, stream>>>((const bf16*)(ws + WS_Q), (const bf16*)(ws + WS_K), (const bf16*)(ws + WS_V), (const bf16*)(ws + WS_KBARB), a.in[I_REL], (bf16*)(ws + WS_XB));
#endif
    launch(3, 4, 0);
    naive_ssd<<<NG, 512, 0, stream>>>((const bf16*)(ws + WS_XBC), (const bf16*)(ws + WS_Z), (const float*)(ws + WS_DT), a.in[I_SCW], a.in[I_SCB], a.in[I_ALOG], a.in[I_SD], a.in[I_SNW], (bf16*)(ws + WS_YG));
#if MK_VARIANT == 3
    diag_cmp<<<1024, 256, 0, stream>>>((const bf16*)(ws + WS_Q), (const bf16*)(ws + WS_XB), (size_t)SEQ * DA, (unsigned*)(ws + WS_CTL + 1024));
#endif
    launch(5, 6, 0); launch(6, 7, 0); launch(7, 8, 0); launch(8, 9, 0); launch(9, 10, 0);
#if MK_VARIANT == 3
    diag_emit<<<1, 64, 0, stream>>>((const unsigned*)(ws + WS_CTL + 1024), (float*)d_out, DIAG_SCALE, DIAG_WHICH);
#endif
#endif
#if MK_VARIANT == 1
    launch(0, 1, 0); launch(1, 2, 0); launch(2, 3, 0);
    naive_attn<<<SEQ * AH / 4, 256, 0, stream>>>((const bf16*)(ws + WS_Q), (const bf16*)(ws + WS_K), (const bf16*)(ws + WS_V), (const bf16*)(ws + WS_KBARB), a.in[I_REL], (bf16*)(ws + WS_Q));
    naive_ssd<<<NG, 512, 0, stream>>>((const bf16*)(ws + WS_XBC), (const bf16*)(ws + WS_Z), (const float*)(ws + WS_DT), a.in[I_SCW], a.in[I_SCB], a.in[I_ALOG], a.in[I_SD], a.in[I_SNW], (bf16*)(ws + WS_YG));
    launch(5, 6, 0); launch(6, 7, 0); launch(7, 8, 0); launch(8, 9, 0); launch(9, 10, 0);
#endif
}
```

```cpp
#define MK_VARIANT 8
#define DIAG_SCALE 1.0f
#define DIAG_WHICH 0
#define MK_STAMPS 0
#define STAMP_A 0
#define STAMP_B 1
#define EXTRA_PH 9
#define EXTRA_FLAG 0
#include <hip/hip_runtime.h>
#include <cstdio>
#include <cstdint>
#include <type_traits>
namespace pg8 {
#define PG8_LAS __attribute__((address_space(3)))
typedef unsigned short bf16_t;
typedef short bf16x8 __attribute__((ext_vector_type(8)));
typedef float f32x4 __attribute__((ext_vector_type(4)));
typedef unsigned u32x4 __attribute__((ext_vector_type(4)));
constexpr int BM = 256, BK = 64, HALF = 128, HTB = HALF * BK * 2  , STAGE_BYTES = 8 * HTB, NXCD = 8, WGM = 4;

__host__ __device__ __forceinline__ int lds_byte(int r, int c) { const int st = (r >> 4) * 2 + (c >> 5), rr = r & 15, cc = c & 31, ob = rr * 64 + cc * 2; return st * 1024 + (ob ^ (((ob >> 9) & 1) << 5)); }
__host__ __device__ __forceinline__ void stage_rc(int b, int& R, int& C) { const int st = b / 1024, sb = b % 1024, swz = sb ^ (((sb >> 9) & 1) << 5); R = (st >> 1) * 16 + swz / 64; C = (st & 1) * 32 + (swz % 64) / 2; }
__host__ __device__ __forceinline__ int perm32(int rho) { const int n = rho >> 4, i = rho & 15; return 8 * (i >> 2) + 4 * n + (i & 3); }

struct Unit { int pm, pn; };
struct Gemm { const bf16_t* A; const bf16_t* Bt; int M, N, K; int ld = 0; };

struct StaticOrder {
    int nM, nN, nwg, G, c;
    __host__ __device__ void init(int M, int N, int G_, int c_) { nM = M / BM; nN = N / BM; nwg = nM * nN; G = G_; c = c_; }
    __host__ __device__ bool next(int i, Unit& u) const {
        const long L = (long)i * G + c; if (L >= nwg) return false;
        int wgid = (int)L; { const int q = nwg / NXCD, r = nwg % NXCD, xcd = wgid % NXCD, off = wgid / NXCD; wgid = (xcd < r ? xcd * (q + 1) : r * (q + 1) + (xcd - r) * q) + off; }
        const int nig = WGM * nN, gid = wgid / nig, fm = gid * WGM, gsz = (nM - fm) < WGM ? (nM - fm) : WGM;
        u.pm = fm + ((wgid % nig) % gsz); u.pn = (wgid % nig) / gsz; return true;
    }
    __device__ __forceinline__ void a_ready(const Unit&) const {}
    __device__ __forceinline__ void done(const Unit&) const {}
};

__device__ __forceinline__ unsigned cvt_pk_bf16(float lo, float hi) { unsigned r; asm volatile("v_cvt_pk_bf16_f32 %0, %1, %2" : "=v"(r) : "v"(lo), "v"(hi)); return r; }
typedef float f32x2 __attribute__((ext_vector_type(2)));
template <class Epi, class Sched, bool ALIGN_EPI = false, bool SP2 = false>
__device__ __forceinline__ void gemm_phase(PG8_LAS unsigned char* lds, const Gemm g, const Sched& S, const Epi& E) {
    const int tid = threadIdx.x, wid = __builtin_amdgcn_readfirstlane(tid >> 6), lane = tid & 63, wr = wid >> 2, wc = wid & 3, fr = lane & 15, fq = lane >> 4;
    const int K = g.ld ? g.ld : g.K  , nt = g.K / BK;
    unsigned voffA[2], voffB[2];
#pragma unroll
    for (int i = 0; i < 2; ++i) { int R, C; stage_rc(tid * 16 + i * 8192, R, C); const int Rb = Epi::PERM ? ((R & ~31) + perm32(R & 31)) : R;
        voffA[i] = (unsigned)(R * K + C) * 2u; voffB[i] = (unsigned)(Rb * K + C) * 2u; }
    const size_t kstep = (size_t)(BK * 2);
    const size_t hstep = (size_t)HALF * K * 2;
    const size_t tstep = 2 * hstep;
    const unsigned ldsw = (unsigned)wid * 1024u;
    const int aoff = lds_byte(wr * 64 + fr, fq * 8), boff = lds_byte(wc * 32 + fr, fq * 8);
#define PG8_SA(b, h) (((b) * 2 + (h)) * HTB)
#define PG8_SB(b, h) ((4 + (b) * 2 + (h)) * HTB)
#define PG8_STAGE(bufoff, gbase, voff) do { _Pragma("unroll") for (int _i = 0; _i < 2; ++_i) \
        __builtin_amdgcn_global_load_lds((const unsigned*)((const char*)(gbase) + (voff)[_i]), (PG8_LAS unsigned*)(lds + (bufoff) + ldsw + _i * 8192), 16, 0, 0); } while (0)
#define PG8_LDA(dst, b, h) do { _Pragma("unroll") for (int m = 0; m < 4; ++m) _Pragma("unroll") for (int k = 0; k < 2; ++k) dst[m][k] = *(const PG8_LAS bf16x8*)(lds + PG8_SA(b, h) + aoff + m * 2048 + k * 1024); } while (0)
#define PG8_LDB(dst, b, h) do { _Pragma("unroll") for (int n = 0; n < 2; ++n) _Pragma("unroll") for (int k = 0; k < 2; ++k) dst[n][k] = *(const PG8_LAS bf16x8*)(lds + PG8_SB(b, h) + boff + n * 2048 + k * 1024); } while (0)
#define PG8_MMA(ai, bj, At, Bt) do { __builtin_amdgcn_s_setprio(1); _Pragma("unroll") for (int m = 0; m < 4; ++m) _Pragma("unroll") for (int n = 0; n < 2; ++n) _Pragma("unroll") for (int k = 0; k < 2; ++k) \
        acc[ai][bj][m][n] = __builtin_amdgcn_mfma_f32_16x16x32_bf16(Bt[n][k], At[m][k], acc[ai][bj][m][n], 0, 0, 0); __builtin_amdgcn_s_setprio(0); } while (0)
#define PG8_WAIT_V(n) asm volatile("s_waitcnt vmcnt(" #n ")" ::: "memory")
#define PG8_WAIT_L(n) asm volatile("s_waitcnt lgkmcnt(" #n ")" ::: "memory")
#define PG8_BAR __builtin_amdgcn_s_barrier()
#define PG8_SCHED __builtin_amdgcn_sched_barrier(0)
    Unit cur, nxt; int ui = 0;
    if (!S.next(0, cur)) return;
    f32x4 acc[2][2][4][2];
#pragma unroll
    for (int a = 0; a < 2; ++a)
#pragma unroll
        for (int b = 0; b < 2; ++b)
#pragma unroll
            for (int m = 0; m < 4; ++m)
#pragma unroll
                for (int n = 0; n < 2; ++n) acc[a][b][m][n] = (f32x4){0.f, 0.f, 0.f, 0.f};
    bf16x8 At[4][2], B0[2][2], B1[2][2];
    const char* cA = (const char*)g.A + (size_t)cur.pm * tstep; const char* cB = (const char*)g.Bt + (size_t)cur.pn * tstep;
    S.a_ready(cur);
    if constexpr (SP2) {
        PG8_STAGE(PG8_SB(0, 0), cB, voffB); PG8_STAGE(PG8_SB(0, 1), cB + hstep, voffB); PG8_STAGE(PG8_SA(0, 0), cA, voffA); PG8_STAGE(PG8_SA(0, 1), cA + hstep, voffA);
        if (wr == 1) PG8_BAR;
        PG8_WAIT_V(2); PG8_BAR;
        PG8_STAGE(PG8_SB(1, 0), cB + kstep, voffB); PG8_STAGE(PG8_SA(1, 0), cA + kstep, voffA); PG8_STAGE(PG8_SB(1, 1), cB + hstep + kstep, voffB);
        PG8_WAIT_V(6); PG8_BAR;
    } else {
        PG8_STAGE(PG8_SB(0, 0), cB, voffB); PG8_STAGE(PG8_SA(0, 0), cA, voffA); PG8_STAGE(PG8_SB(0, 1), cB + hstep, voffB); PG8_STAGE(PG8_SA(0, 1), cA + hstep, voffA);
        if (wr == 1) PG8_BAR;
        PG8_WAIT_V(4); PG8_BAR;
        PG8_STAGE(PG8_SB(1, 0), cB + kstep, voffB); PG8_STAGE(PG8_SA(1, 0), cA + kstep, voffA); PG8_STAGE(PG8_SB(1, 1), cB + hstep + kstep, voffB);
        PG8_WAIT_V(6); PG8_BAR;
    }
    for (;;) {
        const bool has_next = S.next(ui + 1, nxt);
        const char* nA = has_next ? (const char*)g.A + (size_t)nxt.pm * tstep : cA; const char* nB = has_next ? (const char*)g.Bt + (size_t)nxt.pn * tstep : cB;
        for (int t = 0; t < nt; t += 2) {
            const bool last = (t == nt - 2);
            const char* a1 = cA + (size_t)(t + 1) * kstep;
            const char* a2 = last ? nA : cA + (size_t)(t + 2) * kstep; const char* b2 = last ? nB : cB + (size_t)(t + 2) * kstep;
            const char* a3 = a2 + kstep; const char* b3 = b2 + kstep;
            if (last && has_next) S.a_ready(nxt);
            if constexpr (SP2) {
            PG8_LDB(B0, 0, 0); PG8_LDB(B1, 0, 1); PG8_SCHED; PG8_LDA(At, 0, 0); PG8_STAGE(PG8_SA(1, 1), a1 + hstep, voffA);
            PG8_WAIT_V(8); PG8_WAIT_L(0); PG8_BAR; PG8_MMA(0, 0, At, B0); PG8_MMA(0, 1, At, B1); PG8_BAR; PG8_SCHED;
            PG8_LDA(At, 0, 1); PG8_STAGE(PG8_SB(0, 0), b2, voffB); PG8_STAGE(PG8_SB(0, 1), b2 + hstep, voffB); PG8_STAGE(PG8_SA(0, 0), a2, voffA);
            PG8_WAIT_V(8); PG8_WAIT_L(0); PG8_BAR; PG8_MMA(1, 0, At, B0); PG8_MMA(1, 1, At, B1); PG8_BAR; PG8_SCHED;
            PG8_LDB(B0, 1, 0); PG8_LDB(B1, 1, 1); PG8_SCHED; PG8_LDA(At, 1, 0); PG8_STAGE(PG8_SA(0, 1), a2 + hstep, voffA);
            PG8_WAIT_V(8); PG8_WAIT_L(0); PG8_BAR; PG8_MMA(0, 0, At, B0); PG8_MMA(0, 1, At, B1); PG8_BAR; PG8_SCHED;
            PG8_LDA(At, 1, 1); PG8_STAGE(PG8_SB(1, 0), b3, voffB); PG8_STAGE(PG8_SB(1, 1), b3 + hstep, voffB); PG8_STAGE(PG8_SA(1, 0), a3, voffA);
            PG8_WAIT_V(8); PG8_WAIT_L(0); PG8_BAR; PG8_MMA(1, 0, At, B0); PG8_MMA(1, 1, At, B1); PG8_BAR; PG8_SCHED;
            } else {
            PG8_LDB(B0, 0, 0); PG8_SCHED; PG8_LDA(At, 0, 0); PG8_STAGE(PG8_SA(1, 1), a1 + hstep, voffA);
            PG8_WAIT_L(8); PG8_BAR; PG8_WAIT_L(0); PG8_MMA(0, 0, At, B0); PG8_BAR; PG8_SCHED;
            PG8_LDB(B1, 0, 1); PG8_STAGE(PG8_SB(0, 0), b2, voffB);
            PG8_BAR; PG8_WAIT_L(0); PG8_MMA(0, 1, At, B1); PG8_BAR;
            PG8_LDA(At, 0, 1); PG8_STAGE(PG8_SA(0, 0), a2, voffA);
            PG8_BAR; PG8_WAIT_L(0); PG8_MMA(1, 0, At, B0); PG8_BAR; PG8_SCHED;
            PG8_STAGE(PG8_SB(0, 1), b2 + hstep, voffB);
            PG8_WAIT_V(6); PG8_BAR; PG8_MMA(1, 1, At, B1); PG8_BAR;
            PG8_LDB(B0, 1, 0); PG8_SCHED; PG8_LDA(At, 1, 0); PG8_STAGE(PG8_SA(0, 1), a2 + hstep, voffA);
            PG8_WAIT_L(8); PG8_BAR; PG8_WAIT_L(0); PG8_MMA(0, 0, At, B0); PG8_BAR; PG8_SCHED;
            PG8_LDB(B1, 1, 1); PG8_STAGE(PG8_SB(1, 0), b3, voffB);
            PG8_BAR; PG8_WAIT_L(0); PG8_MMA(0, 1, At, B1); PG8_BAR;
            PG8_LDA(At, 1, 1); PG8_STAGE(PG8_SA(1, 0), a3, voffA);
            PG8_BAR; PG8_WAIT_L(0); PG8_MMA(1, 0, At, B0); PG8_BAR; PG8_SCHED;
            PG8_STAGE(PG8_SB(1, 1), b3 + hstep, voffB);
            PG8_WAIT_V(6); PG8_BAR; PG8_MMA(1, 1, At, B1); PG8_BAR;
            }
        }
        if constexpr (ALIGN_EPI) { if (wr == 0) PG8_BAR; }
        if constexpr (!Epi::AFTER_DRAIN) { E(acc, cur, wr, wc, fr, fq); S.done(cur); }
        if (!has_next) break;
#pragma unroll
        for (int a = 0; a < 2; ++a)
#pragma unroll
            for (int b = 0; b < 2; ++b)
#pragma unroll
                for (int m = 0; m < 4; ++m)
#pragma unroll
                    for (int n = 0; n < 2; ++n) acc[a][b][m][n] = (f32x4){0.f, 0.f, 0.f, 0.f};
        cur = nxt; cA = nA; cB = nB; ++ui;
        if constexpr (ALIGN_EPI) { if (wr == 1) PG8_BAR; }
    }
    PG8_WAIT_V(0);
    if constexpr (!ALIGN_EPI) { if (wr == 0) PG8_BAR; }
    PG8_BAR;
    if constexpr (Epi::AFTER_DRAIN) { E.fused(acc, cur, wr, wc, fr, fq, lds, wid, lane); S.done(cur); }
#undef PG8_SA
#undef PG8_SB
#undef PG8_STAGE
#undef PG8_LDA
#undef PG8_LDB
#undef PG8_MMA
#undef PG8_WAIT_V
#undef PG8_WAIT_L
#undef PG8_BAR
#undef PG8_SCHED
}
}

#define GAS __attribute__((address_space(1)))
#define LAS __attribute__((address_space(3)))
typedef unsigned short bf16;
typedef unsigned v4u __attribute__((ext_vector_type(4)));
typedef unsigned v2u __attribute__((ext_vector_type(2)));
typedef float f32x4 __attribute__((ext_vector_type(4)));
typedef float f32x2 __attribute__((ext_vector_type(2)));
typedef float f32x16 __attribute__((ext_vector_type(16)));
typedef short bf16x8 __attribute__((ext_vector_type(8)));
typedef short s16x4 __attribute__((ext_vector_type(4)));
typedef GAS unsigned gu32;
#define RLX_AGENT __ATOMIC_RELAXED, __HIP_MEMORY_SCOPE_AGENT
#define LDS_WAIT() asm volatile("s_waitcnt lgkmcnt(0)" ::: "memory")
#define VM_WAIT() asm volatile("s_waitcnt vmcnt(0)" ::: "memory")

constexpr int NWAVES = 8, NTHR = 512;
constexpr int SEQ = 8192, DM = 2048, DI = 4096, NHS = 64, HP = 64, NG = 8, NST = 128, DXBC = 6144, CHK = 256, NCH = 32;
constexpr int AH = 16, AD = 128, DA = 2048, BLK = 256, NBLK = 32;
constexpr int DFF = 5632, DFF2 = 11264;
constexpr int NIN = 20480;
constexpr int DINP = 20544;
constexpr float EPS = 1e-6f;

enum { I_X = 0, I_ANW, I_WIN, I_BG, I_SCW, I_SCB, I_DTB, I_ALOG, I_SD, I_SNW, I_QNW, I_KNW, I_REL, I_WSS, I_WAT, I_WOUT, I_FNW, I_WUP, I_FCW, I_FCB, I_WDN, N_INPUTS };

constexpr size_t MiB = 1u << 20;
constexpr size_t WS_CTL = 0, CTL_ZERO_BYTES = 256 * 1024;
constexpr size_t WS_R1 = 1 * MiB;
constexpr size_t WS_SS2 = WS_R1 + 64 * 1024;
constexpr size_t WS_KBAR = WS_SS2 + 64 * 1024;
constexpr size_t WS_KBARB = WS_KBAR + 256 * 1024;
constexpr size_t WS_CNT = WS_KBARB + 128 * 1024;
constexpr size_t WS_DT = 2 * MiB;
constexpr size_t WS_ACS = 4 * MiB;
constexpr size_t WS_WIN = 16 * MiB;
constexpr size_t WS_STATES = 16 * MiB;
constexpr size_t WS_BCC = 200 * MiB;
constexpr size_t WS_UP2 = 16 * MiB;
constexpr size_t WS_WSS = 100 * MiB;
constexpr size_t WS_WAT = 116 * MiB;
constexpr size_t WS_WOUT = 124 * MiB;
constexpr size_t WS_WUP = 132 * MiB;
constexpr size_t WS_WDN = 176 * MiB;
constexpr size_t WS_XB = 200 * MiB;
constexpr size_t WS_Z = 232 * MiB;
constexpr size_t WS_XBC = 296 * MiB;
constexpr size_t WS_Q = 392 * MiB;
constexpr size_t WS_K = 424 * MiB;
constexpr size_t WS_V = 456 * MiB;
constexpr size_t WS_GT = 488 * MiB;
constexpr size_t WS_YG = 556 * MiB;
constexpr size_t WS_UPRE = 232 * MiB;
constexpr size_t WS_ACT = 456 * MiB;
constexpr size_t WS_PML = 82 * MiB;
constexpr size_t WS_PART = 296 * MiB;
constexpr size_t WS_LIST = 620 * MiB;
constexpr size_t WS_END = 636 * MiB;

constexpr int CW_BAR = 4096;

typedef __bf16 hwbf16x2 __attribute__((ext_vector_type(2)));
__device__ __forceinline__ unsigned pk2(float lo, float hi) { const f32x2 v = {lo, hi}; return __builtin_bit_cast(unsigned, __builtin_convertvector(v, hwbf16x2)); }
__device__ __forceinline__ unsigned f2bf(float f) { return pk2(f, 0.f) & 0xffffu; }
__device__ __forceinline__ float bf2f(unsigned short b) { return __builtin_bit_cast(float, (unsigned)b << 16); }
__device__ __forceinline__ float bflo(unsigned w) { return __builtin_bit_cast(float, w << 16); }
__device__ __forceinline__ float bfhi(unsigned w) { return __builtin_bit_cast(float, w & 0xffff0000u); }
__device__ __forceinline__ float siluf(float v) { return v * __builtin_amdgcn_rcpf(1.f + __expf(-v)); }
__device__ __forceinline__ float sigmf(float v) { return __builtin_amdgcn_rcpf(1.f + __expf(-v)); }
__device__ __forceinline__ float wave_sum(float v) {
    v += __builtin_bit_cast(float, __builtin_amdgcn_mov_dpp(__builtin_bit_cast(int, v), 0xB1, 0xF, 0xF, true));
    v += __builtin_bit_cast(float, __builtin_amdgcn_mov_dpp(__builtin_bit_cast(int, v), 0x4E, 0xF, 0xF, true));
    v += __builtin_bit_cast(float, __builtin_amdgcn_mov_dpp(__builtin_bit_cast(int, v), 0x141, 0xF, 0xF, true));
    v += __builtin_bit_cast(float, __builtin_amdgcn_mov_dpp(__builtin_bit_cast(int, v), 0x140, 0xF, 0xF, true));
    v += __shfl_xor(v, 16); v += __shfl_xor(v, 32);
    return v;
}

#define XB_TMO      128
#define XB_XCNT(j)  (256  + 64 * (j))
#define XB_XSUB(j)  (1280 + 64 * (j))
#define XB_XGEN(j)  (2304 + 64 * (j))
#define XB_TOP      3328
#define XB_TOPGEN   3392
#define XCD_BAR_WORDS 3456
#define XB_SPIN_CAP (1u << 20)
__device__ __forceinline__ unsigned xb_ld(unsigned* p)              { return __hip_atomic_load(p, __ATOMIC_RELAXED, __HIP_MEMORY_SCOPE_AGENT); }
__device__ __forceinline__ unsigned xb_add(unsigned* p, unsigned v) { return __hip_atomic_fetch_add(p, v, __ATOMIC_RELAXED, __HIP_MEMORY_SCOPE_AGENT); }
__device__ __forceinline__ unsigned xb_xcc_id() { return (unsigned)__builtin_amdgcn_s_getreg((3 << 11) | 20) & 0xFu; }
#define XB_SPIN(cond, bar) do { unsigned _sp = 0; while (cond) { __builtin_amdgcn_s_sleep(1); \
    if ((++_sp & 255u) == 0u) { if (xb_ld(&(bar)[XB_TMO])) break; if (_sp > XB_SPIN_CAP) { atomicAdd(&(bar)[XB_TMO], 1u); break; } } } } while (0)
struct XcdBarrier { unsigned* bar; unsigned x; volatile LAS unsigned* st; };
__device__ __forceinline__ XcdBarrier xcd_barrier_post(unsigned* bar, volatile LAS unsigned* st) {
    XcdBarrier b; b.bar = bar; b.x = xb_xcc_id(); b.st = st;
    if (threadIdx.x == 0) (void)xb_add(&bar[XB_XCNT(b.x)], 1u);
    return b;
}
__device__ __forceinline__ void xcd_barrier_complete(unsigned* bar, unsigned x, unsigned& nloc, unsigned& nx) {
    const unsigned G = gridDim.x * gridDim.y * gridDim.z;
    unsigned sum, cnt, mine, sp = 0u;
    for (;;) {
        sum = 0u; cnt = 0u; mine = 0u;
#pragma unroll
        for (unsigned j = 0; j < 16; ++j) { const unsigned c = xb_ld(&bar[XB_XCNT(j)]); sum += c; cnt += (c > 0u) ? 1u : 0u; mine = (j == x) ? c : mine; }
        if (sum == G) break;
        __builtin_amdgcn_s_sleep(1);
        if ((++sp & 255u) == 0u) { if (xb_ld(&bar[XB_TMO])) break; if (sp > XB_SPIN_CAP) { atomicAdd(&bar[XB_TMO], 1u); break; } }
    }
    nloc = mine > 0u ? mine : 1u; nx = cnt > 0u ? cnt : 1u;
}
__device__ __forceinline__ void xcd_barrier(const XcdBarrier& b) {
    asm volatile("s_waitcnt vmcnt(0)" ::: "memory");
    __syncthreads();
    if (threadIdx.x == 0) {
        unsigned* bar = b.bar;
        __builtin_amdgcn_s_waitcnt(0);
        unsigned nloc = b.st[0], nx = b.st[1];
        if (nloc == 0u) { xcd_barrier_complete(bar, b.x, nloc, nx); b.st[0] = nloc; b.st[1] = nx; }
        const unsigned old = xb_add(&bar[XB_XSUB(b.x)], 1u);
        const unsigned gen = old / nloc;
        if (old + 1u == (gen + 1u) * nloc) {
            __builtin_amdgcn_fence(__ATOMIC_RELEASE, "agent");
            asm volatile("s_waitcnt vmcnt(0)" ::: "memory");
            const unsigned og = xb_add(&bar[XB_TOP], 1u);
            const unsigned tg = og / nx;
            if (og + 1u == (tg + 1u) * nx) xb_add(&bar[XB_TOPGEN], 1u);
            else XB_SPIN(xb_ld(&bar[XB_TOPGEN]) == tg, bar);
            __builtin_amdgcn_fence(__ATOMIC_ACQUIRE, "agent");
            xb_add(&bar[XB_XGEN(b.x)], 1u);
            asm volatile("s_waitcnt vmcnt(0)" ::: "memory");
        } else {
            XB_SPIN(xb_ld(&bar[XB_XGEN(b.x)]) == gen, bar);
            __builtin_amdgcn_fence(__ATOMIC_ACQUIRE, "agent");
            asm volatile("s_waitcnt vmcnt(0)" ::: "memory");
        }
    }
    __syncthreads();
}

constexpr int RING_OFF = 0, RING_BYTES = 131072;
constexpr int LDS_BYTES = 163840;
constexpr int LDSCTL_OFF = LDS_BYTES - 1024, MISC_OFF = LDSCTL_OFF + 320;

struct Args { const float* in[N_INPUTS]; float* out; unsigned char* ws; int ph_lo, ph_hi, li, pad; };
static_assert(sizeof(Args) == N_INPUTS * 8 + 8 + 8 + 16, "Args has no padding");

struct Frame {
    LAS unsigned char* lds;
    int tid, lane, wave, vcu, G;
};

__device__ __forceinline__ int map_ident(int n) { return n; }
__device__ __forceinline__ int map_win(int n) { return n < 10240 ? n : (n < 10304 ? 20480 + (n - 10240) : n - 64); }
template <int MAP>
__device__ __forceinline__ void p0_transpose_item(const float* __restrict__ W, int K, int N, bf16* WT, const float* __restrict__ kscale, LAS float* scr, int item, int lane) {
    const int nblk = (N + 63) / 64, kb = item / nblk, nb = item % nblk, k0 = 64 * kb, n0 = 64 * nb;
    const int kq = lane >> 4, nq = (lane & 15) * 4;
    const bool okn = (n0 + nq) < N;
    f32x4 v[16];
#pragma unroll
    for (int i = 0; i < 16; ++i) v[i] = okn ? __builtin_nontemporal_load((const GAS f32x4*)(W + (size_t)(k0 + 4 * i + kq) * N + n0 + nq)) : (f32x4){0.f, 0.f, 0.f, 0.f};
    if (kscale) {
#pragma unroll
        for (int i = 0; i < 16; ++i) v[i] = v[i] * kscale[k0 + 4 * i + kq]; }
#pragma unroll
    for (int i = 0; i < 16; ++i) { LAS float* d = scr + (4 * i + kq) * 65 + nq; d[0] = v[i][0]; d[1] = v[i][1]; d[2] = v[i][2]; d[3] = v[i][3]; }
    LDS_WAIT(); asm volatile("" ::: "memory");
    const int c = lane & 7;
#pragma unroll
    for (int j = 0; j < 8; ++j) { const int n = (lane >> 3) + 8 * j; const LAS float* s = scr + (8 * c) * 65 + n;
        v4u o; o.x = pk2(s[0 * 65], s[1 * 65]); o.y = pk2(s[2 * 65], s[3 * 65]); o.z = pk2(s[4 * 65], s[5 * 65]); o.w = pk2(s[6 * 65], s[7 * 65]);
        const int nn = n0 + n; const int dr = (MAP == 1) ? map_win(nn) : nn;
        if (nn < N) *(GAS v4u*)(WT + (size_t)dr * K + k0 + 8 * c) = o; }
    LDS_WAIT(); asm volatile("" ::: "memory");
}
__device__ __forceinline__ void p0_prologue(Frame& F, const Args& A, int part) {
    LAS float* scr = (LAS float*)(F.lds + RING_OFF + F.wave * 16640);
    const int gw = F.vcu * NWAVES + F.wave, NGW = F.G * NWAVES;
    unsigned char* ws = A.ws;
    constexpr int IT_WIN = (DM / 64) * ((DINP + 63) / 64), IT_WSS = (DI / 64) * (DM / 64), IT_WAT = (DA / 64) * (DM / 64), IT_WOUT = (DM / 64) * (DM / 64),
                  IT_WUP = (DM / 64) * (DFF2 / 64), IT_WDN = (DFF / 64) * (DM / 64);
    constexpr int NREST = IT_WSS + IT_WAT + IT_WOUT + IT_WUP + IT_WDN;
    if (part == 0) {
        for (int it = gw; it < IT_WIN; it += NGW) p0_transpose_item<1>(A.in[I_WIN], DM, DINP, (bf16*)(ws + WS_WIN), A.in[I_ANW], scr, it, F.lane);
    } else {
        for (int it = gw + (part - 1) * NGW; it < NREST; it += 2 * NGW) {
            int r = it;
            if (r < IT_WSS) { p0_transpose_item<0>(A.in[I_WSS], DI, DM, (bf16*)(ws + WS_WSS), nullptr, scr, r, F.lane); continue; } r -= IT_WSS;
            if (r < IT_WAT) { p0_transpose_item<0>(A.in[I_WAT], DA, DM, (bf16*)(ws + WS_WAT), nullptr, scr, r, F.lane); continue; } r -= IT_WAT;
            if (r < IT_WOUT) { p0_transpose_item<0>(A.in[I_WOUT], DM, DM, (bf16*)(ws + WS_WOUT), nullptr, scr, r, F.lane); continue; } r -= IT_WOUT;
            if (r < IT_WUP) { p0_transpose_item<0>(A.in[I_WUP], DM, DFF2, (bf16*)(ws + WS_WUP), A.in[I_FNW], scr, r, F.lane); continue; } r -= IT_WUP;
            p0_transpose_item<0>(A.in[I_WDN], DFF, DM, (bf16*)(ws + WS_WDN), nullptr, scr, r, F.lane);
        }
        return;
    }
    if (F.vcu == 0) ((int*)(ws + WS_CNT))[F.tid] = 0;
    float* r1 = (float*)(ws + WS_R1); float* ss2 = (float*)(ws + WS_SS2);
    bf16* xb = (bf16*)(ws + WS_XB);
    for (int m = gw; m < SEQ; m += NGW) {
        const GAS f32x4* xr = (const GAS f32x4*)(A.in[I_X] + (size_t)m * DM) + F.lane;
        f32x4 v[8]; float s = 0.f;
#pragma unroll
        for (int j = 0; j < 8; ++j) { v[j] = __builtin_nontemporal_load(xr + 64 * j); s += (v[j].x * v[j].x + v[j].y * v[j].y) + (v[j].z * v[j].z + v[j].w * v[j].w); }
        s = wave_sum(s);
        const float rr = 1.0f / sqrtf(s * (1.0f / DM) + EPS);
        GAS unsigned long long* o8 = (GAS unsigned long long*)(xb + (size_t)m * DM) + F.lane;
#pragma unroll
        for (int j = 0; j < 8; ++j) o8[64 * j] = (unsigned long long)pk2(v[j].x * rr, v[j].y * rr) | ((unsigned long long)pk2(v[j].z * rr, v[j].w * rr) << 32);
        if (F.lane == 0) { r1[m] = rr; ss2[m] = 0.f; }
    }
}

namespace pg8 {
__device__ __forceinline__ f32x4 bf2f4(const u32x4 v_, bool lo_) { const unsigned a_ = lo_ ? v_.x : v_.z, b_ = lo_ ? v_.y : v_.w; return (f32x4){__builtin_bit_cast(float, a_ << 16), __builtin_bit_cast(float, a_ & 0xffff0000u), __builtin_bit_cast(float, b_ << 16), __builtin_bit_cast(float, b_ & 0xffff0000u)}; }
#define PG8_BF2F4(v_, lo_) bf2f4(v_, lo_)
struct EpiInProj {
    static constexpr bool PERM = true, AFTER_DRAIN = false;
    bf16_t *z, *xbc, *q, *k, *v, *gt; const float* bg; int flag;
    __device__ __forceinline__ void operator()(const f32x4 (&acc)[2][2][4][2], const Unit& u, int wr, int wc, int fr, int fq) const {
        if (flag == 10) { if (acc[0][0][0][0][0] == 123.456f) z[0] = 1; return; }
        const int pn = u.pn; bf16_t* base; int ldc, colt; bool isg = false;
        if (pn < 16) { base = z; ldc = DI; colt = pn * 256; }
        else if (pn < 40) { base = xbc; ldc = DXBC; colt = (pn - 16) * 256; }
        else if (pn < 48) { base = q; ldc = DA; colt = (pn - 40) * 256; }
        else if (pn < 56) { base = k; ldc = DA; colt = (pn - 48) * 256; }
        else if (pn < 64) { base = v; ldc = DA; colt = (pn - 56) * 256; }
        else { base = gt; ldc = DI; colt = (pn - 64) * 256; isg = true; }
        const int row0 = u.pm * BM + wr * 64 + fr, col0 = colt + wc * 32 + 8 * fq;
        f32x4 bv[2][2];
#pragma unroll
        for (int bj = 0; bj < 2; ++bj)
#pragma unroll
            for (int n = 0; n < 2; ++n) bv[bj][n] = isg ? *(const f32x4*)(bg + col0 + bj * HALF + 4 * n) : (f32x4){0.f, 0.f, 0.f, 0.f};
#pragma unroll
        for (int ai = 0; ai < 2; ++ai)
#pragma unroll
            for (int m = 0; m < 4; ++m) { const int row = row0 + ai * HALF + m * 16; bf16_t* rowp = base + (size_t)row * ldc + col0;
#pragma unroll
                for (int bj = 0; bj < 2; ++bj) { f32x4 v0 = acc[ai][bj][m][0] + bv[bj][0], v1 = acc[ai][bj][m][1] + bv[bj][1];
                    if (isg) {
#pragma unroll
                        for (int e = 0; e < 4; ++e) { v0[e] = __builtin_amdgcn_rcpf(1.f + __expf(-v0[e])); v1[e] = __builtin_amdgcn_rcpf(1.f + __expf(-v1[e])); } }
                    u32x4 w; w.x = cvt_pk_bf16(v0[0], v0[1]); w.y = cvt_pk_bf16(v0[2], v0[3]); w.z = cvt_pk_bf16(v1[0], v1[1]); w.w = cvt_pk_bf16(v1[2], v1[3]);
                    __builtin_nontemporal_store(w, (u32x4*)(rowp + bj * HALF)); } }
    }
};
struct EpiGateF32 {
    static constexpr bool PERM = true, AFTER_DRAIN = false;
    bf16_t* T; const bf16_t* gt; int goff;
    __device__ __forceinline__ void operator()(const f32x4 (&acc)[2][2][4][2], const Unit& u, int wr, int wc, int fr, int fq) const {
        const int row0 = u.pm * BM + wr * 64 + fr, col0 = u.pn * BM + wc * 32 + 8 * fq;
        u32x4 g[2][2];
#define LDG(i, s) do { const int row_ = row0 + ((i) >> 2) * HALF + ((i) & 3) * 16; g[s][0] = *(const u32x4*)(gt + (size_t)row_ * DI + goff + col0); g[s][1] = *(const u32x4*)(gt + (size_t)row_ * DI + goff + col0 + HALF); } while (0)
        LDG(0, 0);
#pragma unroll
        for (int i = 0; i < 8; ++i) { const int ai = i >> 2, m = i & 3, s = i & 1; const int row = row0 + ai * HALF + m * 16;
            if (i + 1 < 8) LDG(i + 1, s ^ 1);
#pragma unroll
            for (int bj = 0; bj < 2; ++bj) { const f32x4 v0 = acc[ai][bj][m][0] * PG8_BF2F4(g[s][bj], true), v1 = acc[ai][bj][m][1] * PG8_BF2F4(g[s][bj], false);
                u32x4 w; w.x = cvt_pk_bf16(v0[0], v0[1]); w.y = cvt_pk_bf16(v0[2], v0[3]); w.z = cvt_pk_bf16(v1[0], v1[1]); w.w = cvt_pk_bf16(v1[2], v1[3]);
                *(u32x4*)(T + (size_t)row * DM + col0 + bj * HALF) = w; } }
#undef LDG
    }
};
struct EpiGateAddBf16 {
    static constexpr bool PERM = true, AFTER_DRAIN = false;
    const bf16_t* T; const bf16_t* gt; int goff; bf16_t* O;
    __device__ __forceinline__ void operator()(const f32x4 (&acc)[2][2][4][2], const Unit& u, int wr, int wc, int fr, int fq) const {
        const int row0 = u.pm * BM + wr * 64 + fr, col0 = u.pn * BM + wc * 32 + 8 * fq;
        u32x4 g[2][2]; u32x4 t[2][2];
#define LDG(i, s) do { const int row_ = row0 + ((i) >> 2) * HALF + ((i) & 3) * 16; \
            _Pragma("unroll") for (int bj_ = 0; bj_ < 2; ++bj_) { g[s][bj_] = *(const u32x4*)(gt + (size_t)row_ * DI + goff + col0 + bj_ * HALF); t[s][bj_] = *(const u32x4*)(T + (size_t)row_ * DM + col0 + bj_ * HALF); } } while (0)
        LDG(0, 0);
#pragma unroll
        for (int i = 0; i < 8; ++i) { const int ai = i >> 2, m = i & 3, s = i & 1; const int row = row0 + ai * HALF + m * 16;
            if (i + 1 < 8) LDG(i + 1, s ^ 1);
#pragma unroll
            for (int bj = 0; bj < 2; ++bj) { const f32x4 v0 = PG8_BF2F4(t[s][bj], true) + acc[ai][bj][m][0] * PG8_BF2F4(g[s][bj], true), v1 = PG8_BF2F4(t[s][bj], false) + acc[ai][bj][m][1] * PG8_BF2F4(g[s][bj], false);
                u32x4 w; w.x = cvt_pk_bf16(v0[0], v0[1]); w.y = cvt_pk_bf16(v0[2], v0[3]); w.z = cvt_pk_bf16(v1[0], v1[1]); w.w = cvt_pk_bf16(v1[2], v1[3]);
                *(u32x4*)(O + (size_t)row * DM + col0 + bj * HALF) = w; } }
#undef LDG
    }
};
struct EpiResid1 {
    static constexpr bool PERM = true, AFTER_DRAIN = false;
    const float* X; float* out; bf16_t* xb1; float* ss2; int probe;
    __device__ __forceinline__ void operator()(const f32x4 (&acc)[2][2][4][2], const Unit& u, int wr, int wc, int fr, int fq) const {
        const int row0 = u.pm * BM + wr * 64 + fr, col0 = u.pn * BM + wc * 32 + 8 * fq;
        f32x4 t[2][2][2];
#define LDG(i, s) do { const int row_ = row0 + ((i) >> 2) * HALF + ((i) & 3) * 16; \
            _Pragma("unroll") for (int bj_ = 0; bj_ < 2; ++bj_) { const float* tp_ = X + (size_t)row_ * DM + col0 + bj_ * HALF; t[s][bj_][0] = *(const f32x4*)tp_; t[s][bj_][1] = *(const f32x4*)(tp_ + 4); } } while (0)
        LDG(0, 0);
#pragma unroll
        for (int i = 0; i < 8; ++i) { const int ai = i >> 2, m = i & 3, s = i & 1; const int row = row0 + ai * HALF + m * 16; float sq = 0.f;
            if (i + 1 < 8) LDG(i + 1, s ^ 1);
#pragma unroll
            for (int bj = 0; bj < 2; ++bj) { const size_t off = (size_t)row * DM + col0 + bj * HALF;
                const f32x4 v0 = t[s][bj][0] + acc[ai][bj][m][0], v1 = t[s][bj][1] + acc[ai][bj][m][1];
                *(f32x4*)(out + off) = v0; *(f32x4*)(out + off + 4) = v1;
                sq += (v0[0] * v0[0] + v0[1] * v0[1]) + (v0[2] * v0[2] + v0[3] * v0[3]) + (v1[0] * v1[0] + v1[1] * v1[1]) + (v1[2] * v1[2] + v1[3] * v1[3]);
                u32x4 w; w.x = cvt_pk_bf16(v0[0], v0[1]); w.y = cvt_pk_bf16(v0[2], v0[3]); w.z = cvt_pk_bf16(v1[0], v1[1]); w.w = cvt_pk_bf16(v1[2], v1[3]);
                *(u32x4*)(xb1 + off) = w; }
            sq += __shfl_xor(sq, 16); sq += __shfl_xor(sq, 32);
            if (fq == 0 && !probe) atomicAdd(ss2 + row, sq); }
#undef LDG
    }
};
struct EpiUpPre {
    static constexpr bool PERM = true, AFTER_DRAIN = false;
    bf16_t* O; const float* ss2; int ldo, coloff;
    __device__ __forceinline__ void operator()(const f32x4 (&acc)[2][2][4][2], const Unit& u, int wr, int wc, int fr, int fq) const {
        const int row0 = u.pm * BM + wr * 64 + fr, col0 = u.pn * BM - coloff + wc * 32 + 8 * fq;
        float rs[2][4];
#pragma unroll
        for (int ai = 0; ai < 2; ++ai)
#pragma unroll
            for (int m = 0; m < 4; ++m) rs[ai][m] = ss2[row0 + ai * HALF + m * 16];
#pragma unroll
        for (int ai = 0; ai < 2; ++ai)
#pragma unroll
            for (int m = 0; m < 4; ++m) { const int row = row0 + ai * HALF + m * 16; const float r = 1.0f / sqrtf(rs[ai][m] * (1.0f / DM) + EPS);
#pragma unroll
                for (int bj = 0; bj < 2; ++bj) { const f32x4 v0 = acc[ai][bj][m][0] * r, v1 = acc[ai][bj][m][1] * r;
                    u32x4 w; w.x = cvt_pk_bf16(v0[0], v0[1]); w.y = cvt_pk_bf16(v0[2], v0[3]); w.z = cvt_pk_bf16(v1[0], v1[1]); w.w = cvt_pk_bf16(v1[2], v1[3]);
                    __builtin_nontemporal_store(w, (u32x4*)(O + (size_t)row * ldo + col0 + bj * HALF)); } }
    }
};
struct EpiResid2 {
    static constexpr bool PERM = true, AFTER_DRAIN = false;
    float* out; float* dst;
    __device__ __forceinline__ void operator()(const f32x4 (&acc)[2][2][4][2], const Unit& u, int wr, int wc, int fr, int fq) const {
        const int row0 = u.pm * BM + wr * 64 + fr, col0 = u.pn * BM + wc * 32 + 8 * fq;
        f32x4 t[2][2][2];
#define LDG(i, s) do { const int row_ = row0 + ((i) >> 2) * HALF + ((i) & 3) * 16; \
            _Pragma("unroll") for (int bj_ = 0; bj_ < 2; ++bj_) { const float* tp_ = out + (size_t)row_ * DM + col0 + bj_ * HALF; t[s][bj_][0] = *(const f32x4*)tp_; t[s][bj_][1] = *(const f32x4*)(tp_ + 4); } } while (0)
        LDG(0, 0);
#pragma unroll
        for (int i = 0; i < 8; ++i) { const int ai = i >> 2, m = i & 3, s = i & 1; const int row = row0 + ai * HALF + m * 16;
            if (i + 1 < 8) LDG(i + 1, s ^ 1);
#pragma unroll
            for (int bj = 0; bj < 2; ++bj) { float* p = dst + (size_t)row * DM + col0 + bj * HALF;
                *(f32x4*)p = t[s][bj][0] + acc[ai][bj][m][0]; *(f32x4*)(p + 4) = t[s][bj][1] + acc[ai][bj][m][1]; } }
#undef LDG
    }
};
#undef PG8_BF2F4
struct OneUnit { Unit u;
    __device__ __forceinline__ bool next(int i, Unit& o) const { if (i) return false; o = u; return true; }
    __device__ __forceinline__ void a_ready(const Unit&) const {}
    __device__ __forceinline__ void done(const Unit&) const {} };
}

__device__ __forceinline__ float softplusf(float v) { return v > 20.f ? v : log1pf(__expf(v)); }
__device__ __forceinline__ void dt_phase(Frame& F, const Args& A) {
    unsigned char* ws = A.ws;
    const bf16* xb = (const bf16*)(ws + WS_XB); const bf16* wt = (const bf16*)(ws + WS_WIN) + (size_t)NIN * DM;
    const float* r1 = (const float*)(ws + WS_R1); float* dt = (float*)(ws + WS_DT);
    LAS float* part = (LAS float*)(F.lds + RING_OFF);
    const int r32 = F.lane & 31, hi = F.lane >> 5;
    for (int rb = F.vcu; rb < SEQ / 32; rb += F.G) {
        const bf16* xa = xb + (size_t)(rb * 32 + r32) * DM + F.wave * 256 + hi * 8;
        const bf16* w0 = wt + (size_t)r32 * DM + F.wave * 256 + hi * 8; const bf16* w1 = w0 + (size_t)32 * DM;
        f32x16 acc0 = {}, acc1 = {};
#pragma unroll
        for (int ks = 0; ks < 16; ++ks) {
            const bf16x8 af = *reinterpret_cast<const bf16x8*>(xa + ks * 16), b0 = *reinterpret_cast<const bf16x8*>(w0 + ks * 16), b1 = *reinterpret_cast<const bf16x8*>(w1 + ks * 16);
            acc0 = __builtin_amdgcn_mfma_f32_32x32x16_bf16(af, b0, acc0, 0, 0, 0);
            acc1 = __builtin_amdgcn_mfma_f32_32x32x16_bf16(af, b1, acc1, 0, 0, 0); }
#pragma unroll
        for (int q = 0; q < 16; ++q) { const int row = (q & 3) + 8 * (q >> 2) + 4 * hi; part[(F.wave * 32 + row) * 64 + r32] = acc0[q]; part[(F.wave * 32 + row) * 64 + 32 + r32] = acc1[q]; }
        __syncthreads();
        for (int o = F.tid; o < 32 * 64; o += NTHR) { float s = 0.f;
#pragma unroll
            for (int w = 0; w < 8; ++w) s += part[w * 2048 + o];
            const int row = rb * 32 + (o >> 6), h = o & 63;
            dt[(size_t)row * NHS + h] = softplusf(s + A.in[I_DTB][h]); }
        __syncthreads();
    }
}

__device__ __forceinline__ void attn_prep_phase(Frame& F, const Args& A) {
    unsigned char* ws = A.ws;
    bf16* Q = (bf16*)(ws + WS_Q); bf16* K = (bf16*)(ws + WS_K); float* kbar = (float*)(ws + WS_KBAR); bf16* kbarb = (bf16*)(ws + WS_KBARB);
    LAS float* red = (LAS float*)(F.lds + RING_OFF);
    const int sub = F.tid >> 4, l16 = F.tid & 15;
    float qw[8], kw[8];
#pragma unroll
    for (int e = 0; e < 8; ++e) { qw[e] = A.in[I_QNW][l16 * 8 + e] * (0.08838834764831845f * 1.4426950408889634f); kw[e] = A.in[I_KNW][l16 * 8 + e]; }
    for (int u = F.vcu; u < NBLK * AH; u += F.G) {
        const int nb = u / AH, h = u % AH;
        float ksum[8];
#pragma unroll
        for (int e = 0; e < 8; ++e) ksum[e] = 0.f;
        for (int i = 0; i < 8; ++i) {
            const int t = nb * BLK + i * 32 + sub; const size_t off = (size_t)t * DA + h * AD + l16 * 8;
            { const v4u w = *(const GAS v4u*)(Q + off); float v[8] = {bflo(w.x), bfhi(w.x), bflo(w.y), bfhi(w.y), bflo(w.z), bfhi(w.z), bflo(w.w), bfhi(w.w)};
              float s = 0.f;
#pragma unroll
              for (int e = 0; e < 8; ++e) s += v[e] * v[e];
              s += __shfl_xor(s, 1); s += __shfl_xor(s, 2); s += __shfl_xor(s, 4); s += __shfl_xor(s, 8);
              const float r = 1.0f / sqrtf(s * (1.0f / AD) + EPS);
              v4u o; o.x = pk2(v[0] * r * qw[0], v[1] * r * qw[1]); o.y = pk2(v[2] * r * qw[2], v[3] * r * qw[3]); o.z = pk2(v[4] * r * qw[4], v[5] * r * qw[5]); o.w = pk2(v[6] * r * qw[6], v[7] * r * qw[7]);
              *(GAS v4u*)(Q + off) = o; }
            { const v4u w = *(const GAS v4u*)(K + off); float v[8] = {bflo(w.x), bfhi(w.x), bflo(w.y), bfhi(w.y), bflo(w.z), bfhi(w.z), bflo(w.w), bfhi(w.w)};
              float s = 0.f;
#pragma unroll
              for (int e = 0; e < 8; ++e) s += v[e] * v[e];
              s += __shfl_xor(s, 1); s += __shfl_xor(s, 2); s += __shfl_xor(s, 4); s += __shfl_xor(s, 8);
              const float r = 1.0f / sqrtf(s * (1.0f / AD) + EPS);
#pragma unroll
              for (int e = 0; e < 8; ++e) { v[e] = v[e] * r * kw[e]; ksum[e] += v[e]; }
              v4u o; o.x = pk2(v[0], v[1]); o.y = pk2(v[2], v[3]); o.z = pk2(v[4], v[5]); o.w = pk2(v[6], v[7]);
              *(GAS v4u*)(K + off) = o; }
        }
#pragma unroll
        for (int e = 0; e < 8; ++e) red[sub * 128 + l16 * 8 + e] = ksum[e];
        __syncthreads();
        if (F.tid < 128) { float s = 0.f;
#pragma unroll 8
            for (int r = 0; r < 32; ++r) s += red[r * 128 + F.tid];
            kbar[((size_t)h * NBLK + nb) * AD + F.tid] = s * (1.0f / BLK); kbarb[((size_t)h * NBLK + nb) * AD + F.tid] = (bf16)f2bf(s * (1.0f / BLK)); }
        __syncthreads();
    }
}

__device__ __forceinline__ void unpack8(const v4u w, float* v) { v[0] = bflo(w.x); v[1] = bfhi(w.x); v[2] = bflo(w.y); v[3] = bfhi(w.y); v[4] = bflo(w.z); v[5] = bfhi(w.z); v[6] = bflo(w.w); v[7] = bfhi(w.w); }
template <bool SP>
__device__ __forceinline__ void ffn_act_item(const Args& A, int it) {
    unsigned char* ws = A.ws;
    const bf16* __restrict__ U = (const bf16*)(ws + WS_UPRE); bf16* __restrict__ ACT = (bf16*)(ws + WS_ACT);
    const float* __restrict__ cw = A.in[I_FCW]; const float* __restrict__ cb = A.in[I_FCB];
    constexpr int CG = DFF / 8, TSEG = 16;
    {
        const int c0 = (it % CG) * 8, t0 = (it / CG) * TSEG;
        float wg[3][8], wu[3][8], bg[8], bu[8];
#pragma unroll
        for (int k = 0; k < 3; ++k) { const f32x4 a0 = *(const GAS f32x4*)(cw + k * DFF2 + c0), a1 = *(const GAS f32x4*)(cw + k * DFF2 + c0 + 4), b0 = *(const GAS f32x4*)(cw + k * DFF2 + DFF + c0), b1 = *(const GAS f32x4*)(cw + k * DFF2 + DFF + c0 + 4);
#pragma unroll
            for (int e = 0; e < 4; ++e) { wg[k][e] = a0[e]; wg[k][4 + e] = a1[e]; wu[k][e] = b0[e]; wu[k][4 + e] = b1[e]; } }
        { const f32x4 a0 = *(const GAS f32x4*)(cb + c0), a1 = *(const GAS f32x4*)(cb + c0 + 4), b0 = *(const GAS f32x4*)(cb + DFF + c0), b1 = *(const GAS f32x4*)(cb + DFF + c0 + 4);
#pragma unroll
          for (int e = 0; e < 4; ++e) { bg[e] = a0[e]; bg[4 + e] = a1[e]; bu[e] = b0[e]; bu[4 + e] = b1[e]; } }
        constexpr bool sp = SP; const bf16* __restrict__ U2 = (const bf16*)(ws + WS_UP2) + (c0 - 4608);
        float g1[8], g2[8], u1[8], u2[8];
        { const int tm1 = t0 >= 1 ? t0 - 1 : 0, tm2 = t0 >= 2 ? t0 - 2 : 0; const float ok = t0 >= 2 ? 1.f : 0.f;
          unpack8(*(const GAS v4u*)(U + (size_t)tm1 * DFF2 + c0), g1); unpack8(*(const GAS v4u*)(U + (size_t)tm1 * DFF2 + DFF + c0), u1);
          unpack8(*(const GAS v4u*)(U + (size_t)tm2 * DFF2 + c0), g2); unpack8(*(const GAS v4u*)(U + (size_t)tm2 * DFF2 + DFF + c0), u2);
          if (sp) { float a1[8], a2[8]; unpack8(*(const GAS v4u*)(U2 + (size_t)tm1 * 1024), a1); unpack8(*(const GAS v4u*)(U2 + (size_t)tm2 * 1024), a2);
#pragma unroll
            for (int e = 0; e < 8; ++e) { u1[e] += a1[e]; u2[e] += a2[e]; } }
#pragma unroll
          for (int e = 0; e < 8; ++e) { g1[e] *= ok; g2[e] *= ok; u1[e] *= ok; u2[e] *= ok; } }
        for (int tb = 0; tb < TSEG; tb += 4) {
            v4u rg[4], ru[4], rv[4];
#pragma unroll
            for (int j = 0; j < 4; ++j) { rg[j] = *(const GAS v4u*)(U + (size_t)(t0 + tb + j) * DFF2 + c0); ru[j] = *(const GAS v4u*)(U + (size_t)(t0 + tb + j) * DFF2 + DFF + c0); }
            if (sp) {
#pragma unroll
                for (int j = 0; j < 4; ++j) rv[j] = *(const GAS v4u*)(U2 + (size_t)(t0 + tb + j) * 1024); }
#pragma unroll
            for (int j = 0; j < 4; ++j) { float g0[8], u0[8], o[8]; unpack8(rg[j], g0); unpack8(ru[j], u0);
                if (sp) { float a0[8]; unpack8(rv[j], a0);
#pragma unroll
                    for (int e = 0; e < 8; ++e) u0[e] += a0[e]; }
#pragma unroll
                for (int e = 0; e < 8; ++e) { const float gg = bg[e] + wg[0][e] * g2[e] + wg[1][e] * g1[e] + wg[2][e] * g0[e]; const float uu = bu[e] + wu[0][e] * u2[e] + wu[1][e] * u1[e] + wu[2][e] * u0[e];
                    o[e] = siluf(gg) * uu; g2[e] = g1[e]; g1[e] = g0[e]; u2[e] = u1[e]; u1[e] = u0[e]; }
                v4u w; w.x = pk2(o[0], o[1]); w.y = pk2(o[2], o[3]); w.z = pk2(o[4], o[5]); w.w = pk2(o[6], o[7]);
                *(GAS v4u*)(ACT + (size_t)(t0 + tb + j) * DFF + c0) = w; }
        }
    }
}
__device__ __forceinline__ void ffn_act_phase(Frame& F, const Args& A) {
    constexpr int CG = DFF / 8, NIT = CG * (SEQ / 16);
    for (int it = F.vcu * NTHR + F.tid; it < NIT; it += F.G * NTHR) {
        const bool sp = __builtin_amdgcn_readfirstlane((it % CG) * 8) >= 4608;
        if (sp) ffn_act_item<true>(A, it); else ffn_act_item<false>(A, it);
    }
}

__device__ __forceinline__ int rel_bucket(int n) {
    if (n < 16) return n;
    int v = 16 + (int)(logf((float)n / 16.0f) / 2.0794415416798357f * 16.0f);
    return v < 31 ? v : 31;
}
#if MK_VARIANT != 6
__global__ void __launch_bounds__(256) naive_attn(const bf16* __restrict__ Q, const bf16* __restrict__ K, const bf16* __restrict__ V, const bf16* __restrict__ kbar,
                                                  const float* __restrict__ rel, bf16* __restrict__ O) {
    __shared__ float q_s[4][128];
    __shared__ float p_s[4][1024];
    __shared__ int   blk_s[4][4];
    const int w = threadIdx.x >> 6, lane = threadIdx.x & 63;
    const int pair = blockIdx.x * 4 + w, qi = pair / AH, h = pair % AH;
    const int blk = qi / BLK;
    { const unsigned u = *(const unsigned*)(Q + (size_t)qi * DA + h * AD + lane * 2); q_s[w][lane * 2] = bflo(u); q_s[w][lane * 2 + 1] = bfhi(u); }
    __syncthreads();
    float g = -INFINITY;
    if (lane < blk) { float s = 0.f; const bf16* kb = kbar + ((size_t)h * NBLK + lane) * AD; for (int d = 0; d < AD; ++d) s += q_s[w][d] * bf2f(kb[d]); g = s; }
    const int nsel = blk < 3 ? blk : 3;
    for (int t = 0; t < nsel; ++t) {
        float bv = g; int bi = lane;
#pragma unroll
        for (int o = 1; o < 64; o <<= 1) { const float ov = __shfl_xor(bv, o); const int oi = __shfl_xor(bi, o); if (ov > bv || (ov == bv && oi < bi)) { bv = ov; bi = oi; } }
        if (lane == 0) blk_s[w][t] = bi;
        if (lane == bi) g = -INFINITY;
    }
    if (lane == 0) blk_s[w][nsel] = blk;
    __syncthreads();
    const int nslot = nsel + 1;
    float mx = -INFINITY;
    for (int s = 0; s < nslot; ++s) {
        const int nb = blk_s[w][s]; const bool own = (s == nsel);
        for (int i = 0; i < 4; ++i) { const int j = lane + 64 * i, kpos = nb * BLK + j; const int dist = qi - kpos;
            float sc = -INFINITY;
            if (dist >= 0) { const bf16* kr = K + (size_t)kpos * DA + h * AD; float a = 0.f;
                for (int d = 0; d < AD; d += 2) { const unsigned u = *(const unsigned*)(kr + d); a += q_s[w][d] * bflo(u) + q_s[w][d + 1] * bfhi(u); }
                sc = a + rel[rel_bucket(dist) * AH + h] * 1.4426950408889634f; }
            (void)own;
            p_s[w][s * 256 + j] = sc; mx = fmaxf(mx, sc); }
    }
#pragma unroll
    for (int o = 1; o < 64; o <<= 1) mx = fmaxf(mx, __shfl_xor(mx, o));
    float sum = 0.f;
    for (int s = 0; s < nslot; ++s) for (int i = 0; i < 4; ++i) { const int idx = s * 256 + lane + 64 * i; const float e = exp2f(p_s[w][idx] - mx); p_s[w][idx] = e; sum += e; }
    sum = wave_sum(sum);
    __syncthreads();
    float o0 = 0.f, o1 = 0.f;
    for (int s = 0; s < nslot; ++s) { const int nb = blk_s[w][s];
        for (int j = 0; j < 256; ++j) { const float p = p_s[w][s * 256 + j]; const unsigned u = *(const unsigned*)(V + (size_t)(nb * BLK + j) * DA + h * AD + lane * 2); o0 += p * bflo(u); o1 += p * bfhi(u); } }
    const float inv = 1.f / sum;
    *(unsigned*)(O + (size_t)qi * DA + h * AD + lane * 2) = pk2(o0 * inv, o1 * inv);
}

__global__ void __launch_bounds__(512) naive_ssd(const bf16* __restrict__ XBC, const bf16* __restrict__ Z, const float* __restrict__ DT, const float* __restrict__ cw, const float* __restrict__ cb,
                                                 const float* __restrict__ alog, const float* __restrict__ dskip, const float* __restrict__ nw, bf16* __restrict__ YG) {
    __shared__ float bc_s[256];
    __shared__ float red_s[8];
    const int g = blockIdx.x, tid = threadIdx.x, head = g * 8 + (tid >> 6), ch = g * 512 + tid;
    const float Aneg = -__expf(alog[head]), Dh = dskip[head], nwc = nw[ch];
    float hst[128];
#pragma unroll
    for (int n = 0; n < 128; ++n) hst[n] = 0.f;
    const int bcch = (tid < 128) ? (DI + g * NST + tid) : (DI + NG * NST + g * NST + (tid - 128));
    float wx[4], wb[4]; float bx = cb[ch], bb = 0.f;
#pragma unroll
    for (int k = 0; k < 4; ++k) wx[k] = cw[k * DXBC + ch];
    if (tid < 256) { bb = cb[bcch];
#pragma unroll
        for (int k = 0; k < 4; ++k) wb[k] = cw[k * DXBC + bcch]; }
    for (int t = 0; t < SEQ; ++t) {
        float xa = bx, ba = bb;
#pragma unroll
        for (int k = 0; k < 4; ++k) { const int ts = t - 3 + k; if (ts >= 0) { xa += wx[k] * bf2f(XBC[(size_t)ts * DXBC + ch]); if (tid < 256) ba += wb[k] * bf2f(XBC[(size_t)ts * DXBC + bcch]); } }
        const float xv = siluf(xa);
        __syncthreads();
        if (tid < 256) bc_s[tid] = siluf(ba);
        __syncthreads();
        const float dtv = DT[(size_t)t * NHS + head], dA = __expf(dtv * Aneg), dtx = dtv * xv;
        float y = 0.f;
#pragma unroll
        for (int n = 0; n < 128; ++n) { hst[n] = hst[n] * dA + dtx * bc_s[n]; y += bc_s[128 + n] * hst[n]; }
        y += Dh * xv;
        const float zv = bf2f(Z[(size_t)t * DI + ch]);
        const float gv = y * siluf(zv);
        float sq = wave_sum(gv * gv);
        if ((tid & 63) == 0) red_s[tid >> 6] = sq;
        __syncthreads();
        float tot = 0.f;
#pragma unroll
        for (int i = 0; i < 8; ++i) tot += red_s[i];
        const float r = 1.0f / sqrtf(tot * (1.0f / 512.f) + EPS);
        YG[(size_t)t * DI + ch] = (bf16)f2bf(gv * r * nwc);
    }
}
#endif

namespace att {
constexpr int QBLK = 32, KVBLK = 64, D = 128, LD = DA;
constexpr int SHM_V = KVBLK * D * 2, SHM_K = KVBLK * D * 2;
constexpr int OFF_V = 0, OFF_K = 4 * SHM_V, OFF_WS = 4 * SHM_V + 4 * SHM_K, OFF_LUT = OFF_WS + NWAVES * 64 * 4, OFF_KBAR = OFF_LUT + 1536, OFF_QF = 0  , ATT_LDS = OFF_KBAR + 32 * 256;
static_assert(ATT_LDS <= LDSCTL_OFF, "attention LDS scratch overlaps the control words");
constexpr float LOG2E = 1.4426950408889634f;
constexpr float THR2 = 11.5f;
#define KSWZ(row, colB) ((row) * 256 + ((colB) ^ (((row) & 7) << 4)))
#define SBAR() __builtin_amdgcn_sched_barrier(0)
__device__ __forceinline__ int v_st(int k, int c) { const int kk = (k & ~0xC) | ((k & 4) << 1) | ((k & 8) >> 1); return ((kk >> 3) * 4 + (c >> 5)) * 512 + ((kk & 7) * 32 + (c & 31)) * 2; }
__device__ __forceinline__ int v_rd_base(int lane) { return ((lane & 3) << 3) | (((lane >> 2) & 3) << 6) | (((lane >> 4) & 1) << 5) | (((lane >> 5) & 1) << 8); }
constexpr int v_rd_off(int d0, int ks, int half) { return d0 * 512 + ks * 4096 + half * 2048; }
__device__ __forceinline__ int crow(int r, int hi) { return (r & 3) + 8 * (r >> 2) + 4 * hi; }
__device__ __forceinline__ unsigned cvtpk(float lo, float hi) { unsigned r; asm volatile("v_cvt_pk_bf16_f32 %0, %1, %2" : "=v"(r) : "v"(lo), "v"(hi)); return r; }

__device__ __forceinline__ void bias_tile(f32x16& p0, f32x16& p1, int dq, const float* lut) {
    const int dqc = dq > 250 ? 250 : dq;
    const float* base = lut + (dqc + 64);
#pragma unroll
    for (int r = 0; r < 16; ++r) { const int c = (r & 3) + 8 * (r >> 2);
        p0[r] += base[-c]; p1[r] += base[-c - 32]; }
}
__device__ __forceinline__ void partialSM(f32x16& p0, f32x16& p1, float& m_reg, float& mn, float& alpha) {
    float pmax = p0[0];
#pragma unroll
    for (int r = 1; r < 16; ++r) pmax = fmaxf(pmax, p0[r]);
#pragma unroll
    for (int r = 0; r < 16; ++r) pmax = fmaxf(pmax, p1[r]);
    { auto rr = __builtin_amdgcn_permlane32_swap(__float_as_uint(pmax), __float_as_uint(pmax), false, false);
      pmax = fmaxf(__uint_as_float(rr[0]), __uint_as_float(rr[1])); }
    if (__builtin_expect(__all((pmax - m_reg) <= THR2), 1)) { mn = m_reg; alpha = 1.f; }
    else { mn = fmaxf(m_reg, pmax); alpha = __builtin_amdgcn_exp2f(m_reg - mn); m_reg = mn; }
#pragma unroll
    for (int r = 0; r < 16; ++r) p0[r] = p0[r] - mn;
#pragma unroll
    for (int r = 0; r < 16; ++r) p1[r] = p1[r] - mn;
#pragma unroll
    for (int r = 0; r < 16; ++r) p0[r] = __builtin_amdgcn_exp2f(p0[r]);
}
__device__ __forceinline__ void finishSM(f32x16& p0, f32x16& p1, float alpha, float& l_reg, bf16x8& pa0, bf16x8& pa1, bf16x8& pa2, bf16x8& pa3) {
#pragma unroll
    for (int r = 0; r < 16; ++r) p1[r] = __builtin_amdgcn_exp2f(p1[r]);
    float ps = 0;
#pragma unroll
    for (int r = 0; r < 16; ++r) ps += p0[r];
#pragma unroll
    for (int r = 0; r < 16; ++r) ps += p1[r];
    { auto rr = __builtin_amdgcn_permlane32_swap(__float_as_uint(ps), __float_as_uint(ps), false, false);
      ps = __uint_as_float(rr[0]) + __uint_as_float(rr[1]); }
    l_reg = l_reg * alpha + ps;
#define PK4(P, B_, OUT) do { unsigned a0 = cvtpk(P[B_+0], P[B_+1]), a1 = cvtpk(P[B_+2], P[B_+3]);                          \
        unsigned b0 = cvtpk(P[B_+4], P[B_+5]), b1 = cvtpk(P[B_+6], P[B_+7]);                                             \
        auto r0 = __builtin_amdgcn_permlane32_swap(a0, b0, false, false); auto r1 = __builtin_amdgcn_permlane32_swap(a1, b1, false, false); \
        v4u w = {r0[0], r1[0], r0[1], r1[1]}; OUT = __builtin_bit_cast(bf16x8, w); } while (0)
    PK4(p0, 0, pa0); PK4(p0, 8, pa1); PK4(p1, 0, pa2); PK4(p1, 8, pa3);
}
template <int KB>
__device__ __forceinline__ void qkt(f32x16& p0, f32x16& p1, const char* K_lds, int r32, int hi, const bf16x8* qr, bool act, float init) {
    if (!act) { const float NEG = -__builtin_inff();
#pragma unroll
        for (int r = 0; r < 16; ++r) { p0[r] = NEG; p1[r] = NEG; } return; }
#pragma unroll
    for (int r = 0; r < 16; ++r) { p0[r] = init; p1[r] = init; }
    const char* kb[4];
#pragma unroll
    for (int dd = 0; dd < 4; ++dd) kb[dd] = K_lds + KB * SHM_K + KSWZ(r32, (dd * 16 + hi * 8) * 2);
#pragma unroll
    for (int d0 = 0; d0 < 8; ++d0) { const char* a = kb[d0 & 3] + (d0 >> 2) * 128;
        bf16x8 b0 = *reinterpret_cast<const bf16x8*>(a);
        bf16x8 b1 = *reinterpret_cast<const bf16x8*>(a + 32 * 256);
        p0 = __builtin_amdgcn_mfma_f32_32x32x16_bf16(b0, qr[d0], p0, 0, 0, 0);
        p1 = __builtin_amdgcn_mfma_f32_32x32x16_bf16(b1, qr[d0], p1, 0, 0, 0); }
}
__device__ __forceinline__ void qk32(f32x16& p0, const char* tile, int r32, int hi, const char* qf) {
#pragma unroll
    for (int r = 0; r < 16; ++r) p0[r] = 0.f;
#pragma unroll
    for (int d0 = 0; d0 < 8; ++d0) { const char* a = tile + KSWZ(r32, ((d0 & 3) * 16 + hi * 8) * 2) + (d0 >> 2) * 128;
        bf16x8 b0 = *reinterpret_cast<const bf16x8*>(a);
        p0 = __builtin_amdgcn_mfma_f32_32x32x16_bf16(b0, *reinterpret_cast<const bf16x8*>(qf + d0 * 1024), p0, 0, 0, 0); }
}
template <int VB>
__device__ __forceinline__ void pv_tile(f32x16* o, int vb0, bf16x8 pa0, bf16x8 pa1, bf16x8 pa2, bf16x8 pa3, bool act) {
    if (!act) return;
#define TRRD(dst, off) asm volatile("ds_read_b64_tr_b16 %0, %1 offset:%2" : "=&v"(dst) : "v"(vb0), "i"(off) : "memory")
#define PV_D0(d0) do { s16x4 l0, l1, l2, l3, h0, h1, h2, h3; constexpr int b_ = VB * SHM_V + v_rd_off(d0, 0, 0); \
        TRRD(l0, b_); TRRD(h0, b_ + 2048); TRRD(l1, b_ + 4096); TRRD(h1, b_ + 6144); TRRD(l2, b_ + 8192); TRRD(h2, b_ + 10240); TRRD(l3, b_ + 12288); TRRD(h3, b_ + 14336); \
        asm volatile("s_waitcnt lgkmcnt(0)" ::: "memory"); SBAR(); \
        o[d0] = __builtin_amdgcn_mfma_f32_32x32x16_bf16(pa0, (bf16x8){l0[0], l0[1], l0[2], l0[3], h0[0], h0[1], h0[2], h0[3]}, o[d0], 0, 0, 0);   \
        o[d0] = __builtin_amdgcn_mfma_f32_32x32x16_bf16(pa1, (bf16x8){l1[0], l1[1], l1[2], l1[3], h1[0], h1[1], h1[2], h1[3]}, o[d0], 0, 0, 0);   \
        o[d0] = __builtin_amdgcn_mfma_f32_32x32x16_bf16(pa2, (bf16x8){l2[0], l2[1], l2[2], l2[3], h2[0], h2[1], h2[2], h2[3]}, o[d0], 0, 0, 0);   \
        o[d0] = __builtin_amdgcn_mfma_f32_32x32x16_bf16(pa3, (bf16x8){l3[0], l3[1], l3[2], l3[3], h3[0], h3[1], h3[2], h3[3]}, o[d0], 0, 0, 0); } while (0)
    PV_D0(0); PV_D0(1); PV_D0(2); PV_D0(3);
#undef PV_D0
#undef TRRD
}


constexpr int OFF_ENT = OFF_KBAR + 32 * 256;
constexpr int ATT2_LDS = OFF_ENT + NWAVES * 512;
static_assert(ATT2_LDS <= LDSCTL_OFF, "attention LDS scratch overlaps the control words");
#define LD8(p) (*reinterpret_cast<const bf16x8*>(p))

__device__ __forceinline__ void moba_sel_unit(int h, int b, const bf16* __restrict__ Q, const bf16* __restrict__ KBb, int* __restrict__ CNT, int* __restrict__ LIST, char* lds) {
    int tid0 = threadIdx.x; asm volatile("" : "+v"(tid0));
    const int wid = __builtin_amdgcn_readfirstlane(tid0 >> 6), lane = tid0 & 63, r32 = lane & 31, hi = lane >> 5;
    char* kbar_t = lds + OFF_KBAR;
    const int qlo = b * BLK + wid * QBLK;
    char* qf = lds + OFF_QF + wid * 8192 + lane * 16;
    { bf16x8 qr[8];
#pragma unroll
      for (int d0 = 0; d0 < 8; ++d0) qr[d0] = LD8(Q + (size_t)(qlo + r32) * LD + h * D + d0 * 16 + hi * 8);
#pragma unroll
      for (int d0 = 0; d0 < 8; ++d0) *(bf16x8*)(qf + d0 * 1024) = qr[d0];
      const int sr0 = tid0 >> 4, sc0 = (tid0 & 15) * 8;
      const bf16x8 kb = LD8(KBb + ((size_t)h * NBLK + sr0) * D + sc0); *(bf16x8*)(kbar_t + KSWZ(sr0, sc0 * 2)) = kb; }
    __syncthreads();
    f32x16 g0; qk32(g0, kbar_t, r32, hi, qf);
    float t1v = -__builtin_inff(), t2v = t1v, t3v = t1v; int t1n = 64, t2n = 64, t3n = 64;
#define TOP3_INS(vv, nn) do { const float v_ = (vv); const int n_ = (nn);                                         \
        const bool g1 = v_ > t1v || (v_ == t1v && n_ < t1n), g2 = v_ > t2v || (v_ == t2v && n_ < t2n), g3 = v_ > t3v || (v_ == t3v && n_ < t3n); \
        t3v = g2 ? t2v : (g3 ? v_ : t3v); t3n = g2 ? t2n : (g3 ? n_ : t3n);                                        \
        t2v = g1 ? t1v : (g2 ? v_ : t2v); t2n = g1 ? t1n : (g2 ? n_ : t2n);                                        \
        t1v = g1 ? v_ : t1v; t1n = g1 ? n_ : t1n; } while (0)
#pragma unroll
    for (int r = 0; r < 16; ++r) { const int n = crow(r, hi), on = crow(r, 1 - hi); const float ov = __shfl_xor(g0[r], 32);
        TOP3_INS(n < b ? g0[r] : -__builtin_inff(), n); TOP3_INS(on < b ? ov : -__builtin_inff(), on); }
#undef TOP3_INS
    unsigned selmask = ((t1n < 32 ? 1u << t1n : 0u) | (t2n < 32 ? 1u << t2n : 0u) | (t3n < 32 ? 1u << t3n : 0u)) & ((b >= 32) ? 0xffffffffu : ((1u << b) - 1u));
    int* cnt_s = (int*)(lds + OFF_LUT); int* base_s = cnt_s + 32;
    if (tid0 < 32) cnt_s[tid0] = 0;
    __syncthreads();
    int pn[3] = {-1, -1, -1}, pr[3] = {0, 0, 0};
    if (hi == 0) {
#pragma unroll
        for (int s_ = 0; s_ < 3; ++s_) if (selmask) { const int n = __builtin_ctz(selmask); selmask &= selmask - 1u; pn[s_] = n; pr[s_] = atomicAdd(cnt_s + n, 1); } }
    __syncthreads();
    if (tid0 < 32) { const int c = cnt_s[tid0]; base_s[tid0] = c > 0 ? atomicAdd(CNT + h * NBLK + tid0, c) : 0; }
    __syncthreads();
    if (hi == 0) { const int q = qlo + r32;
#pragma unroll
        for (int s_ = 0; s_ < 3; ++s_) if (pn[s_] >= 0) LIST[((size_t)h * NBLK + pn[s_]) * SEQ + base_s[pn[s_]] + pr[s_]] = q | (s_ << 13); }
    __syncthreads();
}

template <int MODE>
__device__ __forceinline__ void moba_tile_unit(int h, int blk, int j, const bf16* Q, const bf16* __restrict__ K, const bf16* __restrict__ V, bf16* O, const int* __restrict__ CNT, const int* __restrict__ LIST,
                                               bf16* PART, float* PML, const float* __restrict__ rel, char* lds) {
    int tid0 = threadIdx.x; asm volatile("" : "+v"(tid0));
    const int wid = __builtin_amdgcn_readfirstlane(tid0 >> 6), lane = tid0 & 63, r32 = lane & 31, hi = lane >> 5;
    float* lut = (float*)(lds + OFF_LUT);
    constexpr int NT = 4;
    const int kb0 = blk * BLK;
    int* ent_s = (int*)(lds + OFF_ENT + wid * 512); float* fs = (float*)(lds + OFF_ENT + wid * 512 + 128);
    int tid = threadIdx.x; asm volatile("" : "+v"(tid));
    char* V_lds = lds + OFF_V; char* K_lds = lds + OFF_K;
    const int sr = tid >> 4, sc = (tid & 15) * 8, vst0 = v_st(sr, sc), vst1 = v_st(32 + sr, sc), kws = KSWZ(sr, sc * 2);
    const bf16* Kh = K + (size_t)kb0 * LD + h * D + sc; const bf16* Vh = V + (size_t)kb0 * LD + h * D + sc;
    bf16x8 stk[4][2], stv[4][2];
#pragma unroll
    for (int t = 0; t < 4; ++t) { stk[t][0] = LD8(Kh + (size_t)(t * 64 + sr) * LD); stk[t][1] = LD8(Kh + (size_t)(t * 64 + 32 + sr) * LD); stv[t][0] = LD8(Vh + (size_t)(t * 64 + sr) * LD); stv[t][1] = LD8(Vh + (size_t)(t * 64 + 32 + sr) * LD); }
    int qrow, ent = -1;
    if (MODE == 1) { const int cnt = ((const int*)(lds + OFF_KBAR))[512 + h * NBLK + blk]; const int e0 = j * 256, nv = (cnt - e0) < 256 ? (cnt - e0) : 256; const int ei = wid * 32 + r32;
        const int raw = LIST[((size_t)h * NBLK + blk) * SEQ + e0 + (ei < nv ? ei : 0)];
        ent = ei < nv ? raw : -1; qrow = raw & 8191; if (hi == 0) ent_s[r32] = ent; }
    const int rbw = (MODE == 2) ? (wid < 4 ? wid : 11 - wid) : wid;
    if (MODE != 1) qrow = blk * BLK + rbw * QBLK + r32;
    bf16x8 qr[8];
#pragma unroll
    for (int d0 = 0; d0 < 8; ++d0) qr[d0] = LD8(Q + (size_t)qrow * LD + h * D + d0 * 16 + hi * 8);
    if (tid0 < 320) { const int d = tid0 - 64; lut[tid0] = d < 0 ? -__builtin_inff() : rel[rel_bucket(d > 127 ? 127 : d) * AH + h] * LOG2E; }
#pragma unroll
    for (int t = 0; t < 4; ++t) { *(bf16x8*)(K_lds + t * SHM_K + kws) = stk[t][0]; *(bf16x8*)(K_lds + t * SHM_K + kws + 32 * 256) = stk[t][1];
        *(bf16x8*)(V_lds + t * SHM_V + vst0) = stv[t][0]; *(bf16x8*)(V_lds + t * SHM_V + vst1) = stv[t][1]; }
    float m_reg = -1e30f, l_reg = 0.f; const int nsel = (MODE == 2) ? (blk < 3 ? blk : 3) : 0;
    __syncthreads();
    float* ws = (float*)(lds + OFF_WS) + wid * 64; float* li_l = ws, * al_l = ws + 32;
    const int vb0 = (int)(uintptr_t)V_lds + v_rd_base(tid & 63);
#define KBASE(t) (kb0 + (t) * KVBLK)
    f32x16 o[4] = {};
    const float lut127 = lut[64 + 127];
    const int qlo = (MODE == 2) ? blk * BLK + rbw * QBLK : 0;
    const int qm = qrow - 4 * hi;
#define RESC(a) do { if (__any((a) < 1.f)) { if (hi == 0) al_l[r32] = (a); asm volatile("s_waitcnt lgkmcnt(0)" ::: "memory");              \
                     for (int d_ = 0; d_ < 4; ++d_) for (int r = 0; r < 16; ++r) o[d_][r] *= al_l[crow(r, hi)]; } } while (0)
#define ACT(t) ((MODE == 1) ? true : (KBASE(t) <= qlo + QBLK - 1))
#define NEAR(t) ((MODE == 1) ? (__any(qrow < KBASE(t) + 191) != 0) : (KBASE(t) > qlo - 191))
#define INITV(t) (NEAR(t) ? 0.f : lut127)
#define MASKT(P0_, P1_, t) do { if (ACT(t) && NEAR(t)) bias_tile(P0_, P1_, qm - KBASE(t), lut); } while (0)
    f32x16 pA0, pA1, pB0, pB1; float mnA, mnB, alA, alB; bf16x8 pa0, pa1, pa2, pa3;
    if (!((MODE == 1 && O != nullptr) || (MODE == 2 && j == 1))) {
    qkt<0>(pA0, pA1, K_lds, r32, hi, qr, ACT(0), INITV(0)); MASKT(pA0, pA1, 0); partialSM(pA0, pA1, m_reg, mnA, alA);
    SBAR(); qkt<1>(pB0, pB1, K_lds, r32, hi, qr, ACT(1), INITV(1)); finishSM(pA0, pA1, alA, l_reg, pa0, pa1, pa2, pa3); SBAR();
    pv_tile<0>(o, vb0, pa0, pa1, pa2, pa3, ACT(0)); MASKT(pB0, pB1, 1); partialSM(pB0, pB1, m_reg, mnB, alB); RESC(alB);
    SBAR(); qkt<2>(pA0, pA1, K_lds, r32, hi, qr, ACT(2), INITV(2)); finishSM(pB0, pB1, alB, l_reg, pa0, pa1, pa2, pa3); SBAR();
    pv_tile<1>(o, vb0, pa0, pa1, pa2, pa3, ACT(1)); MASKT(pA0, pA1, 2); partialSM(pA0, pA1, m_reg, mnA, alA); RESC(alA);
    SBAR(); qkt<3>(pB0, pB1, K_lds, r32, hi, qr, ACT(3), INITV(3)); finishSM(pA0, pA1, alA, l_reg, pa0, pa1, pa2, pa3); SBAR();
    pv_tile<2>(o, vb0, pa0, pa1, pa2, pa3, ACT(2)); MASKT(pB0, pB1, 3); partialSM(pB0, pB1, m_reg, mnB, alB); RESC(alB);
    finishSM(pB0, pB1, alB, l_reg, pa0, pa1, pa2, pa3); SBAR(); pv_tile<3>(o, vb0, pa0, pa1, pa2, pa3, ACT(3));
    } else { asm volatile("" :: "v"(qr[0]), "v"(qr[7])); l_reg = 1.f; }
    __syncthreads();
    char* stg = lds + OFF_K + wid * 8192;
    if (MODE == 1) {
        if (hi == 0 && ent >= 0) { float* p = PML + (((size_t)qrow * AH + h) * 3 + (ent >> 13)) * 2; p[0] = m_reg; p[1] = l_reg; }
#pragma unroll
        for (int r = 0; r < 16; ++r) { const int row = crow(r, hi);
#pragma unroll
            for (int d0 = 0; d0 < 4; ++d0) *(bf16*)(stg + row * 256 + (d0 * 32 + r32) * 2) = (bf16)f2bf(o[d0][r]); }
        asm volatile("s_waitcnt lgkmcnt(0)" ::: "memory");
#pragma unroll
        for (int i = 0; i < 8; ++i) { const int c = lane + 64 * i, row = c >> 4, ch = c & 15; const int er = ent_s[row];
            const v4u v = *(const v4u*)(stg + row * 256 + ch * 16);
            if (er >= 0) *(GAS v4u*)(PART + (((size_t)(er & 8191) * AH + h) * 3 + (er >> 13)) * D + ch * 8) = v; }
    } else {
        { float mt[3] = {-1e30f, -1e30f, -1e30f}, lt[3] = {0.f, 0.f, 0.f};
#pragma unroll
          for (int t = 0; t < 3; ++t) { const f32x2 ml = *(const GAS f32x2*)(PML + (((size_t)qrow * AH + h) * 3 + t) * 2); mt[t] = (t < nsel) ? ml[0] : -1e30f; lt[t] = (t < nsel) ? ml[1] : 0.f; }
          const float M = fmaxf(fmaxf(m_reg, mt[0]), fmaxf(mt[1], mt[2]));
          const float fo = __builtin_amdgcn_exp2f(m_reg - M); float L = l_reg * fo; float ft[3];
#pragma unroll
          for (int t = 0; t < 3; ++t) { ft[t] = (t < nsel) ? __builtin_amdgcn_exp2f(mt[t] - M) : 0.f; L += lt[t] * ft[t]; }
          const float rL = 1.0f / L;
          if (hi == 0) { li_l[r32] = fo * rL; fs[r32] = ft[0] * rL; fs[32 + r32] = ft[1] * rL; fs[64 + r32] = ft[2] * rL; } }
        asm volatile("s_waitcnt lgkmcnt(0)" ::: "memory");
#pragma unroll
        for (int r = 0; r < 16; ++r) { const int row = crow(r, hi); const float sc_ = li_l[row];
#pragma unroll
            for (int d0 = 0; d0 < 4; ++d0) *(bf16*)(stg + row * 256 + (d0 * 32 + r32) * 2) = (bf16)f2bf(o[d0][r] * sc_); }
        asm volatile("s_waitcnt lgkmcnt(0)" ::: "memory");
        bf16* Ow = O + (size_t)qlo * LD + h * D;
        auto merge = [&](auto NSEL_) { constexpr int NS = decltype(NSEL_)::value;
#pragma unroll
            for (int i = 0; i < 8; ++i) { const int c = lane + 64 * i, row = c >> 4, ch = c & 15;
                v4u pw[NS > 0 ? NS : 1];
#pragma unroll
                for (int t = 0; t < NS; ++t) pw[t] = *(const GAS v4u*)(PART + (((size_t)(qlo + row) * AH + h) * 3 + t) * D + ch * 8);
                float v[8]; { const v4u w = *(const v4u*)(stg + row * 256 + ch * 16); v[0] = bflo(w.x); v[1] = bfhi(w.x); v[2] = bflo(w.y); v[3] = bfhi(w.y); v[4] = bflo(w.z); v[5] = bfhi(w.z); v[6] = bflo(w.w); v[7] = bfhi(w.w); }
#pragma unroll
                for (int t = 0; t < NS; ++t) { const float f = fs[t * 32 + row]; const v4u w = pw[t];
                    v[0] += f * bflo(w.x); v[1] += f * bfhi(w.x); v[2] += f * bflo(w.y); v[3] += f * bfhi(w.y); v[4] += f * bflo(w.z); v[5] += f * bfhi(w.z); v[6] += f * bflo(w.w); v[7] += f * bfhi(w.w); }
                v4u ov; ov.x = pk2(v[0], v[1]); ov.y = pk2(v[2], v[3]); ov.z = pk2(v[4], v[5]); ov.w = pk2(v[6], v[7]);
                *(GAS v4u*)(Ow + (size_t)row * LD + ch * 8) = ov; } };
        if (nsel == 3) merge(std::integral_constant<int, 3>{}); else if (nsel == 2) merge(std::integral_constant<int, 2>{}); else if (nsel == 1) merge(std::integral_constant<int, 1>{}); else merge(std::integral_constant<int, 0>{});
    }
    __syncthreads();
#undef RESC
#undef KBASE
#undef ACT
#undef NEAR
#undef INITV
#undef MASKT
}
#undef LD8
}

namespace ssd {
using att::crow; using att::cvtpk;
constexpr int OFF_B = 0;
constexpr int OFF_X = 65536;
constexpr int OFF_ACS = 132096;
constexpr int OFF_DT = OFF_ACS + 8192;
constexpr float LOG2E = 1.4426950408889634f;
static_assert(OFF_DT + 16384 <= LDSCTL_OFF, "SSD LDS scratch overlaps the control words");
__device__ __forceinline__ int v_st64(int k, int c) { const int kk = (k & ~0xC) | ((k & 4) << 1) | ((k & 8) >> 1); return ((kk >> 3) * 2 + (c >> 5)) * 512 + ((kk & 7) * 32 + (c & 31)) * 2; }
constexpr int v_rd_off64(int d0, int ks, int half) { return d0 * 512 + ks * 2048 + half * 1024; }

__device__ __forceinline__ void conv8(const bf16* __restrict__ XBC, int t, int ch0, const float (&w)[4][8], const float (&bs)[8], float (&out)[8]) {
    v4u raw[4];
#pragma unroll
    for (int k = 0; k < 4; ++k) { const int ts = t - 3 + k; raw[k] = *(const GAS v4u*)(XBC + (size_t)(ts < 0 ? 0 : ts) * DXBC + ch0); }
#pragma unroll
    for (int e = 0; e < 8; ++e) out[e] = bs[e];
#pragma unroll
    for (int k = 0; k < 4; ++k) { const float ok = (t - 3 + k) >= 0 ? 1.f : 0.f; float a[8]; unpack8(raw[k], a);
#pragma unroll
        for (int e = 0; e < 8; ++e) out[e] += (w[k][e] * ok) * a[e]; }
#pragma unroll
    for (int e = 0; e < 8; ++e) out[e] = siluf(out[e]);
}
template <int NTOK>
__device__ __forceinline__ void conv8_run(const bf16* __restrict__ XBC, int t, int ch0, const float (&w)[4][8], const float (&bs)[8], float (&out)[NTOK][8]) {
    v4u raw[NTOK + 3];
#pragma unroll
    for (int k = 0; k < NTOK + 3; ++k) { const int ts = t - 3 + k; raw[k] = *(const GAS v4u*)(XBC + (size_t)(ts < 0 ? 0 : ts) * DXBC + ch0); }
    if (t < 3) {
#pragma unroll
        for (int k = 0; k < 3; ++k) if (t - 3 + k < 0) raw[k] = (v4u){0u, 0u, 0u, 0u};
    }
    float a[4][8];
#pragma unroll
    for (int k = 0; k < 3; ++k) unpack8(raw[k], a[k]);
#pragma unroll
    for (int i = 0; i < NTOK; ++i) { unpack8(raw[i + 3], a[(i + 3) & 3]);
#pragma unroll
        for (int e = 0; e < 8; ++e) { float v = bs[e];
#pragma unroll
            for (int k = 0; k < 4; ++k) v += w[k][e] * a[(i + k) & 3][e];
            out[i][e] = siluf(v); } }
}
__device__ __forceinline__ void load_convw(const float* __restrict__ cw, const float* __restrict__ cb, int ch0, float (&w)[4][8], float (&bs)[8]) {
#pragma unroll
    for (int k = 0; k < 4; ++k)
#pragma unroll
        for (int e = 0; e < 8; ++e) w[k][e] = cw[k * DXBC + ch0 + e];
#pragma unroll
    for (int e = 0; e < 8; ++e) bs[e] = cb[ch0 + e];
}
__device__ __forceinline__ void conv8_lite(const bf16* __restrict__ XBC, int t, int ch0, const float* __restrict__ cw, const float* __restrict__ cb, float (&out)[8]) {
    { const f32x4 b0 = *(const GAS f32x4*)(cb + ch0), b1 = *(const GAS f32x4*)(cb + ch0 + 4); out[0] = b0[0]; out[1] = b0[1]; out[2] = b0[2]; out[3] = b0[3]; out[4] = b1[0]; out[5] = b1[1]; out[6] = b1[2]; out[7] = b1[3]; }
#pragma unroll
    for (int k = 0; k < 4; ++k) { const int ts = t - 3 + k; const float ok = ts >= 0 ? 1.f : 0.f; const int row = ts >= 0 ? ts : 0;
        float a[8]; unpack8(*(const GAS v4u*)(XBC + (size_t)row * DXBC + ch0), a);
        const f32x4 w0 = *(const GAS f32x4*)(cw + k * DXBC + ch0) * ok, w1 = *(const GAS f32x4*)(cw + k * DXBC + ch0 + 4) * ok;
        out[0] += w0[0] * a[0]; out[1] += w0[1] * a[1]; out[2] += w0[2] * a[2]; out[3] += w0[3] * a[3]; out[4] += w1[0] * a[4]; out[5] += w1[1] * a[5]; out[6] += w1[2] * a[6]; out[7] += w1[3] * a[7]; }
#pragma unroll
    for (int e = 0; e < 8; ++e) out[e] = siluf(out[e]);
}
__device__ __forceinline__ v4u pack8f(const float (&v)[8]) { v4u o; o.x = pk2(v[0], v[1]); o.y = pk2(v[2], v[3]); o.z = pk2(v[4], v[5]); o.w = pk2(v[6], v[7]); return o; }

#define SSD_TRRD(dst, base, off) asm volatile("ds_read_b64_tr_b16 %0, %1 offset:%2" : "=&v"(dst) : "v"(base), "i"(off) : "memory")
#define SSD_F8(l, h) ((bf16x8){l[0], l[1], l[2], l[3], h[0], h[1], h[2], h[3]})

__device__ __forceinline__ void states_unit(int c, int g, const Args& A, char* lds, int flag = 0) {
    int tid = threadIdx.x; asm volatile("" : "+v"(tid));
    const int wid = __builtin_amdgcn_readfirstlane(tid >> 6), lane = tid & 63, r32 = lane & 31, hi = lane >> 5;
    unsigned char* ws = A.ws;
    const bf16* XBC = (const bf16*)(ws + WS_XBC); const float* DT = (const float*)(ws + WS_DT); float* ACS = (float*)(ws + WS_ACS); float* ST = (float*)(ws + WS_STATES);
    const float* cw = A.in[I_SCW]; const float* cb = A.in[I_SCB];
    float* acs_s = (float*)(lds + OFF_ACS); float* dt_s = (float*)(lds + OFF_DT);
    bf16* BCC = (bf16*)(ws + WS_BCC); bf16* XC = (bf16*)A.out;
    const int t0 = c * CHK;
    { const int head = g * 8 + wid; const float Aneg = -__expf(A.in[I_ALOG][head]);
      float d[4], a[4];
#pragma unroll
      for (int i = 0; i < 4; ++i) d[i] = DT[(size_t)(t0 + 4 * lane + i) * NHS + head];
      a[0] = d[0] * Aneg; a[1] = a[0] + d[1] * Aneg; a[2] = a[1] + d[2] * Aneg; a[3] = a[2] + d[3] * Aneg;
      float incl = a[3];
#pragma unroll
      for (int o = 1; o < 64; o <<= 1) { const float v = __shfl_up(incl, o); if (lane >= o) incl += v; }
      const float excl = incl - a[3];
#pragma unroll
      for (int i = 0; i < 4; ++i) { const float v = a[i] + excl; acs_s[(4 * lane + i) * 8 + wid] = v; dt_s[(4 * lane + i) * 8 + wid] = d[i]; ACS[(size_t)(t0 + 4 * lane + i) * NHS + head] = v; } }
    if (flag != 8) { float w[4][8], bs[8]; const int ch0 = DI + g * NST + (tid & 15) * 8; load_convw(cw, cb, ch0, w, bs);
      const int l0 = (tid >> 4) * 8; float v[8][8]; conv8_run<8>(XBC, t0 + l0, ch0, w, bs, v);
#pragma unroll
      for (int i = 0; i < 8; ++i) { const int l = l0 + i; const v4u pk = pack8f(v[i]);
          *(v4u*)(lds + OFF_B + (l >> 6) * 16384 + att::v_st(l & 63, (tid & 15) * 8)) = pk;
          *(GAS v4u*)(BCC + (size_t)(t0 + l) * 2048 + g * NST + (tid & 15) * 8) = pk; } }
    if (flag != 8) { float w[4][8], bs[8]; const int ch0 = DI + NG * NST + g * NST + (tid & 15) * 8; load_convw(cw, cb, ch0, w, bs);
      const int l0 = (tid >> 4) * 8; float v[8][8]; conv8_run<8>(XBC, t0 + l0, ch0, w, bs, v);
#pragma unroll
      for (int i = 0; i < 8; ++i) *(GAS v4u*)(BCC + (size_t)(t0 + l0 + i) * 2048 + 1024 + g * NST + (tid & 15) * 8) = pack8f(v[i]); }
    __syncthreads();
    const int mb = wid & 1, nb = wid >> 1;
    const int rdb = att::v_rd_base(lane);
    auto stage_xs = [&](int r) {
        const int head = g * 8 + r; char* xs = lds + OFF_X + (r & 1) * 32768;
        float w[4][8], bs[8]; const int ch0 = head * HP + (tid & 7) * 8; load_convw(cw, cb, ch0, w, bs);
        const float alast = acs_s[255 * 8 + r];
        const int l0 = (tid >> 3) * 4; float vv[4][8]; conv8_run<4>(XBC, t0 + l0, ch0, w, bs, vv);
#pragma unroll
        for (int i = 0; i < 4; ++i) { const int l = l0 + i;
            const float dtl = dt_s[l * 8 + r], f = __expf(alast - acs_s[l * 8 + r]);
#pragma unroll
            for (int e = 0; e < 8; ++e) vv[i][e] *= dtl;
            *(GAS v4u*)(XC + (size_t)(t0 + l) * DI + ch0) = pack8f(vv[i]);
#pragma unroll
            for (int e = 0; e < 8; ++e) vv[i][e] *= f;
            *(v4u*)(xs + (l >> 6) * 8192 + v_st64(l & 63, (tid & 7) * 8)) = pack8f(vv[i]); } };
    if (flag != 7) stage_xs(0);
    __syncthreads();
    for (int r = 0; r < ((flag == 7) ? 0 : 8); ++r) {
        const int head = g * 8 + r; char* xs = lds + OFF_X + (r & 1) * 32768;
        if (r + 1 < 8) stage_xs(r + 1);
        f32x16 acc = {};
        if (flag == 9) { __syncthreads(); continue; }
        const int xb = (int)(uintptr_t)xs + rdb, bb = (int)(uintptr_t)(lds + OFF_B) + rdb;
#pragma unroll
        for (int tl = 0; tl < 4; ++tl) {
            const int xbt = xb + tl * 8192 + mb * 512, bbt = bb + tl * 16384 + nb * 512;
            s16x4 al[4], ah[4], bl[4], bh[4];
#define ST_RD(ks) do { SSD_TRRD(al[ks], xbt, (ks) * 2048); SSD_TRRD(ah[ks], xbt, (ks) * 2048 + 1024); SSD_TRRD(bl[ks], bbt, (ks) * 4096); SSD_TRRD(bh[ks], bbt, (ks) * 4096 + 2048); } while (0)
            ST_RD(0); ST_RD(1); ST_RD(2); ST_RD(3);
            asm volatile("s_waitcnt lgkmcnt(0)" ::: "memory"); __builtin_amdgcn_sched_barrier(0);
#pragma unroll
            for (int ks = 0; ks < 4; ++ks) acc = __builtin_amdgcn_mfma_f32_32x32x16_bf16(SSD_F8(al[ks], ah[ks]), SSD_F8(bl[ks], bh[ks]), acc, 0, 0, 0);
#undef ST_RD
#define ST_KS(ks)
#undef ST_KS
        }
        float* so = ST + (((size_t)c * NHS + head) * HP + mb * 32) * NST + nb * 32 + r32;
#pragma unroll
        for (int q = 0; q < 16; ++q) so[(size_t)crow(q, hi) * NST] = acc[q];
        __syncthreads();
    }
}
__device__ __forceinline__ void ssd_states_phase(Frame& F, const Args& A, char* lds, int flag = 0) {
    for (int u = F.vcu; u < NCH * NG; u += F.G) states_unit(u >> 3, u & 7, A, lds, flag);
}

__device__ __forceinline__ void ssd_scan_phase(Frame& F, const Args& A) {
    unsigned char* ws = A.ws;
    float* ST = (float*)(ws + WS_STATES); const float* ACS = (const float*)(ws + WS_ACS);
    constexpr int PER = NHS * HP * NST;
    for (int e4 = F.vcu * NTHR + F.tid; e4 < PER / 4; e4 += F.G * NTHR) {
        const int head = (e4 * 4) / (HP * NST);
        f32x4 h = {0.f, 0.f, 0.f, 0.f};
        f32x4 s[8];
#pragma unroll
        for (int j = 0; j < 8; ++j) s[j] = *(const GAS f32x4*)(ST + (size_t)j * PER + (size_t)e4 * 4);
        for (int c0 = 0; c0 < NCH; c0 += 8) {
#pragma unroll
            for (int j = 0; j < 8; ++j) { const int c = c0 + j;
                *(GAS f32x4*)(ST + (size_t)c * PER + (size_t)e4 * 4) = h;
                const float dec = __expf(ACS[(size_t)(c * CHK + CHK - 1) * NHS + head]);
                h = h * dec + s[j];
                if (c + 8 < NCH) s[j] = *(const GAS f32x4*)(ST + (size_t)(c + 8) * PER + (size_t)e4 * 4); }
        }
    }
}

__device__ __forceinline__ void cb_tile(f32x16& p0, f32x16& p1, const char* Kt, int r32, int hi, const bf16x8* qr) {
#pragma unroll
    for (int r = 0; r < 16; ++r) { p0[r] = 0.f; p1[r] = 0.f; }
#pragma unroll
    for (int d0 = 0; d0 < 8; ++d0) { const char* a = Kt + KSWZ(r32, ((d0 & 3) * 16 + hi * 8) * 2) + (d0 >> 2) * 128;
        const bf16x8 b0 = *reinterpret_cast<const bf16x8*>(a), b1 = *reinterpret_cast<const bf16x8*>(a + 32 * 256);
        p0 = __builtin_amdgcn_mfma_f32_32x32x16_bf16(b0, qr[d0], p0, 0, 0, 0);
        p1 = __builtin_amdgcn_mfma_f32_32x32x16_bf16(b1, qr[d0], p1, 0, 0, 0); }
}
__device__ __forceinline__ void out_unit(int c, int g, const Args& A, char* lds, int flag = 0) {
    int tid = threadIdx.x; asm volatile("" : "+v"(tid));
    const int wv = __builtin_amdgcn_readfirstlane(tid >> 6), wid = wv < 4 ? wv : 11 - wv, lane = tid & 63, r32 = lane & 31, hi = lane >> 5;
    unsigned char* ws = A.ws;
    const bf16* __restrict__ Z = (const bf16*)(ws + WS_Z); const float* __restrict__ DT = (const float*)(ws + WS_DT); const float* __restrict__ ACS = (const float*)(ws + WS_ACS);
    const float* __restrict__ HPV = (const float*)(ws + WS_STATES); bf16* __restrict__ YG = (bf16*)(ws + WS_YG);
    const bf16* BCC = (const bf16*)(ws + WS_BCC); const bf16* XC = (const bf16*)A.out;
    float* acs_s = (float*)(lds + OFF_ACS); char* ht = lds + OFF_DT;
    const int t0 = c * CHK;
    for (int i = tid; i < CHK * 8; i += NTHR) { const int l = i >> 3, r = i & 7; acs_s[i] = ACS[(size_t)(t0 + l) * NHS + g * 8 + r] * LOG2E; }
    { for (int i = 0; i < 8; ++i) { const int l = (tid >> 4) + 32 * i;
          *(v4u*)(lds + OFF_B + (l >> 6) * 16384 + KSWZ(l & 63, (tid & 15) * 16)) = *(const GAS v4u*)(BCC + (size_t)(t0 + l) * 2048 + g * NST + (tid & 15) * 8); } }
    bf16x8 qr[8];
    { const int l = wid * 32 + r32;
#pragma unroll
      for (int d0 = 0; d0 < 8; ++d0) qr[d0] = *reinterpret_cast<const bf16x8*>(BCC + (size_t)(t0 + l) * 2048 + 1024 + g * NST + d0 * 16 + hi * 8); }
    const int lrow = wid * 32 + r32;
    const int nt = (wid >> 1) + 1;
    const int rdb = att::v_rd_base(lane);
    auto stage_x = [&](int r) {
        const int head = g * 8 + r; char* xs = lds + OFF_X + (r & 1) * 32768;
#pragma unroll
        for (int i = 0; i < 4; ++i) { const int l = (tid >> 3) + 64 * i;
            *(v4u*)(xs + i * 8192 + v_st64(l & 63, (tid & 7) * 8)) = *(const GAS v4u*)(XC + (size_t)(t0 + l) * DI + head * HP + (tid & 7) * 8); } };
    f32x4 hreg[4];
    auto load_h = [&](int r) { const float* hp = HPV + (((size_t)c * NHS + g * 8 + r) * HP + (tid >> 3)) * NST + (tid & 7) * 16;
#pragma unroll
        for (int j = 0; j < 4; ++j) hreg[j] = *(const GAS f32x4*)(hp + 4 * j); };
    auto write_h = [&]() {
        v4u w0, w1; w0.x = cvtpk(hreg[0][0], hreg[0][1]); w0.y = cvtpk(hreg[0][2], hreg[0][3]); w0.z = cvtpk(hreg[1][0], hreg[1][1]); w0.w = cvtpk(hreg[1][2], hreg[1][3]);
        w1.x = cvtpk(hreg[2][0], hreg[2][1]); w1.y = cvtpk(hreg[2][2], hreg[2][3]); w1.z = cvtpk(hreg[3][0], hreg[3][1]); w1.w = cvtpk(hreg[3][2], hreg[3][3]);
        *(v4u*)(ht + KSWZ(tid >> 3, (tid & 7) * 32)) = w0; *(v4u*)(ht + KSWZ(tid >> 3, (tid & 7) * 32 + 16)) = w1; };
    stage_x(0); load_h(0); write_h();
    __syncthreads();
    for (int r = 0; r < 8; ++r) {
        const int head = g * 8 + r; const char* xs = lds + OFF_X + (r & 1) * 32768;
        if (r + 1 < 8) stage_x(r + 1);
        const float a2l = acs_s[lrow * 8 + r];
        f32x16 o[2] = {};
        if (flag != 4) { const float el = __builtin_amdgcn_exp2f(a2l);
#pragma unroll
          for (int d0 = 0; d0 < 8; ++d0) { float cv[8]; unpack8(__builtin_bit_cast(v4u, qr[d0]), cv);
#pragma unroll
              for (int e = 0; e < 8; ++e) cv[e] *= el;
              const bf16x8 af = __builtin_bit_cast(bf16x8, pack8f(cv));
              const char* a = ht + KSWZ(r32, ((d0 & 3) * 16 + hi * 8) * 2) + (d0 >> 2) * 128;
              const bf16x8 b0 = *reinterpret_cast<const bf16x8*>(a), b1 = *reinterpret_cast<const bf16x8*>(a + 32 * 256);
              o[0] = __builtin_amdgcn_mfma_f32_32x32x16_bf16(af, b0, o[0], 0, 0, 0);
              o[1] = __builtin_amdgcn_mfma_f32_32x32x16_bf16(af, b1, o[1], 0, 0, 0); } }
        __syncthreads();
        if (r + 1 < 8) { load_h(r + 1); write_h(); }
        const float dskip = A.in[I_SD][head] / fmaxf(DT[(size_t)(t0 + lrow) * NHS + head], 1e-30f);
        for (int t = 0; t < ((flag == 3) ? 0 : nt); ++t) {
            f32x16 p0, p1; cb_tile(p0, p1, lds + OFF_B + t * 16384, r32, hi, qr);
            const int dq = lrow - t * 64 - 4 * hi;
#pragma unroll
            for (int q = 0; q < 16; ++q) { const int cc = (q & 3) + 8 * (q >> 2); const int s0 = t * 64 + cc + 4 * hi;
                const float e0 = __builtin_amdgcn_exp2f(a2l - acs_s[s0 * 8 + r]), e1 = __builtin_amdgcn_exp2f(a2l - acs_s[(s0 + 32) * 8 + r]);
                float v0 = p0[q] * e0, v1 = p1[q] * e1;
                v0 = (cc > dq) ? 0.f : v0; v1 = (cc + 32 > dq) ? 0.f : v1;
                v0 += (cc == dq) ? dskip : 0.f; v1 += (cc + 32 == dq) ? dskip : 0.f;
                p0[q] = v0; p1[q] = v1;
                if ((q & 3) == 3) __builtin_amdgcn_sched_barrier(0); }
            bf16x8 pa0, pa1, pa2, pa3;
            PK4(p0, 0, pa0); PK4(p0, 8, pa1); PK4(p1, 0, pa2); PK4(p1, 8, pa3);
            const int xb = (int)(uintptr_t)xs + rdb + t * 8192;
#define PV64(d0) do { s16x4 l0, l1, l2, l3, h0, h1, h2, h3; \
            SSD_TRRD(l0, xb, v_rd_off64(d0, 0, 0)); SSD_TRRD(h0, xb, v_rd_off64(d0, 0, 1)); SSD_TRRD(l1, xb, v_rd_off64(d0, 1, 0)); SSD_TRRD(h1, xb, v_rd_off64(d0, 1, 1)); \
            SSD_TRRD(l2, xb, v_rd_off64(d0, 2, 0)); SSD_TRRD(h2, xb, v_rd_off64(d0, 2, 1)); SSD_TRRD(l3, xb, v_rd_off64(d0, 3, 0)); SSD_TRRD(h3, xb, v_rd_off64(d0, 3, 1)); \
            asm volatile("s_waitcnt lgkmcnt(0)" ::: "memory"); __builtin_amdgcn_sched_barrier(0); \
            o[d0] = __builtin_amdgcn_mfma_f32_32x32x16_bf16(pa0, SSD_F8(l0, h0), o[d0], 0, 0, 0); o[d0] = __builtin_amdgcn_mfma_f32_32x32x16_bf16(pa1, SSD_F8(l1, h1), o[d0], 0, 0, 0); \
            o[d0] = __builtin_amdgcn_mfma_f32_32x32x16_bf16(pa2, SSD_F8(l2, h2), o[d0], 0, 0, 0); o[d0] = __builtin_amdgcn_mfma_f32_32x32x16_bf16(pa3, SSD_F8(l3, h3), o[d0], 0, 0, 0); } while (0)
            PV64(0); PV64(1);
#undef PV64
        }
        if (flag != 5)
#pragma unroll
        for (int d0 = 0; d0 < 2; ++d0) {
#pragma unroll
          for (int q = 0; q < 16; ++q) { const size_t off = (size_t)(t0 + wid * 32 + crow(q, hi)) * DI + head * HP + r32 + d0 * 32;
              const float v = o[d0][q]; const float vn = __shfl_xor(v, 1);
              if ((r32 & 1) == 0) *(unsigned*)(YG + off) = cvtpk(v, vn); } }
        __syncthreads();
    }
    asm volatile("s_waitcnt vmcnt(0)" ::: "memory");
    if (flag != 5 && flag != 6) { const float* nw = A.in[I_SNW] + g * 512 + lane * 8; float nwv[8];
#pragma unroll
      for (int e = 0; e < 8; ++e) nwv[e] = nw[e];
      v4u raw[2][8], zr[2][8];
#define SSD_LDB(k, s_) do { _Pragma("unroll") for (int j = 0; j < 8; ++j) { const size_t off = (size_t)(t0 + wid * 32 + (k) * 8 + j) * DI + g * 512 + lane * 8; raw[s_][j] = *(const GAS v4u*)(YG + off); zr[s_][j] = *(const GAS v4u*)(Z + off); } } while (0)
      SSD_LDB(0, 0);
#pragma unroll
      for (int k = 0; k < 4; ++k) { const int s_ = k & 1;
          if (k + 1 < 4) SSD_LDB(k + 1, s_ ^ 1);
#pragma unroll
          for (int j = 0; j < 8; ++j) { float v[8], zz[8]; unpack8(raw[s_][j], v); unpack8(zr[s_][j], zz); float sq = 0.f;
#pragma unroll
              for (int e = 0; e < 8; ++e) { v[e] *= siluf(zz[e]); sq += v[e] * v[e]; }
              sq = wave_sum(sq); const float rsv = 1.0f / sqrtf(sq * (1.0f / 512.f) + EPS);
#pragma unroll
              for (int e = 0; e < 8; ++e) v[e] *= rsv * nwv[e];
              *(GAS v4u*)(YG + (size_t)(t0 + wid * 32 + k * 8 + j) * DI + g * 512 + lane * 8) = pack8f(v); } }
#undef SSD_LDB
    }
    __syncthreads();
}
__device__ __forceinline__ void ssd_out_phase(Frame& F, const Args& A, char* lds, int flag = 0) {
    for (int u = F.vcu; u < NCH * NG; u += F.G) out_unit(u >> 3, u & 7, A, lds, flag);
}
#undef SSD_TRRD
#undef SSD_F8
}

__device__ __forceinline__ void moba_sel_phase(Frame& F, const Args& A, char* lds) {
    unsigned char* ws = A.ws;
    for (int u = F.vcu; u < AH * 31; u += F.G)
        att::moba_sel_unit(u / 31, 1 + u % 31, (const bf16*)(ws + WS_Q), (const bf16*)(ws + WS_KBARB), (int*)(ws + WS_CNT), (int*)(ws + WS_LIST), lds);
}
__device__ __forceinline__ void moba_part_phase(Frame& F, const Args& A, char* lds, int flag = 0) {
    unsigned char* ws = A.ws;
    int* nu_s = (int*)(lds + att::OFF_KBAR);
    int* base_s = nu_s + 1024; int* mine_s = nu_s + 1536; int* nmine_s = nu_s + 1600;
    const int* CNT = (const int*)(ws + WS_CNT);
    if (F.tid < AH * NBLK) { const int cv = *(volatile const int*)(CNT + F.tid); nu_s[F.tid] = (cv + 255) >> 8; nu_s[512 + F.tid] = cv; }
    if (F.tid == 0) *nmine_s = 0;
    __syncthreads();
    if (F.tid < 64) {
        int v[8], s = 0;
#pragma unroll
        for (int i = 0; i < 8; ++i) { v[i] = nu_s[F.tid * 8 + i]; s += v[i]; }
        int incl = s;
#pragma unroll
        for (int o = 1; o < 64; o <<= 1) { const int t = __shfl_up(incl, o); if (F.tid >= o) incl += t; }
        int run = incl - s;
#pragma unroll
        for (int i = 0; i < 8; ++i) { base_s[F.tid * 8 + i] = run; run += v[i]; }
    }
    __syncthreads();
    if (F.tid < AH * NBLK) { const int base = base_s[F.tid], nu = nu_s[F.tid];
        int g = base + (((F.vcu - base) % F.G) + F.G) % F.G;
        for (; g < base + nu; g += F.G) { const int idx = atomicAdd(nmine_s, 1); if (idx < 64) mine_s[idx] = F.tid | ((g - base) << 16); } }
    __syncthreads();
    const int nmine = *nmine_s < 64 ? *nmine_s : 64;
    for (int i = 0; i < nmine; ++i) { const int e = __builtin_amdgcn_readfirstlane(mine_s[i]); const int hn = e & 0xffff, jj = e >> 16;
        att::moba_tile_unit<1>(hn >> 5, hn & 31, jj, (const bf16*)(ws + WS_Q), (const bf16*)(ws + WS_K), (const bf16*)(ws + WS_V), flag == 23 ? (bf16*)(ws + WS_Q) : nullptr, CNT, (const int*)(ws + WS_LIST),
                               (bf16*)(ws + WS_PART), (float*)(ws + WS_PML), A.in[I_REL], lds); }
}
__device__ __forceinline__ void moba_own_phase(Frame& F, const Args& A, char* lds, int flag = 0) {
    unsigned char* ws = A.ws;
    for (int u = F.vcu; u < AH * NBLK; u += F.G)
        att::moba_tile_unit<2>(u >> 5, u & 31, flag == 24 ? 1 : 0, (const bf16*)(ws + WS_Q), (const bf16*)(ws + WS_K), (const bf16*)(ws + WS_V), (flag == 22 || flag == 24) ? (bf16*)A.out : (bf16*)(ws + WS_Q), nullptr, nullptr,
                               (bf16*)(ws + WS_PART), (float*)(ws + WS_PML), A.in[I_REL], lds);
}

#if MK_VARIANT != 6
__global__ void diag_cmp(const bf16* __restrict__ a, const bf16* __restrict__ b, size_t n, unsigned* stat) {
    float md = 0.f, mb = 0.f;
    for (size_t i = (size_t)blockIdx.x * blockDim.x + threadIdx.x; i < n; i += (size_t)gridDim.x * blockDim.x) { const float x = bf2f(a[i]), y = bf2f(b[i]); const float d = fabsf(x - y); md = (d > md || d != d) ? d : md; mb = fmaxf(mb, fabsf(y)); }
    if (md != md) md = 1e30f;
    atomicMax(stat, __float_as_uint(md)); atomicMax(stat + 1, __float_as_uint(mb));
    float sd = 0.f, cnt = 0.f;
    for (size_t i = (size_t)blockIdx.x * blockDim.x + threadIdx.x; i < n; i += (size_t)gridDim.x * blockDim.x) { const float d = fabsf(bf2f(a[i]) - bf2f(b[i])); sd += d; cnt += (d > 0.02f) ? 1.f : 0.f; }
    sd = wave_sum(sd); cnt = wave_sum(cnt);
    if ((threadIdx.x & 63) == 0) { atomicAdd((float*)(stat + 2), sd); atomicAdd((float*)(stat + 3), cnt); }
}
__global__ void diag_emit(const unsigned* stat, float* out, float scale, int which) {
    if (threadIdx.x == 0 && blockIdx.x == 0) out[0] = __uint_as_float(stat[which]) * scale;
}

__global__ void diag_stamps(const unsigned long long* ts, float* out, int ka, int kb) {
    if (threadIdx.x == 0 && blockIdx.x == 0) {
        out[0] = (ka == 10) ? (float)(ts[10] - ts[0]) * 0.01f : (float)(ts[ka + 1] - ts[ka]) * 0.01f;
        out[1] = (kb == 10) ? (float)(ts[10] - ts[0]) * 0.01f : (float)(ts[kb + 1] - ts[kb]) * 0.01f; }
}
#endif

__global__ void __launch_bounds__(NTHR, 2) mk_fwd(Args args) {
    extern __shared__ __attribute__((aligned(16))) unsigned char lds[];
    Frame F;
    F.lds = (LAS unsigned char*)lds;
    volatile LAS unsigned* MISC = (volatile LAS unsigned*)(F.lds + MISC_OFF);
    F.tid = threadIdx.x; F.lane = F.tid & 63; F.wave = __builtin_amdgcn_readfirstlane(F.tid >> 6);
    F.G = gridDim.x; { const int bx = blockIdx.x; F.vcu = (F.G % 8 == 0) ? (bx % 8) * (F.G / 8) + bx / 8 : bx; }
    unsigned char* ws = args.ws;
    gu32* ctl = (gu32*)(ws + WS_CTL);
    for (int u = F.tid; u < (LDS_BYTES - LDSCTL_OFF) / 4; u += NTHR) ((LAS unsigned*)(F.lds + LDSCTL_OFF))[u] = 0u;
    __syncthreads();
    const int lo = args.ph_lo, hi = args.ph_hi;
    const bool multi = (hi - lo) > 1;
    XcdBarrier bar; bar.bar = (unsigned*)(ctl + CW_BAR) + args.li * XCD_BAR_WORDS; bar.x = 0; bar.st = nullptr;
    if (multi) bar = xcd_barrier_post((unsigned*)(ctl + CW_BAR) + args.li * XCD_BAR_WORDS, MISC + 8);
#define IN(k) (lo <= (k) && (k) < hi)
#if MK_STAMPS
    unsigned long long* tsp = (unsigned long long*)(ws + WS_CTL + 8192);
    if (blockIdx.x == 0 && F.tid == 0) tsp[0] = __builtin_amdgcn_s_memrealtime();
#define STAMP(k) do { if (blockIdx.x == 0 && F.tid == 0) tsp[(k) + 1] = __builtin_amdgcn_s_memrealtime(); } while (0)
#else
#define STAMP(k) do { } while (0)
#endif
#define SEAM(k) do { if (IN(k) && IN((k) + 1)) xcd_barrier(bar); STAMP(k); } while (0)

    const int flag = args.pad;
    if (IN(0)) { p0_prologue(F, args, 0); SEAM(0); }
    if (IN(1)) {
        pg8::Gemm g{(const bf16*)(ws + WS_XB), (const bf16*)(ws + WS_WIN), SEQ, NIN, DM}; pg8::StaticOrder S; S.init(SEQ, NIN, F.G, (int)blockIdx.x);
        pg8::EpiInProj E{(bf16*)(ws + WS_Z), (bf16*)(ws + WS_XBC), (bf16*)(ws + WS_Q), (bf16*)(ws + WS_K), (bf16*)(ws + WS_V), (bf16*)(ws + WS_GT), args.in[I_BG], flag};
        const int cls = (F.vcu >> 5) % 3;
        if (flag == 0) { if (cls >= 1) p0_prologue(F, args, 1); if (cls == 2) p0_prologue(F, args, 2); __syncthreads(); }
        pg8::gemm_phase<pg8::EpiInProj, pg8::StaticOrder, true, true>(F.lds + RING_OFF, g, S, E);
        if (flag == 0) { __syncthreads(); if (cls == 0) p0_prologue(F, args, 1); if (cls <= 1) p0_prologue(F, args, 2); __syncthreads(); }
        if (flag != 10 && flag != 11) dt_phase(F, args);
        SEAM(1);
    }
    if (IN(2)) { if (flag == 0) { attn_prep_phase(F, args); __syncthreads(); } ssd::ssd_states_phase(F, args, (char*)lds, flag); SEAM(2); }
    if (IN(3)) { ssd::ssd_scan_phase(F, args); moba_sel_phase(F, args, (char*)lds); SEAM(3); }
    if (IN(4)) { if (flag != 21 && flag != 23) ssd::ssd_out_phase(F, args, (char*)lds, flag); if (flag == 0 || flag == 21 || flag == 23) moba_part_phase(F, args, (char*)lds, flag); SEAM(4); }
    if (IN(5)) { moba_own_phase(F, args, (char*)lds, flag); SEAM(5); }
    if (IN(6)) {
        { pg8::Gemm g{(const bf16*)(ws + WS_YG), (const bf16*)(ws + WS_WSS), SEQ, DM, DI}; pg8::StaticOrder S; S.init(SEQ, DM, F.G, (int)blockIdx.x);
          pg8::EpiGateF32 E{(bf16*)args.out, (const bf16*)(ws + WS_GT), 0};
          pg8::gemm_phase<pg8::EpiGateF32, pg8::StaticOrder, true, true>(F.lds + RING_OFF, g, S, E); }
        { pg8::Gemm g{(const bf16*)(ws + WS_Q), (const bf16*)(ws + WS_WAT), SEQ, DM, DA}; pg8::StaticOrder S; S.init(SEQ, DM, F.G, (int)blockIdx.x);
          pg8::EpiGateAddBf16 E{(const bf16*)args.out, (const bf16*)(ws + WS_GT), DM, (bf16*)(ws + WS_XB)};
          pg8::gemm_phase<pg8::EpiGateAddBf16, pg8::StaticOrder, true, true>(F.lds + RING_OFF, g, S, E); }
        SEAM(6);
    }
    if (IN(7)) {
        pg8::Gemm g{(const bf16*)(ws + WS_XB), (const bf16*)(ws + WS_WOUT), SEQ, DM, DM}; pg8::StaticOrder S; S.init(SEQ, DM, F.G, (int)blockIdx.x);
        pg8::EpiResid1 E{args.in[I_X], flag == 30 ? (float*)(ws + WS_Z) : args.out, flag == 30 ? (bf16*)(ws + WS_V) : (bf16*)(ws + WS_K), (float*)(ws + WS_SS2), flag == 30};
        pg8::gemm_phase<pg8::EpiResid1, pg8::StaticOrder, true, true>(F.lds + RING_OFF, g, S, E);
        SEAM(7);
    }
    if (IN(8)) {
        { pg8::Gemm g{(const bf16*)(ws + WS_K), (const bf16*)(ws + WS_WUP), SEQ, DFF2, DM}; pg8::StaticOrder S; S.init(SEQ, 40 * 256, F.G, (int)blockIdx.x);
          pg8::EpiUpPre E{(bf16*)(ws + WS_UPRE), (const float*)(ws + WS_SS2), DFF2, 0};
          pg8::gemm_phase<pg8::EpiUpPre, pg8::StaticOrder, true, true>(F.lds + RING_OFF, g, S, E); }
        if (F.G == 256) { const int c = (int)blockIdx.x, tt = c & 127, half = c >> 7;
          pg8::Gemm g{(const bf16*)(ws + WS_K) + half * 1024, (const bf16*)(ws + WS_WUP) + half * 1024, SEQ, DFF2, 1024, DM};
          pg8::OneUnit S{{tt >> 2, 40 + (tt & 3)}};
          pg8::EpiUpPre E{half ? (bf16*)(ws + WS_UP2) : (bf16*)(ws + WS_UPRE), (const float*)(ws + WS_SS2), half ? 1024 : DFF2, half ? 40 * 256 : 0};
          pg8::gemm_phase<pg8::EpiUpPre, pg8::OneUnit, true, true>(F.lds + RING_OFF, g, S, E); }
        SEAM(8);
    }
    if (IN(9)) { ffn_act_phase(F, args); SEAM(9); }
    if (IN(10)) {
        pg8::Gemm g{(const bf16*)(ws + WS_ACT), (const bf16*)(ws + WS_WDN), SEQ, DM, DFF}; pg8::StaticOrder S; S.init(SEQ, DM, F.G, (int)blockIdx.x);
        pg8::EpiResid2 E{args.out, flag == 31 ? (float*)(ws + WS_Z) : args.out};
        pg8::gemm_phase<pg8::EpiResid2, pg8::StaticOrder, true, true>(F.lds + RING_OFF, g, S, E);
        STAMP(10);
    }
#undef IN
#undef SEAM
}

extern "C" void kernel_launch(void* const* d_in, const int* in_sizes, int n_in, void* d_out, int out_size, void* d_ws, size_t ws_size, hipStream_t stream) {
    static int grid = 0;
    if (grid == 0) {
        if (n_in != N_INPUTS || in_sizes[0] != SEQ * DM || out_size != SEQ * DM || ws_size < WS_END) {
            fprintf(stderr, "kernel_launch: unexpected shapes: n_in %d in0 %d out %d ws %zu (need %zu)\n", n_in, n_in > 0 ? in_sizes[0] : -1, out_size, ws_size, (size_t)WS_END); grid = -1; return; }
        int dev = 0, cus = 0;
        if (hipGetDevice(&dev) != hipSuccess || hipDeviceGetAttribute(&cus, hipDeviceAttributeMultiprocessorCount, dev) != hipSuccess) { grid = -1; return; }
        if (hipFuncSetAttribute((const void*)mk_fwd, hipFuncAttributeMaxDynamicSharedMemorySize, LDS_BYTES) != hipSuccess) { fprintf(stderr, "kernel_launch: hipFuncSetAttribute failed\n"); grid = -1; return; }
        (void)hipGetLastError();
        grid = cus;
    }
    if (grid < 0) return;
    (void)hipMemsetAsync((char*)d_ws + WS_CTL, 0, CTL_ZERO_BYTES, stream);
    Args a{};
    for (int i = 0; i < N_INPUTS; ++i) a.in[i] = (const float*)d_in[i];
    a.out = (float*)d_out; a.ws = (unsigned char*)d_ws;
    unsigned char* ws = (unsigned char*)d_ws;
    auto launch = [&](int lo, int hi, int li, int flag = 0) { a.ph_lo = lo; a.ph_hi = hi; a.li = li; a.pad = flag; hipLaunchKernelGGL(mk_fwd, dim3(grid), dim3(NTHR), LDS_BYTES, stream, a); };
#if MK_VARIANT == 6
    launch(0, 11, 0);
#endif
#if MK_VARIANT == 8
    for (int k = 0; k < 11; ++k) {
        if (k == EXTRA_PH && EXTRA_FLAG) launch(k, k + 1, 0, EXTRA_FLAG);
        launch(k, k + 1, 0);
        if (k == EXTRA_PH && !EXTRA_FLAG) launch(k, k + 1, 0, k == 2 ? 2 : (k == 4 ? 20 : 0));
    }
#endif
#if MK_VARIANT == 10
    (void)hipMemsetAsync(ws + WS_CTL + 1024, 0, 64, stream);
    for (int k = 0; k < 5; ++k) launch(k, k + 1, 0);
    (void)hipMemcpyAsync(d_out, ws + WS_Q, (size_t)SEQ * DA * 2, hipMemcpyDeviceToDevice, stream);
    launch(5, 6, 0);
    naive_attn<<<SEQ * AH / 4, 256, 0, stream>>>((const bf16*)d_out, (const bf16*)(ws + WS_K), (const bf16*)(ws + WS_V), (const bf16*)(ws + WS_KBARB), a.in[I_REL], (bf16*)d_out + (size_t)SEQ * DA);
    diag_cmp<<<1024, 256, 0, stream>>>((const bf16*)(ws + WS_Q), (const bf16*)d_out + (size_t)SEQ * DA, (size_t)SEQ * DA, (unsigned*)(ws + WS_CTL + 1024));
    for (int k = 6; k < 11; ++k) launch(k, k + 1, 0);
    diag_emit<<<1, 64, 0, stream>>>((const unsigned*)(ws + WS_CTL + 1024), (float*)d_out, DIAG_SCALE, DIAG_WHICH);
#endif
}
```

```cpp
#define MK_VARIANT 6
#define DIAG_SCALE 100000.0f
#define DIAG_WHICH 0
#define MK_STAMPS 0
#define STAMP_A 0
#define STAMP_B 1
#define EXTRA_PH -1
#define EXTRA_FLAG 0
#include <hip/hip_runtime.h>
#include <cstdio>
#include <cstdint>
#include <type_traits>
namespace pg8 {
#define PG8_LAS __attribute__((address_space(3)))
typedef unsigned short bf16_t;
typedef short bf16x8 __attribute__((ext_vector_type(8)));
typedef float f32x4 __attribute__((ext_vector_type(4)));
typedef unsigned u32x4 __attribute__((ext_vector_type(4)));
typedef unsigned u32x2 __attribute__((ext_vector_type(2)));
constexpr int BM = 256, BK = 64, HALF = 128, HTB = HALF * BK * 2  , STAGE_BYTES = 8 * HTB, NXCD = 8, WGM = 4;

__host__ __device__ __forceinline__ int lds_byte(int r, int c) { const int st = (r >> 4) * 2 + (c >> 5), rr = r & 15, cc = c & 31, ob = rr * 64 + cc * 2; return st * 1024 + (ob ^ (((ob >> 9) & 1) << 5)); }
__host__ __device__ __forceinline__ void stage_rc(int b, int& R, int& C) { const int st = b / 1024, sb = b % 1024, swz = sb ^ (((sb >> 9) & 1) << 5); R = (st >> 1) * 16 + swz / 64; C = (st & 1) * 32 + (swz % 64) / 2; }
__host__ __device__ __forceinline__ int perm32(int rho) { const int n = rho >> 4, i = rho & 15; return 8 * (i >> 2) + 4 * n + (i & 3); }

struct Unit { int pm, pn; };
struct Gemm { const bf16_t* A; const bf16_t* Bt; int M, N, K; int ld = 0; };

struct StaticOrder {
    int nM, nN, nwg, G, c;
    __host__ __device__ void init(int M, int N, int G_, int c_) { nM = M / BM; nN = N / BM; nwg = nM * nN; G = G_; c = c_; }
    __host__ __device__ bool next(int i, Unit& u) const {
        const long L = (long)i * G + c; if (L >= nwg) return false;
        int wgid = (int)L; { const int q = nwg / NXCD, r = nwg % NXCD, xcd = wgid % NXCD, off = wgid / NXCD; wgid = (xcd < r ? xcd * (q + 1) : r * (q + 1) + (xcd - r) * q) + off; }
        const int nig = WGM * nN, gid = wgid / nig, fm = gid * WGM, gsz = (nM - fm) < WGM ? (nM - fm) : WGM;
        u.pm = fm + ((wgid % nig) % gsz); u.pn = (wgid % nig) / gsz; return true;
    }
    __device__ __forceinline__ void a_ready(const Unit&) const {}
    __device__ __forceinline__ void done(const Unit&) const {}
};

__device__ __forceinline__ unsigned cvt_pk_bf16(float lo, float hi) { unsigned r; asm volatile("v_cvt_pk_bf16_f32 %0, %1, %2" : "=v"(r) : "v"(lo), "v"(hi)); return r; }
typedef float f32x2 __attribute__((ext_vector_type(2)));
template <class E, class = void> struct epi_perma { static constexpr bool value = false; };
template <class E> struct epi_perma<E, std::void_t<decltype(E::PERMA)>> { static constexpr bool value = E::PERMA; };
template <class Epi, class Sched, bool ALIGN_EPI = false, bool SP2 = false, bool DUAL = false>
__device__ __forceinline__ void gemm_phase(PG8_LAS unsigned char* lds, const Gemm g, const Sched& S, const Epi& E, const Gemm g2 = Gemm{nullptr, nullptr, 0, 0, 0, 0}) {
    const int tid = threadIdx.x, wid = __builtin_amdgcn_readfirstlane(tid >> 6), lane = tid & 63, wr = wid >> 2, wc = wid & 3, fr = lane & 15, fq = lane >> 4;
    const int K = g.ld ? g.ld : g.K  , nt1 = g.K / BK, nt = nt1 + (DUAL ? g2.K / BK : 0);
    const int K2 = DUAL ? (g2.ld ? g2.ld : g2.K) : K;
    unsigned voffA[2], voffB[2], voffA2[2], voffB2[2];
#pragma unroll
    for (int i = 0; i < 2; ++i) { int R, C; stage_rc(tid * 16 + i * 8192, R, C); const int Rb = Epi::PERM ? ((R & ~31) + perm32(R & 31)) : R;
        const int Ra = epi_perma<Epi>::value ? ((R & ~63) + 4 * (R & 15) + ((R >> 4) & 3)) : R;
        voffA[i] = (unsigned)(Ra * K + C) * 2u; voffB[i] = (unsigned)(Rb * K + C) * 2u; voffA2[i] = (unsigned)(Ra * K2 + C) * 2u; voffB2[i] = (unsigned)(Rb * K2 + C) * 2u; }
    const size_t hstep2 = (size_t)HALF * K2 * 2, tstep2 = 2 * hstep2;
    const size_t kstep = (size_t)(BK * 2);
    const size_t hstep = (size_t)HALF * K * 2;
    const size_t tstep = 2 * hstep;
    const unsigned ldsw = (unsigned)wid * 1024u;
    const int aoff = lds_byte(wr * 64 + fr, fq * 8), boff = lds_byte(wc * 32 + fr, fq * 8);
#define PG8_SA(b, h) (((b) * 2 + (h)) * HTB)
#define PG8_SB(b, h) ((4 + (b) * 2 + (h)) * HTB)
#define PG8_STAGE(bufoff, gbase, voff) do { _Pragma("unroll") for (int _i = 0; _i < 2; ++_i) \
        __builtin_amdgcn_global_load_lds((const unsigned*)((const char*)(gbase) + (voff)[_i]), (PG8_LAS unsigned*)(lds + (bufoff) + ldsw + _i * 8192), 16, 0, 0); } while (0)
#define PG8_LDA(dst, b, h) do { _Pragma("unroll") for (int m = 0; m < 4; ++m) _Pragma("unroll") for (int k = 0; k < 2; ++k) dst[m][k] = *(const PG8_LAS bf16x8*)(lds + PG8_SA(b, h) + aoff + m * 2048 + k * 1024); } while (0)
#define PG8_LDB(dst, b, h) do { _Pragma("unroll") for (int n = 0; n < 2; ++n) _Pragma("unroll") for (int k = 0; k < 2; ++k) dst[n][k] = *(const PG8_LAS bf16x8*)(lds + PG8_SB(b, h) + boff + n * 2048 + k * 1024); } while (0)
#define PG8_MMA(ai, bj, At, Bt) do { __builtin_amdgcn_s_setprio(1); _Pragma("unroll") for (int m = 0; m < 4; ++m) _Pragma("unroll") for (int n = 0; n < 2; ++n) _Pragma("unroll") for (int k = 0; k < 2; ++k) \
        acc[ai][bj][m][n] = __builtin_amdgcn_mfma_f32_16x16x32_bf16(Bt[n][k], At[m][k], acc[ai][bj][m][n], 0, 0, 0); __builtin_amdgcn_s_setprio(0); } while (0)
#define PG8_WAIT_V(n) asm volatile("s_waitcnt vmcnt(" #n ")" ::: "memory")
#define PG8_WAIT_L(n) asm volatile("s_waitcnt lgkmcnt(" #n ")" ::: "memory")
#define PG8_BAR __builtin_amdgcn_s_barrier()
#define PG8_SCHED __builtin_amdgcn_sched_barrier(0)
    Unit cur, nxt; int ui = 0;
    if (!S.next(0, cur)) return;
    f32x4 acc[2][2][4][2];
#pragma unroll
    for (int a = 0; a < 2; ++a)
#pragma unroll
        for (int b = 0; b < 2; ++b)
#pragma unroll
            for (int m = 0; m < 4; ++m)
#pragma unroll
                for (int n = 0; n < 2; ++n) acc[a][b][m][n] = (f32x4){0.f, 0.f, 0.f, 0.f};
    bf16x8 At[4][2], B0[2][2], B1[2][2];
    const char* cA = (const char*)g.A + (size_t)cur.pm * tstep; const char* cB = (const char*)g.Bt + (size_t)cur.pn * tstep;
    const char* cA2 = DUAL ? (const char*)g2.A + (size_t)cur.pm * tstep2 : cA; const char* cB2 = DUAL ? (const char*)g2.Bt + (size_t)cur.pn * tstep2 : cB;
    S.a_ready(cur);
    if constexpr (SP2) {
        PG8_STAGE(PG8_SB(0, 0), cB, voffB); PG8_STAGE(PG8_SB(0, 1), cB + hstep, voffB); PG8_STAGE(PG8_SA(0, 0), cA, voffA); PG8_STAGE(PG8_SA(0, 1), cA + hstep, voffA);
        if (wr == 1) PG8_BAR;
        PG8_WAIT_V(2); PG8_BAR;
        PG8_STAGE(PG8_SB(1, 0), cB + kstep, voffB); PG8_STAGE(PG8_SA(1, 0), cA + kstep, voffA); PG8_STAGE(PG8_SB(1, 1), cB + hstep + kstep, voffB);
        PG8_WAIT_V(6); PG8_BAR;
    } else {
        PG8_STAGE(PG8_SB(0, 0), cB, voffB); PG8_STAGE(PG8_SA(0, 0), cA, voffA); PG8_STAGE(PG8_SB(0, 1), cB + hstep, voffB); PG8_STAGE(PG8_SA(0, 1), cA + hstep, voffA);
        if (wr == 1) PG8_BAR;
        PG8_WAIT_V(4); PG8_BAR;
        PG8_STAGE(PG8_SB(1, 0), cB + kstep, voffB); PG8_STAGE(PG8_SA(1, 0), cA + kstep, voffA); PG8_STAGE(PG8_SB(1, 1), cB + hstep + kstep, voffB);
        PG8_WAIT_V(6); PG8_BAR;
    }
    for (;;) {
        const bool has_next = S.next(ui + 1, nxt);
        const char* nA = has_next ? (const char*)g.A + (size_t)nxt.pm * tstep : cA; const char* nB = has_next ? (const char*)g.Bt + (size_t)nxt.pn * tstep : cB;
        for (int t = 0; t < nt; t += 2) {
            const bool last = (t == nt - 2);
            const bool sg1 = DUAL && t >= nt1, sg2 = DUAL && !last && t + 2 >= nt1;
            const char* a1 = sg1 ? cA2 + (size_t)(t + 1 - nt1) * kstep : cA + (size_t)(t + 1) * kstep;
            const char* a2 = last ? nA : sg2 ? cA2 + (size_t)(t + 2 - nt1) * kstep : cA + (size_t)(t + 2) * kstep;
            const char* b2 = last ? nB : sg2 ? cB2 + (size_t)(t + 2 - nt1) * kstep : cB + (size_t)(t + 2) * kstep;
            const char* a3 = a2 + kstep; const char* b3 = b2 + kstep;
            const size_t hs1 = sg1 ? hstep2 : hstep, hs2 = sg2 ? hstep2 : hstep;
            const unsigned vA1[2] = {sg1 ? voffA2[0] : voffA[0], sg1 ? voffA2[1] : voffA[1]}, vA2[2] = {sg2 ? voffA2[0] : voffA[0], sg2 ? voffA2[1] : voffA[1]}, vB2[2] = {sg2 ? voffB2[0] : voffB[0], sg2 ? voffB2[1] : voffB[1]};
            if constexpr (DUAL) { if (t == nt1) { PG8_SCHED; E.mid(acc, cur, wr, wc, fr, fq); PG8_SCHED; } }
            if (last && has_next) S.a_ready(nxt);
            if constexpr (SP2) {
            PG8_LDB(B0, 0, 0); PG8_LDB(B1, 0, 1); PG8_SCHED; PG8_LDA(At, 0, 0); PG8_STAGE(PG8_SA(1, 1), a1 + hs1, vA1);
            PG8_WAIT_V(8); PG8_WAIT_L(0); PG8_BAR; PG8_MMA(0, 0, At, B0); PG8_MMA(0, 1, At, B1); PG8_BAR; PG8_SCHED;
            PG8_LDA(At, 0, 1); PG8_STAGE(PG8_SB(0, 0), b2, vB2); PG8_STAGE(PG8_SB(0, 1), b2 + hs2, vB2); PG8_STAGE(PG8_SA(0, 0), a2, vA2);
            PG8_WAIT_V(8); PG8_WAIT_L(0); PG8_BAR; PG8_MMA(1, 0, At, B0); PG8_MMA(1, 1, At, B1); PG8_BAR; PG8_SCHED;
            PG8_LDB(B0, 1, 0); PG8_LDB(B1, 1, 1); PG8_SCHED; PG8_LDA(At, 1, 0); PG8_STAGE(PG8_SA(0, 1), a2 + hs2, vA2);
            PG8_WAIT_V(8); PG8_WAIT_L(0); PG8_BAR; PG8_MMA(0, 0, At, B0); PG8_MMA(0, 1, At, B1); PG8_BAR; PG8_SCHED;
            PG8_LDA(At, 1, 1); PG8_STAGE(PG8_SB(1, 0), b3, vB2); PG8_STAGE(PG8_SB(1, 1), b3 + hs2, vB2); PG8_STAGE(PG8_SA(1, 0), a3, vA2);
            PG8_WAIT_V(8); PG8_WAIT_L(0); PG8_BAR; PG8_MMA(1, 0, At, B0); PG8_MMA(1, 1, At, B1); PG8_BAR; PG8_SCHED;
            } else {
            static_assert(SP2 || !DUAL, "DUAL needs the SP2 loop");
            PG8_LDB(B0, 0, 0); PG8_SCHED; PG8_LDA(At, 0, 0); PG8_STAGE(PG8_SA(1, 1), a1 + hstep, voffA);
            PG8_WAIT_L(8); PG8_BAR; PG8_WAIT_L(0); PG8_MMA(0, 0, At, B0); PG8_BAR; PG8_SCHED;
            PG8_LDB(B1, 0, 1); PG8_STAGE(PG8_SB(0, 0), b2, voffB);
            PG8_BAR; PG8_WAIT_L(0); PG8_MMA(0, 1, At, B1); PG8_BAR;
            PG8_LDA(At, 0, 1); PG8_STAGE(PG8_SA(0, 0), a2, voffA);
            PG8_BAR; PG8_WAIT_L(0); PG8_MMA(1, 0, At, B0); PG8_BAR; PG8_SCHED;
            PG8_STAGE(PG8_SB(0, 1), b2 + hstep, voffB);
            PG8_WAIT_V(6); PG8_BAR; PG8_MMA(1, 1, At, B1); PG8_BAR;
            PG8_LDB(B0, 1, 0); PG8_SCHED; PG8_LDA(At, 1, 0); PG8_STAGE(PG8_SA(0, 1), a2 + hstep, voffA);
            PG8_WAIT_L(8); PG8_BAR; PG8_WAIT_L(0); PG8_MMA(0, 0, At, B0); PG8_BAR; PG8_SCHED;
            PG8_LDB(B1, 1, 1); PG8_STAGE(PG8_SB(1, 0), b3, voffB);
            PG8_BAR; PG8_WAIT_L(0); PG8_MMA(0, 1, At, B1); PG8_BAR;
            PG8_LDA(At, 1, 1); PG8_STAGE(PG8_SA(1, 0), a3, voffA);
            PG8_BAR; PG8_WAIT_L(0); PG8_MMA(1, 0, At, B0); PG8_BAR; PG8_SCHED;
            PG8_STAGE(PG8_SB(1, 1), b3 + hstep, voffB);
            PG8_WAIT_V(6); PG8_BAR; PG8_MMA(1, 1, At, B1); PG8_BAR;
            }
        }
        if constexpr (ALIGN_EPI) { if (wr == 0) PG8_BAR; }
        if constexpr (!Epi::AFTER_DRAIN) { E(acc, cur, wr, wc, fr, fq); S.done(cur); }
        if (!has_next) break;
#pragma unroll
        for (int a = 0; a < 2; ++a)
#pragma unroll
            for (int b = 0; b < 2; ++b)
#pragma unroll
                for (int m = 0; m < 4; ++m)
#pragma unroll
                    for (int n = 0; n < 2; ++n) acc[a][b][m][n] = (f32x4){0.f, 0.f, 0.f, 0.f};
        cur = nxt; cA = nA; cB = nB; ++ui;
        if constexpr (DUAL) { cA2 = (const char*)g2.A + (size_t)cur.pm * tstep2; cB2 = (const char*)g2.Bt + (size_t)cur.pn * tstep2; }
        if constexpr (ALIGN_EPI) { if (wr == 1) PG8_BAR; }
    }
    PG8_WAIT_V(0);
    if constexpr (!ALIGN_EPI) { if (wr == 0) PG8_BAR; }
    PG8_BAR;
    if constexpr (Epi::AFTER_DRAIN) { E.fused(acc, cur, wr, wc, fr, fq, lds, wid, lane); S.done(cur); }
#undef PG8_SA
#undef PG8_SB
#undef PG8_STAGE
#undef PG8_LDA
#undef PG8_LDB
#undef PG8_MMA
#undef PG8_WAIT_V
#undef PG8_WAIT_L
#undef PG8_BAR
#undef PG8_SCHED
}
}

#define GAS __attribute__((address_space(1)))
#define LAS __attribute__((address_space(3)))
typedef unsigned short bf16;
typedef unsigned v4u __attribute__((ext_vector_type(4)));
typedef unsigned v2u __attribute__((ext_vector_type(2)));
typedef float f32x4 __attribute__((ext_vector_type(4)));
typedef float f32x2 __attribute__((ext_vector_type(2)));
typedef float f32x16 __attribute__((ext_vector_type(16)));
typedef short bf16x8 __attribute__((ext_vector_type(8)));
typedef short s16x4 __attribute__((ext_vector_type(4)));
typedef GAS unsigned gu32;
#define RLX_AGENT __ATOMIC_RELAXED, __HIP_MEMORY_SCOPE_AGENT
#define LDS_WAIT() asm volatile("s_waitcnt lgkmcnt(0)" ::: "memory")
#define VM_WAIT() asm volatile("s_waitcnt vmcnt(0)" ::: "memory")

constexpr int NWAVES = 8, NTHR = 512;
constexpr int SEQ = 8192, DM = 2048, DI = 4096, NHS = 64, HP = 64, NG = 8, NST = 128, DXBC = 6144, CHK = 256, NCH = 32;
constexpr int AH = 16, AD = 128, DA = 2048, BLK = 256, NBLK = 32;
constexpr int DFF = 5632, DFF2 = 11264;
constexpr int NIN = 20480;
constexpr int DINP = 20544;
constexpr float EPS = 1e-6f;

enum { I_X = 0, I_ANW, I_WIN, I_BG, I_SCW, I_SCB, I_DTB, I_ALOG, I_SD, I_SNW, I_QNW, I_KNW, I_REL, I_WSS, I_WAT, I_WOUT, I_FNW, I_WUP, I_FCW, I_FCB, I_WDN, N_INPUTS };

constexpr size_t MiB = 1u << 20;
constexpr size_t WS_CTL = 0, CTL_ZERO_BYTES = 256 * 1024;
constexpr size_t WS_R1 = 1 * MiB;
constexpr size_t WS_SS2 = WS_R1 + 64 * 1024;
constexpr size_t WS_KBAR = WS_SS2 + 64 * 1024;
constexpr size_t WS_KBARB = WS_KBAR + 256 * 1024;
constexpr size_t WS_CNT = WS_KBARB + 128 * 1024;
constexpr size_t WS_DT = 2 * MiB;
constexpr size_t WS_ACS = 4 * MiB;
constexpr size_t WS_WIN = 16 * MiB;
constexpr size_t WS_HPREV = 48 * MiB;
constexpr size_t WS_STATES = 16 * MiB;
constexpr size_t WS_BCC = 200 * MiB;
constexpr size_t WS_UP2 = 16 * MiB;
constexpr size_t WS_WSS = 100 * MiB;
constexpr size_t WS_WAT = 116 * MiB;
constexpr size_t WS_WOUT = 124 * MiB;
constexpr size_t WS_WUP = 132 * MiB;
constexpr size_t WS_WDN = 176 * MiB;
constexpr size_t WS_XB = 200 * MiB;
constexpr size_t WS_Z = 232 * MiB;
constexpr size_t WS_XBC = 296 * MiB;
constexpr size_t WS_Q = 392 * MiB;
constexpr size_t WS_K = 424 * MiB;
constexpr size_t WS_V = 456 * MiB;
constexpr size_t WS_GT = 488 * MiB;
constexpr size_t WS_YG = 556 * MiB;
constexpr size_t WS_UPRE = 232 * MiB;
constexpr size_t WS_ACT = 456 * MiB;
constexpr size_t WS_PML = 82 * MiB;
constexpr size_t WS_PART = 296 * MiB;
constexpr size_t WS_LIST = 620 * MiB;
constexpr size_t WS_HALO = 40 * MiB;
constexpr size_t WS_END = 636 * MiB;

constexpr int CW_BAR = 4096;

typedef __bf16 hwbf16x2 __attribute__((ext_vector_type(2)));
__device__ __forceinline__ unsigned pk2(float lo, float hi) { const f32x2 v = {lo, hi}; return __builtin_bit_cast(unsigned, __builtin_convertvector(v, hwbf16x2)); }
__device__ __forceinline__ unsigned f2bf(float f) { return pk2(f, 0.f) & 0xffffu; }
__device__ __forceinline__ float bf2f(unsigned short b) { return __builtin_bit_cast(float, (unsigned)b << 16); }
__device__ __forceinline__ float bflo(unsigned w) { return __builtin_bit_cast(float, w << 16); }
__device__ __forceinline__ float bfhi(unsigned w) { return __builtin_bit_cast(float, w & 0xffff0000u); }
__device__ __forceinline__ float siluf(float v) { return v * __builtin_amdgcn_rcpf(1.f + __expf(-v)); }
__device__ __forceinline__ float sigmf(float v) { return __builtin_amdgcn_rcpf(1.f + __expf(-v)); }
__device__ __forceinline__ float dpp_xor1(float x) { return __builtin_bit_cast(float, __builtin_amdgcn_mov_dpp(__builtin_bit_cast(int, x), 0xB1, 0xF, 0xF, true)); }
__device__ __forceinline__ float wave_sum(float v) {
    v += __builtin_bit_cast(float, __builtin_amdgcn_mov_dpp(__builtin_bit_cast(int, v), 0xB1, 0xF, 0xF, true));
    v += __builtin_bit_cast(float, __builtin_amdgcn_mov_dpp(__builtin_bit_cast(int, v), 0x4E, 0xF, 0xF, true));
    v += __builtin_bit_cast(float, __builtin_amdgcn_mov_dpp(__builtin_bit_cast(int, v), 0x141, 0xF, 0xF, true));
    v += __builtin_bit_cast(float, __builtin_amdgcn_mov_dpp(__builtin_bit_cast(int, v), 0x140, 0xF, 0xF, true));
    const int iv = __builtin_bit_cast(int, v);
    const float r0 = __builtin_bit_cast(float, __builtin_amdgcn_readlane(iv, 0)), r1 = __builtin_bit_cast(float, __builtin_amdgcn_readlane(iv, 16)),
                r2 = __builtin_bit_cast(float, __builtin_amdgcn_readlane(iv, 32)), r3 = __builtin_bit_cast(float, __builtin_amdgcn_readlane(iv, 48));
    return (r0 + r1) + (r2 + r3);
}

#define XB_TMO      128
#define XB_XCNT(j)  (256  + 64 * (j))
#define XB_XSUB(j)  (1280 + 64 * (j))
#define XB_XGEN(j)  (2304 + 64 * (j))
#define XB_TOP      3328
#define XB_TOPGEN   3392
#define XCD_BAR_WORDS 3456
#define XB_SPIN_CAP (1u << 20)
__device__ __forceinline__ unsigned xb_ld(unsigned* p)              { return __hip_atomic_load(p, __ATOMIC_RELAXED, __HIP_MEMORY_SCOPE_AGENT); }
__device__ __forceinline__ unsigned xb_add(unsigned* p, unsigned v) { return __hip_atomic_fetch_add(p, v, __ATOMIC_RELAXED, __HIP_MEMORY_SCOPE_AGENT); }
__device__ __forceinline__ unsigned xb_xcc_id() { return (unsigned)__builtin_amdgcn_s_getreg((3 << 11) | 20) & 0xFu; }
#define XB_SPIN(cond, bar) do { unsigned _sp = 0; while (cond) { __builtin_amdgcn_s_sleep(1); \
    if ((++_sp & 255u) == 0u) { if (xb_ld(&(bar)[XB_TMO])) break; if (_sp > XB_SPIN_CAP) { atomicAdd(&(bar)[XB_TMO], 1u); break; } } } } while (0)
struct XcdBarrier { unsigned* bar; unsigned x; volatile LAS unsigned* st; };
__device__ __forceinline__ XcdBarrier xcd_barrier_post(unsigned* bar, volatile LAS unsigned* st) {
    XcdBarrier b; b.bar = bar; b.x = xb_xcc_id(); b.st = st;
    if (threadIdx.x == 0) (void)xb_add(&bar[XB_XCNT(b.x)], 1u);
    return b;
}
__device__ __forceinline__ void xcd_barrier_complete(unsigned* bar, unsigned x, unsigned& nloc, unsigned& nx) {
    const unsigned G = gridDim.x * gridDim.y * gridDim.z;
    unsigned sum, cnt, mine, sp = 0u;
    for (;;) {
        sum = 0u; cnt = 0u; mine = 0u;
#pragma unroll
        for (unsigned j = 0; j < 16; ++j) { const unsigned c = xb_ld(&bar[XB_XCNT(j)]); sum += c; cnt += (c > 0u) ? 1u : 0u; mine = (j == x) ? c : mine; }
        if (sum == G) break;
        __builtin_amdgcn_s_sleep(1);
        if ((++sp & 255u) == 0u) { if (xb_ld(&bar[XB_TMO])) break; if (sp > XB_SPIN_CAP) { atomicAdd(&bar[XB_TMO], 1u); break; } }
    }
    nloc = mine > 0u ? mine : 1u; nx = cnt > 0u ? cnt : 1u;
}
__device__ __forceinline__ void xcd_barrier(const XcdBarrier& b) {
    asm volatile("s_waitcnt vmcnt(0)" ::: "memory");
    __syncthreads();
    if (threadIdx.x == 0) {
        unsigned* bar = b.bar;
        __builtin_amdgcn_s_waitcnt(0);
        unsigned nloc = b.st[0], nx = b.st[1];
        if (nloc == 0u) { xcd_barrier_complete(bar, b.x, nloc, nx); b.st[0] = nloc; b.st[1] = nx; }
        const unsigned old = xb_add(&bar[XB_XSUB(b.x)], 1u);
        const unsigned gen = old / nloc;
        if (old + 1u == (gen + 1u) * nloc) {
            __builtin_amdgcn_fence(__ATOMIC_RELEASE, "agent");
            asm volatile("s_waitcnt vmcnt(0)" ::: "memory");
            const unsigned og = xb_add(&bar[XB_TOP], 1u);
            const unsigned tg = og / nx;
            if (og + 1u == (tg + 1u) * nx) xb_add(&bar[XB_TOPGEN], 1u);
            else XB_SPIN(xb_ld(&bar[XB_TOPGEN]) == tg, bar);
            __builtin_amdgcn_fence(__ATOMIC_ACQUIRE, "agent");
            xb_add(&bar[XB_XGEN(b.x)], 1u);
            asm volatile("s_waitcnt vmcnt(0)" ::: "memory");
        } else {
            XB_SPIN(xb_ld(&bar[XB_XGEN(b.x)]) == gen, bar);
            __builtin_amdgcn_fence(__ATOMIC_ACQUIRE, "agent");
            asm volatile("s_waitcnt vmcnt(0)" ::: "memory");
        }
    }
    __syncthreads();
}

constexpr int RING_OFF = 0, RING_BYTES = 131072;
constexpr int LDS_BYTES = 163840;
constexpr int QK_SCR_OFF = RING_OFF + RING_BYTES;
static_assert(QK_SCR_OFF + 10240 <= LDS_BYTES - 1024, "q/k epilogue scratch overlaps the control words");
constexpr int LDSCTL_OFF = LDS_BYTES - 1024, MISC_OFF = LDSCTL_OFF + 320;

struct Args { const float* in[N_INPUTS]; float* out; unsigned char* ws; int ph_lo, ph_hi, li, pad; };
static_assert(sizeof(Args) == N_INPUTS * 8 + 8 + 8 + 16, "Args has no padding");

struct Frame {
    LAS unsigned char* lds;
    int tid, lane, wave, vcu, G;
};

__device__ __forceinline__ int map_ident(int n) { return n; }
__device__ __forceinline__ int map_win(int n) { return n < 10240 ? n : (n < 10304 ? 20480 + (n - 10240) : n - 64); }
__device__ __forceinline__ int map_wup(int n) { const int bj = n >= DFF ? 1 : 0, c = n - bj * DFF; return 256 * (c >> 7) + 128 * bj + (c & 127); }
template <int MAP>
__device__ __forceinline__ void p0_transpose_item(const float* __restrict__ W, int K, int N, bf16* WT, const float* __restrict__ kscale, LAS float* scr, int item, int lane) {
    const int nblk = (N + 63) / 64, kb = item / nblk, nb = item % nblk, k0 = 64 * kb, n0 = 64 * nb;
    const int kq = lane >> 4, nq = (lane & 15) * 4;
    const bool okn = (n0 + nq) < N;
    f32x4 v[16];
#pragma unroll
    for (int i = 0; i < 16; ++i) v[i] = okn ? __builtin_nontemporal_load((const GAS f32x4*)(W + (size_t)(k0 + 4 * i + kq) * N + n0 + nq)) : (f32x4){0.f, 0.f, 0.f, 0.f};
    if (kscale) {
#pragma unroll
        for (int i = 0; i < 16; ++i) v[i] = v[i] * kscale[k0 + 4 * i + kq]; }
#pragma unroll
    for (int i = 0; i < 16; ++i) { LAS float* d = scr + (4 * i + kq) * 65 + nq; d[0] = v[i][0]; d[1] = v[i][1]; d[2] = v[i][2]; d[3] = v[i][3]; }
    LDS_WAIT(); asm volatile("" ::: "memory");
    const int c = lane & 7;
#pragma unroll
    for (int j = 0; j < 8; ++j) { const int n = (lane >> 3) + 8 * j; const LAS float* s = scr + (8 * c) * 65 + n;
        v4u o; o.x = pk2(s[0 * 65], s[1 * 65]); o.y = pk2(s[2 * 65], s[3 * 65]); o.z = pk2(s[4 * 65], s[5 * 65]); o.w = pk2(s[6 * 65], s[7 * 65]);
        const int nn = n0 + n; const int dr = (MAP == 1) ? map_win(nn) : (MAP == 2) ? map_wup(nn) : nn;
        if (nn < N) { if (MAP != 1) __builtin_nontemporal_store(o, (GAS v4u*)(WT + (size_t)dr * K + k0 + 8 * c));
                      else *(GAS v4u*)(WT + (size_t)dr * K + k0 + 8 * c) = o; } }
    LDS_WAIT(); asm volatile("" ::: "memory");
}
__device__ __forceinline__ void p0_prologue(Frame& F, const Args& A, int part) {
    LAS float* scr = (LAS float*)(F.lds + RING_OFF + F.wave * 16640);
    const int gw = F.vcu * NWAVES + F.wave, NGW = F.G * NWAVES;
    unsigned char* ws = A.ws;
    constexpr int IT_WIN = (DM / 64) * ((DINP + 63) / 64), IT_WSS = (DI / 64) * (DM / 64), IT_WAT = (DA / 64) * (DM / 64), IT_WOUT = (DM / 64) * (DM / 64),
                  IT_WUP = (DM / 64) * (DFF2 / 64), IT_WDN = (DFF / 64) * (DM / 64);
    constexpr int NREST = IT_WSS + IT_WAT + IT_WOUT + IT_WUP + IT_WDN;
    if (part == 0) {
        for (int it = gw; it < IT_WIN; it += NGW) p0_transpose_item<1>(A.in[I_WIN], DM, DINP, (bf16*)(ws + WS_WIN), A.in[I_ANW], scr, it, F.lane);
    } else {
        for (int it = gw + (part - 1) * NGW; it < NREST; it += 2 * NGW) {
            int r = it;
            if (r < IT_WSS) { p0_transpose_item<0>(A.in[I_WSS], DI, DM, (bf16*)(ws + WS_WSS), nullptr, scr, r, F.lane); continue; } r -= IT_WSS;
            if (r < IT_WAT) { p0_transpose_item<0>(A.in[I_WAT], DA, DM, (bf16*)(ws + WS_WAT), nullptr, scr, r, F.lane); continue; } r -= IT_WAT;
            if (r < IT_WOUT) { p0_transpose_item<0>(A.in[I_WOUT], DM, DM, (bf16*)(ws + WS_WOUT), nullptr, scr, r, F.lane); continue; } r -= IT_WOUT;
            if (r < IT_WUP) { p0_transpose_item<2>(A.in[I_WUP], DM, DFF2, (bf16*)(ws + WS_WUP), A.in[I_FNW], scr, r, F.lane); continue; } r -= IT_WUP;
            p0_transpose_item<0>(A.in[I_WDN], DFF, DM, (bf16*)(ws + WS_WDN), nullptr, scr, r, F.lane);
        }
        return;
    }
    if (F.vcu == 0) ((int*)(ws + WS_CNT))[F.tid] = 0;
    float* r1 = (float*)(ws + WS_R1); float* ss2 = (float*)(ws + WS_SS2);
    bf16* xb = (bf16*)(ws + WS_XB);
    for (int m = gw; m < SEQ; m += NGW) {
        const GAS f32x4* xr = (const GAS f32x4*)(A.in[I_X] + (size_t)m * DM) + F.lane;
        f32x4 v[8]; float s = 0.f;
#pragma unroll
        for (int j = 0; j < 8; ++j) { v[j] = __builtin_nontemporal_load(xr + 64 * j); s += (v[j].x * v[j].x + v[j].y * v[j].y) + (v[j].z * v[j].z + v[j].w * v[j].w); }
        s = wave_sum(s);
        const float rr = 1.0f / sqrtf(s * (1.0f / DM) + EPS);
        GAS unsigned long long* o8 = (GAS unsigned long long*)(xb + (size_t)m * DM) + F.lane;
#pragma unroll
        for (int j = 0; j < 8; ++j) o8[64 * j] = (unsigned long long)pk2(v[j].x * rr, v[j].y * rr) | ((unsigned long long)pk2(v[j].z * rr, v[j].w * rr) << 32);
        if (F.lane == 0) { r1[m] = rr; ss2[m] = 0.f; }
    }
}

namespace pg8 {
__device__ __forceinline__ f32x4 bf2f4(const u32x4 v_, bool lo_) { const unsigned a_ = lo_ ? v_.x : v_.z, b_ = lo_ ? v_.y : v_.w; return (f32x4){__builtin_bit_cast(float, a_ << 16), __builtin_bit_cast(float, a_ & 0xffff0000u), __builtin_bit_cast(float, b_ << 16), __builtin_bit_cast(float, b_ & 0xffff0000u)}; }
#define PG8_BF2F4(v_, lo_) bf2f4(v_, lo_)
struct EpiInProj {
    static constexpr bool PERM = true, AFTER_DRAIN = false;
    bf16_t *z, *xbc, *q, *k, *v, *gt; const float* bg; int flag;
    PG8_LAS float* scr; const float* qnw; const float* knw; float* kbar; bf16_t* kbarb;
    __device__ __forceinline__ void qk_tile(const f32x4 (&acc)[2][2][4][2], const Unit& u, int wr, int wc, int fr, int fq, bool isk) const {
        const int pnl = u.pn - (isk ? 48 : 40);
        bf16_t* base = isk ? k : q;
        PG8_LAS float* part = scr;
        PG8_LAS float* red = scr + 2048;
#pragma unroll
        for (int ai = 0; ai < 2; ++ai)
#pragma unroll
            for (int m = 0; m < 4; ++m) { const int rt = ai * HALF + wr * 64 + m * 16 + fr;
#pragma unroll
                for (int bj = 0; bj < 2; ++bj) { const f32x4 a = acc[ai][bj][m][0], b = acc[ai][bj][m][1];
                    float s = (a[0] * a[0] + a[1] * a[1]) + (a[2] * a[2] + a[3] * a[3]) + (b[0] * b[0] + b[1] * b[1]) + (b[2] * b[2] + b[3] * b[3]);
                    s += __shfl_xor(s, 16); s += __shfl_xor(s, 32);
                    if (fq == 0) part[(rt * 2 + bj) * 4 + wc] = s; } }
        const int d0 = wc * 32 + 8 * fq;
        f32x4 w0, w1;
        { const float* wp = (isk ? knw : qnw) + d0; const float sc = isk ? 1.0f : (0.08838834764831845f * 1.4426950408889634f);
          w0 = *(const f32x4*)wp * sc; w1 = *(const f32x4*)(wp + 4) * sc; }
        asm volatile("s_waitcnt lgkmcnt(0)" ::: "memory"); __builtin_amdgcn_s_barrier(); asm volatile("" ::: "memory");
        f32x4 ks[2][2];
#pragma unroll
        for (int bj = 0; bj < 2; ++bj) { ks[bj][0] = (f32x4){0.f, 0.f, 0.f, 0.f}; ks[bj][1] = (f32x4){0.f, 0.f, 0.f, 0.f}; }
        const int row0 = u.pm * BM, col0 = pnl * 256 + d0;
#pragma unroll
        for (int ai = 0; ai < 2; ++ai)
#pragma unroll
            for (int m = 0; m < 4; ++m) { const int rt = ai * HALF + wr * 64 + m * 16 + fr;
#pragma unroll
                for (int bj = 0; bj < 2; ++bj) { const f32x4 pp = *(const PG8_LAS f32x4*)(part + (rt * 2 + bj) * 4);
                    const float r = __builtin_amdgcn_rsqf(((pp[0] + pp[1]) + (pp[2] + pp[3])) * (1.0f / 128.f) + EPS);
                    const f32x4 v0 = acc[ai][bj][m][0] * r * w0, v1 = acc[ai][bj][m][1] * r * w1;
                    ks[bj][0] += v0; ks[bj][1] += v1;
                    u32x4 w; w.x = cvt_pk_bf16(v0[0], v0[1]); w.y = cvt_pk_bf16(v0[2], v0[3]); w.z = cvt_pk_bf16(v1[0], v1[1]); w.w = cvt_pk_bf16(v1[2], v1[3]);
                    __builtin_nontemporal_store(w, (u32x4*)(base + (size_t)(row0 + rt) * DA + col0 + bj * HALF)); } }
        if (isk) {
#pragma unroll
            for (int bj = 0; bj < 2; ++bj)
#pragma unroll
                for (int n = 0; n < 2; ++n)
#pragma unroll
                    for (int e = 0; e < 4; ++e) { float s = ks[bj][n][e]; s += __shfl_xor(s, 1); s += __shfl_xor(s, 2); s += __shfl_xor(s, 4); s += __shfl_xor(s, 8);
                        if (fr == 0) red[(wr * 2 + bj) * 128 + d0 + 4 * n + e] = s; }
            asm volatile("s_waitcnt lgkmcnt(0)" ::: "memory"); __builtin_amdgcn_s_barrier(); asm volatile("" ::: "memory");
            if (wr == 0 && fr == 0) {
#pragma unroll
                for (int bj = 0; bj < 2; ++bj) { const int h = 2 * pnl + bj;
#pragma unroll
                    for (int i = 0; i < 8; ++i) { const float s = (red[bj * 128 + d0 + i] + red[(2 + bj) * 128 + d0 + i]) * (1.0f / 256.f);
                        kbar[((size_t)h * 32 + u.pm) * 128 + d0 + i] = s; kbarb[((size_t)h * 32 + u.pm) * 128 + d0 + i] = (bf16_t)(cvt_pk_bf16(s, 0.f) & 0xffffu); } } }
        }
    }
    __device__ __forceinline__ void operator()(const f32x4 (&acc)[2][2][4][2], const Unit& u, int wr, int wc, int fr, int fq) const {
        if (flag == 10) { if (acc[0][0][0][0][0] == 123.456f) z[0] = 1; return; }
        if (u.pn >= 40 && u.pn < 56) { qk_tile(acc, u, wr, wc, fr, fq, u.pn >= 48); return; }
        const int pn = u.pn; bf16_t* base; int ldc, colt; bool isg = false;
        if (pn < 16) { base = z; ldc = DI; colt = pn * 256; }
        else if (pn < 40) { base = xbc; ldc = DXBC; colt = (pn - 16) * 256; }
        else if (pn < 48) { base = q; ldc = DA; colt = (pn - 40) * 256; }
        else if (pn < 56) { base = k; ldc = DA; colt = (pn - 48) * 256; }
        else if (pn < 64) { base = v; ldc = DA; colt = (pn - 56) * 256; }
        else { base = gt; ldc = DI; colt = (pn - 64) * 256; isg = true; }
        const int row0 = u.pm * BM + wr * 64 + fr, col0 = colt + wc * 32 + 8 * fq;
        f32x4 bv[2][2];
#pragma unroll
        for (int bj = 0; bj < 2; ++bj)
#pragma unroll
            for (int n = 0; n < 2; ++n) bv[bj][n] = isg ? *(const f32x4*)(bg + col0 + bj * HALF + 4 * n) : (f32x4){0.f, 0.f, 0.f, 0.f};
#pragma unroll
        for (int ai = 0; ai < 2; ++ai)
#pragma unroll
            for (int m = 0; m < 4; ++m) { const int row = row0 + ai * HALF + m * 16; bf16_t* rowp = base + (size_t)row * ldc + col0;
#pragma unroll
                for (int bj = 0; bj < 2; ++bj) { f32x4 v0 = acc[ai][bj][m][0] + bv[bj][0], v1 = acc[ai][bj][m][1] + bv[bj][1];
                    if (isg) {
#pragma unroll
                        for (int e = 0; e < 4; ++e) { v0[e] = __builtin_amdgcn_rcpf(1.f + __expf(-v0[e])); v1[e] = __builtin_amdgcn_rcpf(1.f + __expf(-v1[e])); } }
                    u32x4 w; w.x = cvt_pk_bf16(v0[0], v0[1]); w.y = cvt_pk_bf16(v0[2], v0[3]); w.z = cvt_pk_bf16(v1[0], v1[1]); w.w = cvt_pk_bf16(v1[2], v1[3]);
                    __builtin_nontemporal_store(w, (u32x4*)(rowp + bj * HALF)); } }
    }
};
struct EpiGateF32 {
    static constexpr bool PERM = true, AFTER_DRAIN = false;
    bf16_t* T; const bf16_t* gt; int goff;
    __device__ __forceinline__ void operator()(const f32x4 (&acc)[2][2][4][2], const Unit& u, int wr, int wc, int fr, int fq) const {
        const int row0 = u.pm * BM + wr * 64 + fr, col0 = u.pn * BM + wc * 32 + 8 * fq;
        u32x4 g[2][2];
#define LDG(i, s) do { const int row_ = row0 + ((i) >> 2) * HALF + ((i) & 3) * 16; g[s][0] = *(const u32x4*)(gt + (size_t)row_ * DI + goff + col0); g[s][1] = *(const u32x4*)(gt + (size_t)row_ * DI + goff + col0 + HALF); } while (0)
        LDG(0, 0);
#pragma unroll
        for (int i = 0; i < 8; ++i) { const int ai = i >> 2, m = i & 3, s = i & 1; const int row = row0 + ai * HALF + m * 16;
            if (i + 1 < 8) LDG(i + 1, s ^ 1);
#pragma unroll
            for (int bj = 0; bj < 2; ++bj) { const f32x4 v0 = acc[ai][bj][m][0] * PG8_BF2F4(g[s][bj], true), v1 = acc[ai][bj][m][1] * PG8_BF2F4(g[s][bj], false);
                u32x4 w; w.x = cvt_pk_bf16(v0[0], v0[1]); w.y = cvt_pk_bf16(v0[2], v0[3]); w.z = cvt_pk_bf16(v1[0], v1[1]); w.w = cvt_pk_bf16(v1[2], v1[3]);
                *(u32x4*)(T + (size_t)row * DM + col0 + bj * HALF) = w; } }
#undef LDG
    }
};
struct EpiGateMix {
    static constexpr bool PERM = true, AFTER_DRAIN = false;
    bf16_t* O; const bf16_t* gt;
    __device__ __forceinline__ void mid(f32x4 (&acc)[2][2][4][2], const Unit& u, int wr, int wc, int fr, int fq) const {
        int row0 = u.pm * BM + wr * 64 + fr, col0 = u.pn * BM + wc * 32 + 8 * fq;
        asm volatile("" : "+v"(row0), "+v"(col0));
        u32x4 gs[2][2], ga[2][2];
#define LDG(i, s) do { const int row_ = row0 + ((i) >> 2) * HALF + ((i) & 3) * 16; \
            _Pragma("unroll") for (int bj_ = 0; bj_ < 2; ++bj_) { gs[s][bj_] = *(const u32x4*)(gt + (size_t)row_ * DI + col0 + bj_ * HALF); ga[s][bj_] = *(const u32x4*)(gt + (size_t)row_ * DI + DM + col0 + bj_ * HALF); } } while (0)
        LDG(0, 0);
#pragma unroll
        for (int i = 0; i < 8; ++i) { const int ai = i >> 2, m = i & 3, s = i & 1;
            if (i + 1 < 8) LDG(i + 1, s ^ 1);
            __builtin_amdgcn_sched_barrier(0);
#pragma unroll
            for (int bj = 0; bj < 2; ++bj)
#pragma unroll
                for (int n = 0; n < 2; ++n) { const f32x4 a = PG8_BF2F4(ga[s][bj], n == 0), b = PG8_BF2F4(gs[s][bj], n == 0);
#pragma unroll
                    for (int e = 0; e < 4; ++e) acc[ai][bj][m][n][e] *= a[e] * __builtin_amdgcn_rcpf(fmaxf(b[e], 1e-30f)); }
            __builtin_amdgcn_sched_barrier(0); }
#undef LDG
    }
    __device__ __forceinline__ void operator()(const f32x4 (&acc)[2][2][4][2], const Unit& u, int wr, int wc, int fr, int fq) const {
        const int row0 = u.pm * BM + wr * 64 + fr, col0 = u.pn * BM + wc * 32 + 8 * fq;
        u32x4 g[2][2];
#define LDG(i, s) do { const int row_ = row0 + ((i) >> 2) * HALF + ((i) & 3) * 16; g[s][0] = *(const u32x4*)(gt + (size_t)row_ * DI + col0); g[s][1] = *(const u32x4*)(gt + (size_t)row_ * DI + col0 + HALF); } while (0)
        LDG(0, 0);
#pragma unroll
        for (int i = 0; i < 8; ++i) { const int ai = i >> 2, m = i & 3, s = i & 1; const int row = row0 + ai * HALF + m * 16;
            if (i + 1 < 8) LDG(i + 1, s ^ 1);
#pragma unroll
            for (int bj = 0; bj < 2; ++bj) { const f32x4 v0 = acc[ai][bj][m][0] * PG8_BF2F4(g[s][bj], true), v1 = acc[ai][bj][m][1] * PG8_BF2F4(g[s][bj], false);
                u32x4 w; w.x = cvt_pk_bf16(v0[0], v0[1]); w.y = cvt_pk_bf16(v0[2], v0[3]); w.z = cvt_pk_bf16(v1[0], v1[1]); w.w = cvt_pk_bf16(v1[2], v1[3]);
                *(u32x4*)(O + (size_t)row * DM + col0 + bj * HALF) = w; } }
#undef LDG
    }
};
struct EpiGateAddBf16 {
    static constexpr bool PERM = true, AFTER_DRAIN = false;
    const bf16_t* T; const bf16_t* gt; int goff; bf16_t* O;
    __device__ __forceinline__ void operator()(const f32x4 (&acc)[2][2][4][2], const Unit& u, int wr, int wc, int fr, int fq) const {
        const int row0 = u.pm * BM + wr * 64 + fr, col0 = u.pn * BM + wc * 32 + 8 * fq;
        u32x4 g[2][2]; u32x4 t[2][2];
#define LDG(i, s) do { const int row_ = row0 + ((i) >> 2) * HALF + ((i) & 3) * 16; \
            _Pragma("unroll") for (int bj_ = 0; bj_ < 2; ++bj_) { g[s][bj_] = *(const u32x4*)(gt + (size_t)row_ * DI + goff + col0 + bj_ * HALF); t[s][bj_] = *(const u32x4*)(T + (size_t)row_ * DM + col0 + bj_ * HALF); } } while (0)
        LDG(0, 0);
#pragma unroll
        for (int i = 0; i < 8; ++i) { const int ai = i >> 2, m = i & 3, s = i & 1; const int row = row0 + ai * HALF + m * 16;
            if (i + 1 < 8) LDG(i + 1, s ^ 1);
#pragma unroll
            for (int bj = 0; bj < 2; ++bj) { const f32x4 v0 = PG8_BF2F4(t[s][bj], true) + acc[ai][bj][m][0] * PG8_BF2F4(g[s][bj], true), v1 = PG8_BF2F4(t[s][bj], false) + acc[ai][bj][m][1] * PG8_BF2F4(g[s][bj], false);
                u32x4 w; w.x = cvt_pk_bf16(v0[0], v0[1]); w.y = cvt_pk_bf16(v0[2], v0[3]); w.z = cvt_pk_bf16(v1[0], v1[1]); w.w = cvt_pk_bf16(v1[2], v1[3]);
                *(u32x4*)(O + (size_t)row * DM + col0 + bj * HALF) = w; } }
#undef LDG
    }
};
struct EpiResid1 {
    static constexpr bool PERM = true, AFTER_DRAIN = false;
    const float* X; float* out; bf16_t* xb1; float* ss2; int probe;
    __device__ __forceinline__ void operator()(const f32x4 (&acc)[2][2][4][2], const Unit& u, int wr, int wc, int fr, int fq) const {
        const int row0 = u.pm * BM + wr * 64 + fr, col0 = u.pn * BM + wc * 32 + 8 * fq;
        f32x4 t[2][2][2];
#define LDG(i, s) do { const int row_ = row0 + ((i) >> 2) * HALF + ((i) & 3) * 16; \
            _Pragma("unroll") for (int bj_ = 0; bj_ < 2; ++bj_) { const float* tp_ = X + (size_t)row_ * DM + col0 + bj_ * HALF; t[s][bj_][0] = *(const f32x4*)tp_; t[s][bj_][1] = *(const f32x4*)(tp_ + 4); } } while (0)
        LDG(0, 0);
#pragma unroll
        for (int i = 0; i < 8; ++i) { const int ai = i >> 2, m = i & 3, s = i & 1; const int row = row0 + ai * HALF + m * 16; float sq = 0.f;
            if (i + 1 < 8) LDG(i + 1, s ^ 1);
#pragma unroll
            for (int bj = 0; bj < 2; ++bj) { const size_t off = (size_t)row * DM + col0 + bj * HALF;
                const f32x4 v0 = t[s][bj][0] + acc[ai][bj][m][0], v1 = t[s][bj][1] + acc[ai][bj][m][1];
                sq += (v0[0] * v0[0] + v0[1] * v0[1]) + (v0[2] * v0[2] + v0[3] * v0[3]) + (v1[0] * v1[0] + v1[1] * v1[1]) + (v1[2] * v1[2] + v1[3] * v1[3]);
                u32x4 w; w.x = cvt_pk_bf16(v0[0], v0[1]); w.y = cvt_pk_bf16(v0[2], v0[3]); w.z = cvt_pk_bf16(v1[0], v1[1]); w.w = cvt_pk_bf16(v1[2], v1[3]);
                *(u32x4*)(xb1 + off) = w; }
            sq += __shfl_xor(sq, 16); sq += __shfl_xor(sq, 32);
            if (fq == 0 && !probe) atomicAdd(ss2 + row, sq); }
#undef LDG
    }
};
struct EpiUpPre {
    static constexpr bool PERM = true, AFTER_DRAIN = false;
    bf16_t* O; const float* ss2; int ldo, coloff;
    __device__ __forceinline__ void operator()(const f32x4 (&acc)[2][2][4][2], const Unit& u, int wr, int wc, int fr, int fq) const {
        const int row0 = u.pm * BM + wr * 64 + fr, col0 = u.pn * BM - coloff + wc * 32 + 8 * fq;
        float rs[2][4];
#pragma unroll
        for (int ai = 0; ai < 2; ++ai)
#pragma unroll
            for (int m = 0; m < 4; ++m) rs[ai][m] = ss2[row0 + ai * HALF + m * 16];
#pragma unroll
        for (int ai = 0; ai < 2; ++ai)
#pragma unroll
            for (int m = 0; m < 4; ++m) { const int row = row0 + ai * HALF + m * 16; const float r = 1.0f / sqrtf(rs[ai][m] * (1.0f / DM) + EPS);
#pragma unroll
                for (int bj = 0; bj < 2; ++bj) { const f32x4 v0 = acc[ai][bj][m][0] * r, v1 = acc[ai][bj][m][1] * r;
                    u32x4 w; w.x = cvt_pk_bf16(v0[0], v0[1]); w.y = cvt_pk_bf16(v0[2], v0[3]); w.z = cvt_pk_bf16(v1[0], v1[1]); w.w = cvt_pk_bf16(v1[2], v1[3]);
                    *(u32x4*)(O + (size_t)row * ldo + col0 + bj * HALF) = w; } }
    }
};
__device__ __forceinline__ f32x4 dpp_shr1(const f32x4 v) { f32x4 r;
#pragma unroll
    for (int e = 0; e < 4; ++e) { float x = v[e], y;
        asm volatile("s_nop 1\n\tv_mov_b32_dpp %0, %1 row_shr:1 row_mask:0xf bank_mask:0xf bound_ctrl:1" : "=v"(y) : "v"(x)); r[e] = y; }
    return r; }
__device__ __forceinline__ f32x4 silu4(const f32x4 v) { return (f32x4){siluf(v[0]), siluf(v[1]), siluf(v[2]), siluf(v[3])}; }
struct EpiFfnAct {
    static constexpr bool PERM = true, AFTER_DRAIN = false, PERMA = true;
    bf16_t* ACT; bf16_t* HALO; const float* ss2; const float* cw; const float* cb;
    __device__ __forceinline__ void operator()(const f32x4 (&acc)[2][2][4][2], const Unit& u, int wr, int wc, int fr, int fq) const {
        const int ch0 = u.pn * 128 + wc * 32 + 8 * fq;
        const int rb0 = u.pm * BM + wr * 64;
        f32x4 wg[2][3], wu[2][3], bg[2], bu[2], ssv[2];
#pragma unroll
        for (int ai = 0; ai < 2; ++ai) ssv[ai] = *(const f32x4*)(ss2 + rb0 + ai * HALF + 4 * fr);
#define FFN_LDW(n) do { int c_ = ch0 + 4 * (n); asm volatile("" : "+v"(c_)); \
            _Pragma("unroll") for (int k = 0; k < 3; ++k) { wg[n][k] = *(const f32x4*)(cw + k * DFF2 + c_); wu[n][k] = *(const f32x4*)(cw + k * DFF2 + DFF + c_); } \
            bg[n] = *(const f32x4*)(cb + c_); bu[n] = *(const f32x4*)(cb + DFF + c_); } while (0)
        FFN_LDW(0);
        f32x4 r[2];
#pragma unroll
        for (int ai = 0; ai < 2; ++ai)
#pragma unroll
            for (int m = 0; m < 4; ++m) r[ai][m] = __builtin_amdgcn_rsqf(ssv[ai][m] * (1.0f / DM) + EPS);
#pragma unroll
        for (int n = 0; n < 2; ++n) { const int c = ch0 + 4 * n;
#pragma unroll
            for (int ai = 0; ai < 2; ++ai) {
                const int rb = rb0 + ai * HALF, blk = rb >> 6, row0 = rb + 4 * fr;
                if (n == 0 && ai == 1) FFN_LDW(1);
                f32x4 G[4], U[4];
#pragma unroll
                for (int m = 0; m < 4; ++m) { G[m] = acc[ai][0][m][n] * r[ai][m]; U[m] = acc[ai][1][m][n] * r[ai][m]; }
                const f32x4 g2 = dpp_shr1(G[2]), g3 = dpp_shr1(G[3]), u2 = dpp_shr1(U[2]), u3 = dpp_shr1(U[3]);
                f32x4 cg[4], cu[4];
                cg[0] = bg[n] + wg[n][0] * g2 + wg[n][1] * g3 + wg[n][2] * G[0];     cu[0] = bu[n] + wu[n][0] * u2 + wu[n][1] * u3 + wu[n][2] * U[0];
                cg[1] = bg[n] + wg[n][0] * g3 + wg[n][1] * G[0] + wg[n][2] * G[1];   cu[1] = bu[n] + wu[n][0] * u3 + wu[n][1] * U[0] + wu[n][2] * U[1];
                cg[2] = bg[n] + wg[n][0] * G[0] + wg[n][1] * G[1] + wg[n][2] * G[2]; cu[2] = bu[n] + wu[n][0] * U[0] + wu[n][1] * U[1] + wu[n][2] * U[2];
                cg[3] = bg[n] + wg[n][0] * G[1] + wg[n][1] * G[2] + wg[n][2] * G[3]; cu[3] = bu[n] + wu[n][0] * U[1] + wu[n][1] * U[2] + wu[n][2] * U[3];
#pragma unroll
                for (int m = 0; m < 4; ++m) { const f32x4 o = silu4(cg[m]) * cu[m]; u32x2 w; w.x = cvt_pk_bf16(o[0], o[1]); w.y = cvt_pk_bf16(o[2], o[3]);
                    if (!(fr == 0 && m < 2)) *(u32x2*)(ACT + (size_t)(row0 + m) * DFF + c) = w; }
                if (fr == 0 || fr == 15) {
                    const int m0 = fr == 0 ? 0 : 2;
#pragma unroll
                    for (int j = 0; j < 2; ++j) { const f32x4 gv = fr == 0 ? G[j] : G[2 + j], uv = fr == 0 ? U[j] : U[2 + j];
                        bf16_t* hp = HALO + ((size_t)(blk * 4 + m0 + j) * 2) * DFF + c;
                        u32x2 a; a.x = cvt_pk_bf16(gv[0], gv[1]); a.y = cvt_pk_bf16(gv[2], gv[3]); *(u32x2*)hp = a;
                        u32x2 b; b.x = cvt_pk_bf16(uv[0], uv[1]); b.y = cvt_pk_bf16(uv[2], uv[3]); *(u32x2*)(hp + DFF) = b; } }
            }
        }
#undef FFN_LDW
    }
};
struct EpiResid2 {
    static constexpr bool PERM = true, AFTER_DRAIN = false;
    const bf16_t* xb1; float* dst;
    __device__ __forceinline__ void operator()(const f32x4 (&acc)[2][2][4][2], const Unit& u, int wr, int wc, int fr, int fq) const {
        const int row0 = u.pm * BM + wr * 64 + fr, col0 = u.pn * BM + wc * 32 + 8 * fq;
        u32x4 t[2][2];
#define LDG(i, s) do { const int row_ = row0 + ((i) >> 2) * HALF + ((i) & 3) * 16; \
            _Pragma("unroll") for (int bj_ = 0; bj_ < 2; ++bj_) t[s][bj_] = *(const u32x4*)(xb1 + (size_t)row_ * DM + col0 + bj_ * HALF); } while (0)
        LDG(0, 0);
#pragma unroll
        for (int i = 0; i < 8; ++i) { const int ai = i >> 2, m = i & 3, s = i & 1; const int row = row0 + ai * HALF + m * 16;
            if (i + 1 < 8) LDG(i + 1, s ^ 1);
#pragma unroll
            for (int bj = 0; bj < 2; ++bj) { float* p = dst + (size_t)row * DM + col0 + bj * HALF;
                __builtin_nontemporal_store(PG8_BF2F4(t[s][bj], true) + acc[ai][bj][m][0], (f32x4*)p); __builtin_nontemporal_store(PG8_BF2F4(t[s][bj], false) + acc[ai][bj][m][1], (f32x4*)(p + 4)); } }
#undef LDG
    }
};
#undef PG8_BF2F4
struct OneUnit { Unit u;
    __device__ __forceinline__ bool next(int i, Unit& o) const { if (i) return false; o = u; return true; }
    __device__ __forceinline__ void a_ready(const Unit&) const {}
    __device__ __forceinline__ void done(const Unit&) const {} };
}

__device__ __forceinline__ float softplusf(float v) { return v > 20.f ? v : log1pf(__expf(v)); }
__device__ __forceinline__ void dt_phase(Frame& F, const Args& A) {
    unsigned char* ws = A.ws;
    const bf16* xb = (const bf16*)(ws + WS_XB); const bf16* wt = (const bf16*)(ws + WS_WIN) + (size_t)NIN * DM;
    const float* r1 = (const float*)(ws + WS_R1); float* dt = (float*)(ws + WS_DT);
    LAS float* part = (LAS float*)(F.lds + RING_OFF);
    const int r32 = F.lane & 31, hi = F.lane >> 5;
    for (int rb = F.vcu; rb < SEQ / 32; rb += F.G) {
        const bf16* xa = xb + (size_t)(rb * 32 + r32) * DM + F.wave * 256 + hi * 8;
        const bf16* w0 = wt + (size_t)r32 * DM + F.wave * 256 + hi * 8; const bf16* w1 = w0 + (size_t)32 * DM;
        f32x16 acc0 = {}, acc1 = {};
#pragma unroll
        for (int ks = 0; ks < 16; ++ks) {
            const bf16x8 af = *reinterpret_cast<const bf16x8*>(xa + ks * 16), b0 = *reinterpret_cast<const bf16x8*>(w0 + ks * 16), b1 = *reinterpret_cast<const bf16x8*>(w1 + ks * 16);
            acc0 = __builtin_amdgcn_mfma_f32_32x32x16_bf16(af, b0, acc0, 0, 0, 0);
            acc1 = __builtin_amdgcn_mfma_f32_32x32x16_bf16(af, b1, acc1, 0, 0, 0); }
#pragma unroll
        for (int q = 0; q < 16; ++q) { const int row = (q & 3) + 8 * (q >> 2) + 4 * hi; part[(F.wave * 32 + row) * 64 + r32] = acc0[q]; part[(F.wave * 32 + row) * 64 + 32 + r32] = acc1[q]; }
        __syncthreads();
        for (int o = F.tid; o < 32 * 64; o += NTHR) { float s = 0.f;
#pragma unroll
            for (int w = 0; w < 8; ++w) s += part[w * 2048 + o];
            const int row = rb * 32 + (o >> 6), h = o & 63;
            dt[(size_t)row * NHS + h] = softplusf(s + A.in[I_DTB][h]); }
        __syncthreads();
    }
}

__device__ __forceinline__ void attn_prep_phase(Frame& F, const Args& A) {
    unsigned char* ws = A.ws;
    bf16* Q = (bf16*)(ws + WS_Q); bf16* K = (bf16*)(ws + WS_K); float* kbar = (float*)(ws + WS_KBAR); bf16* kbarb = (bf16*)(ws + WS_KBARB);
    LAS float* red = (LAS float*)(F.lds + RING_OFF);
    const int sub = F.tid >> 4, l16 = F.tid & 15;
    float qw[8], kw[8];
#pragma unroll
    for (int e = 0; e < 8; ++e) { qw[e] = A.in[I_QNW][l16 * 8 + e] * (0.08838834764831845f * 1.4426950408889634f); kw[e] = A.in[I_KNW][l16 * 8 + e]; }
    for (int u = F.vcu; u < NBLK * AH; u += F.G) {
        const int nb = u / AH, h = u % AH;
        float ksum[8];
#pragma unroll
        for (int e = 0; e < 8; ++e) ksum[e] = 0.f;
        for (int i = 0; i < 8; ++i) {
            const int t = nb * BLK + i * 32 + sub; const size_t off = (size_t)t * DA + h * AD + l16 * 8;
            { const v4u w = *(const GAS v4u*)(Q + off); float v[8] = {bflo(w.x), bfhi(w.x), bflo(w.y), bfhi(w.y), bflo(w.z), bfhi(w.z), bflo(w.w), bfhi(w.w)};
              float s = 0.f;
#pragma unroll
              for (int e = 0; e < 8; ++e) s += v[e] * v[e];
              s += __shfl_xor(s, 1); s += __shfl_xor(s, 2); s += __shfl_xor(s, 4); s += __shfl_xor(s, 8);
              const float r = __builtin_amdgcn_rsqf(s * (1.0f / AD) + EPS);
              v4u o; o.x = pk2(v[0] * r * qw[0], v[1] * r * qw[1]); o.y = pk2(v[2] * r * qw[2], v[3] * r * qw[3]); o.z = pk2(v[4] * r * qw[4], v[5] * r * qw[5]); o.w = pk2(v[6] * r * qw[6], v[7] * r * qw[7]);
              *(GAS v4u*)(Q + off) = o; }
            { const v4u w = *(const GAS v4u*)(K + off); float v[8] = {bflo(w.x), bfhi(w.x), bflo(w.y), bfhi(w.y), bflo(w.z), bfhi(w.z), bflo(w.w), bfhi(w.w)};
              float s = 0.f;
#pragma unroll
              for (int e = 0; e < 8; ++e) s += v[e] * v[e];
              s += __shfl_xor(s, 1); s += __shfl_xor(s, 2); s += __shfl_xor(s, 4); s += __shfl_xor(s, 8);
              const float r = __builtin_amdgcn_rsqf(s * (1.0f / AD) + EPS);
#pragma unroll
              for (int e = 0; e < 8; ++e) { v[e] = v[e] * r * kw[e]; ksum[e] += v[e]; }
              v4u o; o.x = pk2(v[0], v[1]); o.y = pk2(v[2], v[3]); o.z = pk2(v[4], v[5]); o.w = pk2(v[6], v[7]);
              *(GAS v4u*)(K + off) = o; }
        }
#pragma unroll
        for (int e = 0; e < 8; ++e) red[sub * 128 + l16 * 8 + e] = ksum[e];
        __syncthreads();
        if (F.tid < 128) { float s = 0.f;
#pragma unroll 8
            for (int r = 0; r < 32; ++r) s += red[r * 128 + F.tid];
            kbar[((size_t)h * NBLK + nb) * AD + F.tid] = s * (1.0f / BLK); kbarb[((size_t)h * NBLK + nb) * AD + F.tid] = (bf16)f2bf(s * (1.0f / BLK)); }
        __syncthreads();
    }
}

__device__ __forceinline__ void unpack8(const v4u w, float* v) { v[0] = bflo(w.x); v[1] = bfhi(w.x); v[2] = bflo(w.y); v[3] = bfhi(w.y); v[4] = bflo(w.z); v[5] = bfhi(w.z); v[6] = bflo(w.w); v[7] = bfhi(w.w); }
template <bool SP>
__device__ __forceinline__ void ffn_act_item(const Args& A, int it) {
    unsigned char* ws = A.ws;
    const bf16* __restrict__ U = (const bf16*)(ws + WS_UPRE); bf16* __restrict__ ACT = (bf16*)(ws + WS_ACT);
    const float* __restrict__ cw = A.in[I_FCW]; const float* __restrict__ cb = A.in[I_FCB];
    constexpr int CG = DFF / 8, TSEG = 16;
    {
        const int c0 = (it % CG) * 8, t0 = (it / CG) * TSEG;
        float wg[3][8], wu[3][8], bg[8], bu[8];
#pragma unroll
        for (int k = 0; k < 3; ++k) { const f32x4 a0 = *(const GAS f32x4*)(cw + k * DFF2 + c0), a1 = *(const GAS f32x4*)(cw + k * DFF2 + c0 + 4), b0 = *(const GAS f32x4*)(cw + k * DFF2 + DFF + c0), b1 = *(const GAS f32x4*)(cw + k * DFF2 + DFF + c0 + 4);
#pragma unroll
            for (int e = 0; e < 4; ++e) { wg[k][e] = a0[e]; wg[k][4 + e] = a1[e]; wu[k][e] = b0[e]; wu[k][4 + e] = b1[e]; } }
        { const f32x4 a0 = *(const GAS f32x4*)(cb + c0), a1 = *(const GAS f32x4*)(cb + c0 + 4), b0 = *(const GAS f32x4*)(cb + DFF + c0), b1 = *(const GAS f32x4*)(cb + DFF + c0 + 4);
#pragma unroll
          for (int e = 0; e < 4; ++e) { bg[e] = a0[e]; bg[4 + e] = a1[e]; bu[e] = b0[e]; bu[4 + e] = b1[e]; } }
        constexpr bool sp = SP; const bf16* __restrict__ U2 = (const bf16*)(ws + WS_UP2) + (c0 - 4608);
        float g1[8], g2[8], u1[8], u2[8];
        { const int tm1 = t0 >= 1 ? t0 - 1 : 0, tm2 = t0 >= 2 ? t0 - 2 : 0; const float ok = t0 >= 2 ? 1.f : 0.f;
          unpack8(*(const GAS v4u*)(U + (size_t)tm1 * DFF2 + c0), g1); unpack8(*(const GAS v4u*)(U + (size_t)tm1 * DFF2 + DFF + c0), u1);
          unpack8(*(const GAS v4u*)(U + (size_t)tm2 * DFF2 + c0), g2); unpack8(*(const GAS v4u*)(U + (size_t)tm2 * DFF2 + DFF + c0), u2);
          if (sp) { float a1[8], a2[8]; unpack8(*(const GAS v4u*)(U2 + (size_t)tm1 * 1024), a1); unpack8(*(const GAS v4u*)(U2 + (size_t)tm2 * 1024), a2);
#pragma unroll
            for (int e = 0; e < 8; ++e) { u1[e] += a1[e]; u2[e] += a2[e]; } }
#pragma unroll
          for (int e = 0; e < 8; ++e) { g1[e] *= ok; g2[e] *= ok; u1[e] *= ok; u2[e] *= ok; } }
        for (int tb = 0; tb < TSEG; tb += 4) {
            v4u rg[4], ru[4], rv[4];
#pragma unroll
            for (int j = 0; j < 4; ++j) { rg[j] = *(const GAS v4u*)(U + (size_t)(t0 + tb + j) * DFF2 + c0); ru[j] = *(const GAS v4u*)(U + (size_t)(t0 + tb + j) * DFF2 + DFF + c0); }
            if (sp) {
#pragma unroll
                for (int j = 0; j < 4; ++j) rv[j] = *(const GAS v4u*)(U2 + (size_t)(t0 + tb + j) * 1024); }
#pragma unroll
            for (int j = 0; j < 4; ++j) { float g0[8], u0[8], o[8]; unpack8(rg[j], g0); unpack8(ru[j], u0);
                if (sp) { float a0[8]; unpack8(rv[j], a0);
#pragma unroll
                    for (int e = 0; e < 8; ++e) u0[e] += a0[e]; }
#pragma unroll
                for (int e = 0; e < 8; ++e) { const float gg = bg[e] + wg[0][e] * g2[e] + wg[1][e] * g1[e] + wg[2][e] * g0[e]; const float uu = bu[e] + wu[0][e] * u2[e] + wu[1][e] * u1[e] + wu[2][e] * u0[e];
                    o[e] = siluf(gg) * uu; g2[e] = g1[e]; g1[e] = g0[e]; u2[e] = u1[e]; u1[e] = u0[e]; }
                v4u w; w.x = pk2(o[0], o[1]); w.y = pk2(o[2], o[3]); w.z = pk2(o[4], o[5]); w.w = pk2(o[6], o[7]);
                *(GAS v4u*)(ACT + (size_t)(t0 + tb + j) * DFF + c0) = w; }
        }
    }
}
__device__ __forceinline__ void ffn_act_phase(Frame& F, const Args& A) {
    constexpr int CG = DFF / 8, NIT = CG * (SEQ / 16);
    for (int it = F.vcu * NTHR + F.tid; it < NIT; it += F.G * NTHR) {
        const bool sp = __builtin_amdgcn_readfirstlane((it % CG) * 8) >= 4608;
        if (sp) ffn_act_item<true>(A, it); else ffn_act_item<false>(A, it);
    }
}

__device__ __forceinline__ void ffn_tail_item(const Args& A, int it) {
    unsigned char* ws = A.ws;
    const bf16* __restrict__ U = (const bf16*)(ws + WS_UPRE); const bf16* __restrict__ U2 = (const bf16*)(ws + WS_UP2); bf16* __restrict__ ACT = (bf16*)(ws + WS_ACT);
    const float* __restrict__ cw = A.in[I_FCW]; const float* __restrict__ cb = A.in[I_FCB];
    const int cg = it & 63, c0 = 5120 + 8 * cg, t0 = (it >> 6) * 4;
    const int colg = 256 * (c0 >> 7) + (c0 & 127), col2 = colg - 10240;
    v4u rg[6], rg2[6], ru[6], ru2[6];
#pragma unroll
    for (int j = 0; j < 6; ++j) { const int t = t0 - 2 + j, tc = t < 0 ? 0 : t;
        rg[j] = *(const GAS v4u*)(U + (size_t)tc * DFF2 + colg); rg2[j] = *(const GAS v4u*)(U2 + (size_t)tc * 1024 + col2);
        ru[j] = *(const GAS v4u*)(U + (size_t)tc * DFF2 + colg + 128); ru2[j] = *(const GAS v4u*)(U2 + (size_t)tc * 1024 + col2 + 128); }
    float wg[3][8], wu[3][8], bg[8], bu[8];
#pragma unroll
    for (int k = 0; k < 3; ++k) { const f32x4 a0 = *(const GAS f32x4*)(cw + k * DFF2 + c0), a1 = *(const GAS f32x4*)(cw + k * DFF2 + c0 + 4), b0 = *(const GAS f32x4*)(cw + k * DFF2 + DFF + c0), b1 = *(const GAS f32x4*)(cw + k * DFF2 + DFF + c0 + 4);
#pragma unroll
        for (int e = 0; e < 4; ++e) { wg[k][e] = a0[e]; wg[k][4 + e] = a1[e]; wu[k][e] = b0[e]; wu[k][4 + e] = b1[e]; } }
    { const f32x4 a0 = *(const GAS f32x4*)(cb + c0), a1 = *(const GAS f32x4*)(cb + c0 + 4), b0 = *(const GAS f32x4*)(cb + DFF + c0), b1 = *(const GAS f32x4*)(cb + DFF + c0 + 4);
#pragma unroll
      for (int e = 0; e < 4; ++e) { bg[e] = a0[e]; bg[4 + e] = a1[e]; bu[e] = b0[e]; bu[4 + e] = b1[e]; } }
    float g[6][8], u[6][8];
#pragma unroll
    for (int j = 0; j < 6; ++j) { float a_[8]; const float ok = (t0 - 2 + j) >= 0 ? 1.f : 0.f;
        unpack8(rg[j], g[j]); unpack8(rg2[j], a_);
#pragma unroll
        for (int e = 0; e < 8; ++e) g[j][e] = (g[j][e] + a_[e]) * ok;
        unpack8(ru[j], u[j]); unpack8(ru2[j], a_);
#pragma unroll
        for (int e = 0; e < 8; ++e) u[j][e] = (u[j][e] + a_[e]) * ok; }
#pragma unroll
    for (int j = 0; j < 4; ++j) { float o[8];
#pragma unroll
        for (int e = 0; e < 8; ++e) { const float gg = bg[e] + wg[0][e] * g[j][e] + wg[1][e] * g[j + 1][e] + wg[2][e] * g[j + 2][e]; const float uu = bu[e] + wu[0][e] * u[j][e] + wu[1][e] * u[j + 1][e] + wu[2][e] * u[j + 2][e];
            o[e] = siluf(gg) * uu; }
        v4u w; w.x = pk2(o[0], o[1]); w.y = pk2(o[2], o[3]); w.z = pk2(o[4], o[5]); w.w = pk2(o[6], o[7]);
        *(GAS v4u*)(ACT + (size_t)(t0 + j) * DFF + c0) = w; }
}
__device__ __forceinline__ void ffn_seam_item(const Args& A, int it) {
    unsigned char* ws = A.ws;
    const bf16* __restrict__ H = (const bf16*)(ws + WS_HALO); bf16* __restrict__ ACT = (bf16*)(ws + WS_ACT);
    const float* __restrict__ cw = A.in[I_FCW]; const float* __restrict__ cb = A.in[I_FCB];
    const int cg = it % 640, c0 = 8 * cg, blk = it / 640;
    float wg[3][8], wu[3][8], bg[8], bu[8];
#pragma unroll
    for (int k = 0; k < 3; ++k) { const f32x4 a0 = *(const GAS f32x4*)(cw + k * DFF2 + c0), a1 = *(const GAS f32x4*)(cw + k * DFF2 + c0 + 4), b0 = *(const GAS f32x4*)(cw + k * DFF2 + DFF + c0), b1 = *(const GAS f32x4*)(cw + k * DFF2 + DFF + c0 + 4);
#pragma unroll
        for (int e = 0; e < 4; ++e) { wg[k][e] = a0[e]; wg[k][4 + e] = a1[e]; wu[k][e] = b0[e]; wu[k][4 + e] = b1[e]; } }
    { const f32x4 a0 = *(const GAS f32x4*)(cb + c0), a1 = *(const GAS f32x4*)(cb + c0 + 4), b0 = *(const GAS f32x4*)(cb + DFF + c0), b1 = *(const GAS f32x4*)(cb + DFF + c0 + 4);
#pragma unroll
      for (int e = 0; e < 4; ++e) { bg[e] = a0[e]; bg[4 + e] = a1[e]; bu[e] = b0[e]; bu[4 + e] = b1[e]; } }
    float g[4][8], u[4][8];
    const int pb = blk > 0 ? blk - 1 : 0; const float ok = blk > 0 ? 1.f : 0.f;
#pragma unroll
    for (int j = 0; j < 2; ++j) {
        unpack8(*(const GAS v4u*)(H + ((size_t)(pb * 4 + 2 + j) * 2) * DFF + c0), g[j]); unpack8(*(const GAS v4u*)(H + ((size_t)(pb * 4 + 2 + j) * 2 + 1) * DFF + c0), u[j]);
        unpack8(*(const GAS v4u*)(H + ((size_t)(blk * 4 + j) * 2) * DFF + c0), g[2 + j]); unpack8(*(const GAS v4u*)(H + ((size_t)(blk * 4 + j) * 2 + 1) * DFF + c0), u[2 + j]);
#pragma unroll
        for (int e = 0; e < 8; ++e) { g[j][e] *= ok; u[j][e] *= ok; } }
#pragma unroll
    for (int j = 0; j < 2; ++j) { float o[8];
#pragma unroll
        for (int e = 0; e < 8; ++e) { const float gg = bg[e] + wg[0][e] * g[j][e] + wg[1][e] * g[j + 1][e] + wg[2][e] * g[j + 2][e]; const float uu = bu[e] + wu[0][e] * u[j][e] + wu[1][e] * u[j + 1][e] + wu[2][e] * u[j + 2][e];
            o[e] = siluf(gg) * uu; }
        v4u w; w.x = pk2(o[0], o[1]); w.y = pk2(o[2], o[3]); w.z = pk2(o[4], o[5]); w.w = pk2(o[6], o[7]);
        *(GAS v4u*)(ACT + (size_t)(blk * 64 + j) * DFF + c0) = w; }
}
__device__ __forceinline__ void ffn_fix_phase(Frame& F, const Args& A) {
    constexpr int NTAIL = 64 * (SEQ / 4), NSEAM = 640 * (SEQ / 64);
    if (F.G == 256) {
        static_assert(NTAIL == 256 * 512 && NSEAM == 256 * 320, "item split");
        ffn_tail_item(A, F.vcu * 512 + F.tid);
        if (F.tid < 320) ffn_seam_item(A, F.vcu * 320 + F.tid);
        return;
    }
    for (int it = F.vcu * NTHR + F.tid; it < NTAIL + NSEAM; it += F.G * NTHR) {
        if (__builtin_amdgcn_readfirstlane(it) < NTAIL) ffn_tail_item(A, it); else ffn_seam_item(A, it - NTAIL);
    }
}

__device__ __forceinline__ int rel_bucket(int n) {
    if (n < 16) return n;
    int v = 16 + (int)(logf((float)n / 16.0f) / 2.0794415416798357f * 16.0f);
    return v < 31 ? v : 31;
}
#if MK_VARIANT != 6
__global__ void __launch_bounds__(256) naive_attn(const bf16* __restrict__ Q, const bf16* __restrict__ K, const bf16* __restrict__ V, const bf16* __restrict__ kbar,
                                                  const float* __restrict__ rel, bf16* __restrict__ O) {
    __shared__ float q_s[4][128];
    __shared__ float p_s[4][1024];
    __shared__ int   blk_s[4][4];
    const int w = threadIdx.x >> 6, lane = threadIdx.x & 63;
    const int pair = blockIdx.x * 4 + w, qi = pair / AH, h = pair % AH;
    const int blk = qi / BLK;
    { const unsigned u = *(const unsigned*)(Q + (size_t)qi * DA + h * AD + lane * 2); q_s[w][lane * 2] = bflo(u); q_s[w][lane * 2 + 1] = bfhi(u); }
    __syncthreads();
    float g = -INFINITY;
    if (lane < blk) { float s = 0.f; const bf16* kb = kbar + ((size_t)h * NBLK + lane) * AD; for (int d = 0; d < AD; ++d) s += q_s[w][d] * bf2f(kb[d]); g = s; }
    const int nsel = blk < 3 ? blk : 3;
    for (int t = 0; t < nsel; ++t) {
        float bv = g; int bi = lane;
#pragma unroll
        for (int o = 1; o < 64; o <<= 1) { const float ov = __shfl_xor(bv, o); const int oi = __shfl_xor(bi, o); if (ov > bv || (ov == bv && oi < bi)) { bv = ov; bi = oi; } }
        if (lane == 0) blk_s[w][t] = bi;
        if (lane == bi) g = -INFINITY;
    }
    if (lane == 0) blk_s[w][nsel] = blk;
    __syncthreads();
    const int nslot = nsel + 1;
    float mx = -INFINITY;
    for (int s = 0; s < nslot; ++s) {
        const int nb = blk_s[w][s]; const bool own = (s == nsel);
        for (int i = 0; i < 4; ++i) { const int j = lane + 64 * i, kpos = nb * BLK + j; const int dist = qi - kpos;
            float sc = -INFINITY;
            if (dist >= 0) { const bf16* kr = K + (size_t)kpos * DA + h * AD; float a = 0.f;
                for (int d = 0; d < AD; d += 2) { const unsigned u = *(const unsigned*)(kr + d); a += q_s[w][d] * bflo(u) + q_s[w][d + 1] * bfhi(u); }
                sc = a + rel[rel_bucket(dist) * AH + h] * 1.4426950408889634f; }
            (void)own;
            p_s[w][s * 256 + j] = sc; mx = fmaxf(mx, sc); }
    }
#pragma unroll
    for (int o = 1; o < 64; o <<= 1) mx = fmaxf(mx, __shfl_xor(mx, o));
    float sum = 0.f;
    for (int s = 0; s < nslot; ++s) for (int i = 0; i < 4; ++i) { const int idx = s * 256 + lane + 64 * i; const float e = exp2f(p_s[w][idx] - mx); p_s[w][idx] = e; sum += e; }
    sum = wave_sum(sum);
    __syncthreads();
    float o0 = 0.f, o1 = 0.f;
    for (int s = 0; s < nslot; ++s) { const int nb = blk_s[w][s];
        for (int j = 0; j < 256; ++j) { const float p = p_s[w][s * 256 + j]; const unsigned u = *(const unsigned*)(V + (size_t)(nb * BLK + j) * DA + h * AD + lane * 2); o0 += p * bflo(u); o1 += p * bfhi(u); } }
    const float inv = 1.f / sum;
    *(unsigned*)(O + (size_t)qi * DA + h * AD + lane * 2) = pk2(o0 * inv, o1 * inv);
}

__global__ void __launch_bounds__(512) naive_ssd(const bf16* __restrict__ XBC, const bf16* __restrict__ Z, const float* __restrict__ DT, const float* __restrict__ cw, const float* __restrict__ cb,
                                                 const float* __restrict__ alog, const float* __restrict__ dskip, const float* __restrict__ nw, bf16* __restrict__ YG) {
    __shared__ float bc_s[256];
    __shared__ float red_s[8];
    const int g = blockIdx.x, tid = threadIdx.x, head = g * 8 + (tid >> 6), ch = g * 512 + tid;
    const float Aneg = -__expf(alog[head]), Dh = dskip[head], nwc = nw[ch];
    float hst[128];
#pragma unroll
    for (int n = 0; n < 128; ++n) hst[n] = 0.f;
    const int bcch = (tid < 128) ? (DI + g * NST + tid) : (DI + NG * NST + g * NST + (tid - 128));
    float wx[4], wb[4]; float bx = cb[ch], bb = 0.f;
#pragma unroll
    for (int k = 0; k < 4; ++k) wx[k] = cw[k * DXBC + ch];
    if (tid < 256) { bb = cb[bcch];
#pragma unroll
        for (int k = 0; k < 4; ++k) wb[k] = cw[k * DXBC + bcch]; }
    for (int t = 0; t < SEQ; ++t) {
        float xa = bx, ba = bb;
#pragma unroll
        for (int k = 0; k < 4; ++k) { const int ts = t - 3 + k; if (ts >= 0) { xa += wx[k] * bf2f(XBC[(size_t)ts * DXBC + ch]); if (tid < 256) ba += wb[k] * bf2f(XBC[(size_t)ts * DXBC + bcch]); } }
        const float xv = siluf(xa);
        __syncthreads();
        if (tid < 256) bc_s[tid] = siluf(ba);
        __syncthreads();
        const float dtv = DT[(size_t)t * NHS + head], dA = __expf(dtv * Aneg), dtx = dtv * xv;
        float y = 0.f;
#pragma unroll
        for (int n = 0; n < 128; ++n) { hst[n] = hst[n] * dA + dtx * bc_s[n]; y += bc_s[128 + n] * hst[n]; }
        y += Dh * xv;
        const float zv = bf2f(Z[(size_t)t * DI + ch]);
        const float gv = y * siluf(zv);
        float sq = wave_sum(gv * gv);
        if ((tid & 63) == 0) red_s[tid >> 6] = sq;
        __syncthreads();
        float tot = 0.f;
#pragma unroll
        for (int i = 0; i < 8; ++i) tot += red_s[i];
        const float r = 1.0f / sqrtf(tot * (1.0f / 512.f) + EPS);
        YG[(size_t)t * DI + ch] = (bf16)f2bf(gv * r * nwc);
    }
}
#endif

namespace att {
constexpr int QBLK = 32, KVBLK = 64, D = 128, LD = DA;
constexpr int SHM_V = KVBLK * D * 2, SHM_K = KVBLK * D * 2;
constexpr int OFF_V = 0, OFF_K = 4 * SHM_V, OFF_WS = 4 * SHM_V + 4 * SHM_K, OFF_LUT = OFF_WS + NWAVES * 64 * 4, OFF_KBAR = OFF_LUT + 1536, OFF_QF = 0  , ATT_LDS = OFF_KBAR + 32 * 256;
static_assert(ATT_LDS <= LDSCTL_OFF, "attention LDS scratch overlaps the control words");
constexpr float LOG2E = 1.4426950408889634f;
constexpr float THR2 = 11.5f;
#define KSWZ(row, colB) ((row) * 256 + ((colB) ^ (((row) & 7) << 4)))
#define SBAR() __builtin_amdgcn_sched_barrier(0)
__device__ __forceinline__ int v_st(int k, int c) { const int kk = (k & ~0xC) | ((k & 4) << 1) | ((k & 8) >> 1); return ((kk >> 3) * 4 + (c >> 5)) * 512 + ((kk & 7) * 32 + (c & 31)) * 2; }
__device__ __forceinline__ int v_rd_base(int lane) { return ((lane & 3) << 3) | (((lane >> 2) & 3) << 6) | (((lane >> 4) & 1) << 5) | (((lane >> 5) & 1) << 8); }
constexpr int v_rd_off(int d0, int ks, int half) { return d0 * 512 + ks * 4096 + half * 2048; }
__device__ __forceinline__ int crow(int r, int hi) { return (r & 3) + 8 * (r >> 2) + 4 * hi; }
__device__ __forceinline__ unsigned cvtpk(float lo, float hi) { unsigned r; asm volatile("v_cvt_pk_bf16_f32 %0, %1, %2" : "=v"(r) : "v"(lo), "v"(hi)); return r; }

__device__ __forceinline__ void bias_tile(f32x16& p0, f32x16& p1, int dq, const float* lut) {
    const int dqc = dq > 250 ? 250 : dq;
    const float* base = lut + (dqc + 64);
#pragma unroll
    for (int r = 0; r < 16; ++r) { const int c = (r & 3) + 8 * (r >> 2);
        p0[r] += base[-c]; p1[r] += base[-c - 32]; }
}
__device__ __forceinline__ void partialSM(f32x16& p0, f32x16& p1, float& m_reg, float& mn, float& alpha) {
    float pmax = p0[0];
#pragma unroll
    for (int r = 1; r < 16; ++r) pmax = fmaxf(pmax, p0[r]);
#pragma unroll
    for (int r = 0; r < 16; ++r) pmax = fmaxf(pmax, p1[r]);
    { auto rr = __builtin_amdgcn_permlane32_swap(__float_as_uint(pmax), __float_as_uint(pmax), false, false);
      pmax = fmaxf(__uint_as_float(rr[0]), __uint_as_float(rr[1])); }
    if (__builtin_expect(__all((pmax - m_reg) <= THR2), 1)) { mn = m_reg; alpha = 1.f; }
    else { mn = fmaxf(m_reg, pmax); alpha = __builtin_amdgcn_exp2f(m_reg - mn); m_reg = mn; }
#pragma unroll
    for (int r = 0; r < 16; ++r) p0[r] = p0[r] - mn;
#pragma unroll
    for (int r = 0; r < 16; ++r) p1[r] = p1[r] - mn;
#pragma unroll
    for (int r = 0; r < 16; ++r) p0[r] = __builtin_amdgcn_exp2f(p0[r]);
}
__device__ __forceinline__ void finishSM(f32x16& p0, f32x16& p1, float alpha, float& l_reg, bf16x8& pa0, bf16x8& pa1, bf16x8& pa2, bf16x8& pa3) {
#pragma unroll
    for (int r = 0; r < 16; ++r) p1[r] = __builtin_amdgcn_exp2f(p1[r]);
    float ps = 0;
#pragma unroll
    for (int r = 0; r < 16; ++r) ps += p0[r];
#pragma unroll
    for (int r = 0; r < 16; ++r) ps += p1[r];
    { auto rr = __builtin_amdgcn_permlane32_swap(__float_as_uint(ps), __float_as_uint(ps), false, false);
      ps = __uint_as_float(rr[0]) + __uint_as_float(rr[1]); }
    l_reg = l_reg * alpha + ps;
#define PK4(P, B_, OUT) do { unsigned a0 = cvtpk(P[B_+0], P[B_+1]), a1 = cvtpk(P[B_+2], P[B_+3]);                          \
        unsigned b0 = cvtpk(P[B_+4], P[B_+5]), b1 = cvtpk(P[B_+6], P[B_+7]);                                             \
        auto r0 = __builtin_amdgcn_permlane32_swap(a0, b0, false, false); auto r1 = __builtin_amdgcn_permlane32_swap(a1, b1, false, false); \
        v4u w = {r0[0], r1[0], r0[1], r1[1]}; OUT = __builtin_bit_cast(bf16x8, w); } while (0)
    PK4(p0, 0, pa0); PK4(p0, 8, pa1); PK4(p1, 0, pa2); PK4(p1, 8, pa3);
}
template <int KB>
__device__ __forceinline__ void qkt(f32x16& p0, f32x16& p1, const char* K_lds, int r32, int hi, const bf16x8* qr, bool act, float init) {
    if (!act) { const float NEG = -__builtin_inff();
#pragma unroll
        for (int r = 0; r < 16; ++r) { p0[r] = NEG; p1[r] = NEG; } return; }
#pragma unroll
    for (int r = 0; r < 16; ++r) { p0[r] = init; p1[r] = init; }
    const char* kb[4];
#pragma unroll
    for (int dd = 0; dd < 4; ++dd) kb[dd] = K_lds + KB * SHM_K + KSWZ(r32, (dd * 16 + hi * 8) * 2);
#pragma unroll
    for (int d0 = 0; d0 < 8; ++d0) { const char* a = kb[d0 & 3] + (d0 >> 2) * 128;
        bf16x8 b0 = *reinterpret_cast<const bf16x8*>(a);
        bf16x8 b1 = *reinterpret_cast<const bf16x8*>(a + 32 * 256);
        p0 = __builtin_amdgcn_mfma_f32_32x32x16_bf16(b0, qr[d0], p0, 0, 0, 0);
        p1 = __builtin_amdgcn_mfma_f32_32x32x16_bf16(b1, qr[d0], p1, 0, 0, 0); }
}
__device__ __forceinline__ void qk32(f32x16& p0, const char* tile, int r32, int hi, const char* qf) {
#pragma unroll
    for (int r = 0; r < 16; ++r) p0[r] = 0.f;
#pragma unroll
    for (int d0 = 0; d0 < 8; ++d0) { const char* a = tile + KSWZ(r32, ((d0 & 3) * 16 + hi * 8) * 2) + (d0 >> 2) * 128;
        bf16x8 b0 = *reinterpret_cast<const bf16x8*>(a);
        p0 = __builtin_amdgcn_mfma_f32_32x32x16_bf16(b0, *reinterpret_cast<const bf16x8*>(qf + d0 * 1024), p0, 0, 0, 0); }
}
template <int VB>
__device__ __forceinline__ void pv_tile(f32x16* o, int vb0, bf16x8 pa0, bf16x8 pa1, bf16x8 pa2, bf16x8 pa3, bool act) {
    if (!act) return;
#define TRRD(dst, off) asm volatile("ds_read_b64_tr_b16 %0, %1 offset:%2" : "=&v"(dst) : "v"(vb0), "i"(off) : "memory")
#define PV_D0(d0) do { s16x4 l0, l1, l2, l3, h0, h1, h2, h3; constexpr int b_ = VB * SHM_V + v_rd_off(d0, 0, 0); \
        TRRD(l0, b_); TRRD(h0, b_ + 2048); TRRD(l1, b_ + 4096); TRRD(h1, b_ + 6144); TRRD(l2, b_ + 8192); TRRD(h2, b_ + 10240); TRRD(l3, b_ + 12288); TRRD(h3, b_ + 14336); \
        asm volatile("s_waitcnt lgkmcnt(0)" ::: "memory"); SBAR(); \
        o[d0] = __builtin_amdgcn_mfma_f32_32x32x16_bf16(pa0, (bf16x8){l0[0], l0[1], l0[2], l0[3], h0[0], h0[1], h0[2], h0[3]}, o[d0], 0, 0, 0);   \
        o[d0] = __builtin_amdgcn_mfma_f32_32x32x16_bf16(pa1, (bf16x8){l1[0], l1[1], l1[2], l1[3], h1[0], h1[1], h1[2], h1[3]}, o[d0], 0, 0, 0);   \
        o[d0] = __builtin_amdgcn_mfma_f32_32x32x16_bf16(pa2, (bf16x8){l2[0], l2[1], l2[2], l2[3], h2[0], h2[1], h2[2], h2[3]}, o[d0], 0, 0, 0);   \
        o[d0] = __builtin_amdgcn_mfma_f32_32x32x16_bf16(pa3, (bf16x8){l3[0], l3[1], l3[2], l3[3], h3[0], h3[1], h3[2], h3[3]}, o[d0], 0, 0, 0); } while (0)
    PV_D0(0); PV_D0(1); PV_D0(2); PV_D0(3);
#undef PV_D0
#undef TRRD
}


constexpr int OFF_ENT = OFF_KBAR + 32 * 256;
constexpr int ATT2_LDS = OFF_ENT + NWAVES * 512;
static_assert(ATT2_LDS <= LDSCTL_OFF, "attention LDS scratch overlaps the control words");
#define LD8(p) (*reinterpret_cast<const bf16x8*>(p))

struct SelRegs { bf16x8 q[8], kb; };
__device__ __forceinline__ void moba_sel_load(SelRegs& p, int h, int b, const bf16* __restrict__ Q, const bf16* __restrict__ KBb) {
    int tid0 = threadIdx.x; asm volatile("" : "+v"(tid0));
    const int wid = tid0 >> 6, lane = tid0 & 63, r32 = lane & 31, hi = lane >> 5, qlo = b * BLK + wid * QBLK;
#pragma unroll
    for (int d0 = 0; d0 < 8; ++d0) p.q[d0] = LD8(Q + (size_t)(qlo + r32) * LD + h * D + d0 * 16 + hi * 8);
    p.kb = LD8(KBb + ((size_t)h * NBLK + (tid0 >> 4)) * D + (tid0 & 15) * 8);
}
__device__ __forceinline__ void moba_sel_unit(int h, int b, const bf16* __restrict__ Q, const bf16* __restrict__ KBb, int* __restrict__ CNT, int* __restrict__ LIST, char* lds, SelRegs& pre, int nh, int nb) {
    int tid0 = threadIdx.x; asm volatile("" : "+v"(tid0));
    const int wid = __builtin_amdgcn_readfirstlane(tid0 >> 6), lane = tid0 & 63, r32 = lane & 31, hi = lane >> 5;
    char* kbar_t = lds + OFF_KBAR;
    const int qlo = b * BLK + wid * QBLK;
    char* qf = lds + OFF_QF + wid * 8192 + lane * 16;
    {
#pragma unroll
      for (int d0 = 0; d0 < 8; ++d0) *(bf16x8*)(qf + d0 * 1024) = pre.q[d0];
      const int sr0 = tid0 >> 4, sc0 = (tid0 & 15) * 8;
      *(bf16x8*)(kbar_t + KSWZ(sr0, sc0 * 2)) = pre.kb; }
    moba_sel_load(pre, nh, nb, Q, KBb);
    __syncthreads();
    f32x16 g0; qk32(g0, kbar_t, r32, hi, qf);
    float t1v = -__builtin_inff(), t2v = t1v, t3v = t1v; int t1n = 64, t2n = 64, t3n = 64;
#define TOP3_INS(vv, nn) do { const float v_ = (vv); const int n_ = (nn);                                         \
        const bool g1 = v_ > t1v || (v_ == t1v && n_ < t1n), g2 = v_ > t2v || (v_ == t2v && n_ < t2n), g3 = v_ > t3v || (v_ == t3v && n_ < t3n); \
        t3v = g2 ? t2v : (g3 ? v_ : t3v); t3n = g2 ? t2n : (g3 ? n_ : t3n);                                        \
        t2v = g1 ? t1v : (g2 ? v_ : t2v); t2n = g1 ? t1n : (g2 ? n_ : t2n);                                        \
        t1v = g1 ? v_ : t1v; t1n = g1 ? n_ : t1n; } while (0)
#pragma unroll
    for (int r = 0; r < 16; ++r) { const int n = crow(r, hi), on = crow(r, 1 - hi); const float ov = __shfl_xor(g0[r], 32);
        TOP3_INS(n < b ? g0[r] : -__builtin_inff(), n); TOP3_INS(on < b ? ov : -__builtin_inff(), on); }
#undef TOP3_INS
    unsigned selmask = ((t1n < 32 ? 1u << t1n : 0u) | (t2n < 32 ? 1u << t2n : 0u) | (t3n < 32 ? 1u << t3n : 0u)) & ((b >= 32) ? 0xffffffffu : ((1u << b) - 1u));
    int* cnt_s = (int*)(lds + OFF_LUT); int* base_s = cnt_s + 32;
    if (tid0 < 32) cnt_s[tid0] = 0;
    __syncthreads();
    int pn[3] = {-1, -1, -1}, pr[3] = {0, 0, 0};
    if (hi == 0) {
#pragma unroll
        for (int s_ = 0; s_ < 3; ++s_) if (selmask) { const int n = __builtin_ctz(selmask); selmask &= selmask - 1u; pn[s_] = n; pr[s_] = atomicAdd(cnt_s + n, 1); } }
    __syncthreads();
    if (tid0 < 32) { const int c = cnt_s[tid0]; base_s[tid0] = c > 0 ? atomicAdd(CNT + h * NBLK + tid0, c) : 0; }
    __syncthreads();
    if (hi == 0) { const int q = qlo + r32;
#pragma unroll
        for (int s_ = 0; s_ < 3; ++s_) if (pn[s_] >= 0) LIST[((size_t)h * NBLK + pn[s_]) * SEQ + base_s[pn[s_]] + pr[s_]] = q | (s_ << 13); }
    __syncthreads();
}

struct KVRegs { bf16x8 k[4][2], v[4][2], q[8]; float lutv; };
#define MOBA_QLOAD(dst, h_, qrow_) do { _Pragma("unroll") for (int d0 = 0; d0 < 8; ++d0) (dst).q[d0] = LD8(Q + (size_t)(qrow_) * LD + (h_) * D + d0 * 16 + hi * 8); } while (0)
#define MOBA_LUTLOAD(dst, h_, t_) do { const int d_ = (t_) - 64; (dst).lutv = ((t_) < 320 && d_ >= 0) ? rel[rel_bucket(d_ > 127 ? 127 : d_) * AH + (h_)] * LOG2E : -__builtin_inff(); } while (0)
#define MOBA_KVLOAD(dst, h_, blk_) do { const bf16* Kh_ = K + (size_t)((blk_) * BLK) * LD + (h_) * D + sc; const bf16* Vh_ = V + (size_t)((blk_) * BLK) * LD + (h_) * D + sc; \
        _Pragma("unroll") for (int t = 0; t < 4; ++t) { (dst).k[t][0] = LD8(Kh_ + (size_t)(t * 64 + sr) * LD); (dst).k[t][1] = LD8(Kh_ + (size_t)(t * 64 + 32 + sr) * LD); \
            (dst).v[t][0] = LD8(Vh_ + (size_t)(t * 64 + sr) * LD); (dst).v[t][1] = LD8(Vh_ + (size_t)(t * 64 + 32 + sr) * LD); } } while (0)
__device__ __forceinline__ void moba_kv_first(KVRegs& kv, int h, int blk, int raw, const bf16* __restrict__ Q, const bf16* __restrict__ K, const bf16* __restrict__ V, const float* __restrict__ rel) {
    int tid = threadIdx.x; asm volatile("" : "+v"(tid)); const int sr = tid >> 4, sc = (tid & 15) * 8, hi = (tid & 63) >> 5; MOBA_KVLOAD(kv, h, blk); MOBA_QLOAD(kv, h, raw & 8191); MOBA_LUTLOAD(kv, h, tid); }
__device__ __forceinline__ void moba_kv_first_own(KVRegs& kv, int h, int blk, const bf16* __restrict__ Q, const bf16* __restrict__ K, const bf16* __restrict__ V, const float* __restrict__ rel) {
    int tid = threadIdx.x; asm volatile("" : "+v"(tid)); const int sr = tid >> 4, sc = (tid & 15) * 8, hi = (tid & 63) >> 5, wid = tid >> 6, rbw = wid < 4 ? wid : 11 - wid;
    MOBA_KVLOAD(kv, h, blk); MOBA_QLOAD(kv, h, blk * BLK + rbw * QBLK + (tid & 31)); MOBA_LUTLOAD(kv, h, tid); }
template <int MODE>
__device__ __forceinline__ void moba_tile_unit(int h, int blk, int j, const bf16* Q, const bf16* __restrict__ K, const bf16* __restrict__ V, bf16* O, const int* __restrict__ CNT, const int* __restrict__ LIST,
                                               bf16* PART, float* PML, const float* __restrict__ rel, char* lds, int* raw_io = nullptr, int nxt = -1, KVRegs* kvc = nullptr) {
    int tid0 = threadIdx.x; asm volatile("" : "+v"(tid0));
    const int wid = __builtin_amdgcn_readfirstlane(tid0 >> 6), lane = tid0 & 63, r32 = lane & 31, hi = lane >> 5;
    float* lut = (float*)(lds + OFF_LUT);
    constexpr int NT = 4;
    const int kb0 = blk * BLK;
    int* ent_s = (int*)(lds + OFF_ENT + wid * 512); float* fs = (float*)(lds + OFF_ENT + wid * 512 + 128);
    int tid = threadIdx.x; asm volatile("" : "+v"(tid));
    char* V_lds = lds + OFF_V; char* K_lds = lds + OFF_K;
    const int sr = tid >> 4, sc = (tid & 15) * 8, vst0 = v_st(sr, sc), vst1 = v_st(32 + sr, sc), kws = KSWZ(sr, sc * 2);
    int qrow, ent = -1, raw = 0; bool entv = false;
    if (MODE == 1) { const int cnt = ((const int*)(lds + OFF_KBAR))[512 + h * NBLK + blk]; const int e0 = j * 256, nv = (cnt - e0) < 256 ? (cnt - e0) : 256; const int ei = wid * 32 + r32;
        raw = *raw_io; entv = ei < nv;
        if (nxt >= 0) { const int hn2 = nxt & 0xffff, e2 = (nxt >> 16) * 256; const int cnt2 = ((const int*)(lds + OFF_KBAR))[512 + hn2], nv2 = (cnt2 - e2) < 256 ? (cnt2 - e2) : 256;
            *raw_io = LIST[(size_t)hn2 * SEQ + e2 + (ei < nv2 ? ei : 0)]; } }
    KVRegs kv;
    kv = *kvc;
    if (MODE == 1) { ent = entv ? raw : -1; qrow = raw & 8191; if (hi == 0) ent_s[r32] = ent; }
    const int rbw = (MODE == 2) ? (wid < 4 ? wid : 11 - wid) : wid;
    if (MODE != 1) qrow = blk * BLK + rbw * QBLK + r32;
    bf16x8 qr[8];
#pragma unroll
    for (int d0 = 0; d0 < 8; ++d0) qr[d0] = kvc->q[d0];
    if (tid0 < 320) lut[tid0] = kvc->lutv;
#pragma unroll
    for (int t = 0; t < 4; ++t) { *(bf16x8*)(K_lds + t * SHM_K + kws) = kv.k[t][0]; *(bf16x8*)(K_lds + t * SHM_K + kws + 32 * 256) = kv.k[t][1];
        *(bf16x8*)(V_lds + t * SHM_V + vst0) = kv.v[t][0]; *(bf16x8*)(V_lds + t * SHM_V + vst1) = kv.v[t][1]; }
    float m_reg = -1e30f, l_reg = 0.f; const int nsel = (MODE == 2) ? (blk < 3 ? blk : 3) : 0;
    __syncthreads();
    float* ws = (float*)(lds + OFF_WS) + wid * 64; float* li_l = ws, * al_l = ws + 32;
    const int vb0 = (int)(uintptr_t)V_lds + v_rd_base(tid & 63);
#define KBASE(t) (kb0 + (t) * KVBLK)
    f32x16 o[4] = {};
    const float lut127 = lut[64 + 127];
    const int qlo = (MODE == 2) ? blk * BLK + rbw * QBLK : 0;
    const int qm = qrow - 4 * hi;
#define RESC(a) do { if (__any((a) < 1.f)) { if (hi == 0) al_l[r32] = (a); asm volatile("s_waitcnt lgkmcnt(0)" ::: "memory");              \
                     for (int d_ = 0; d_ < 4; ++d_) for (int r = 0; r < 16; ++r) o[d_][r] *= al_l[crow(r, hi)]; } } while (0)
#define ACT(t) ((MODE == 1) ? true : (KBASE(t) <= qlo + QBLK - 1))
#define NEAR(t) ((MODE == 1) ? (__any(qrow < KBASE(t) + 191) != 0) : (KBASE(t) > qlo - 191))
#define INITV(t) (NEAR(t) ? 0.f : lut127)
#define MASKT(P0_, P1_, t) do { if (ACT(t) && NEAR(t)) bias_tile(P0_, P1_, qm - KBASE(t), lut); } while (0)
    f32x16 pA0, pA1, pB0, pB1; float mnA, mnB, alA, alB; bf16x8 pa0, pa1, pa2, pa3;
    if (!((MODE == 1 && O != nullptr) || (MODE == 2 && j == 1))) {
    qkt<0>(pA0, pA1, K_lds, r32, hi, qr, ACT(0), INITV(0)); MASKT(pA0, pA1, 0); partialSM(pA0, pA1, m_reg, mnA, alA);
    SBAR(); qkt<1>(pB0, pB1, K_lds, r32, hi, qr, ACT(1), INITV(1)); finishSM(pA0, pA1, alA, l_reg, pa0, pa1, pa2, pa3); SBAR();
    pv_tile<0>(o, vb0, pa0, pa1, pa2, pa3, ACT(0)); MASKT(pB0, pB1, 1); partialSM(pB0, pB1, m_reg, mnB, alB); RESC(alB);
    SBAR(); qkt<2>(pA0, pA1, K_lds, r32, hi, qr, ACT(2), INITV(2)); finishSM(pB0, pB1, alB, l_reg, pa0, pa1, pa2, pa3); SBAR();
    pv_tile<1>(o, vb0, pa0, pa1, pa2, pa3, ACT(1)); MASKT(pA0, pA1, 2); partialSM(pA0, pA1, m_reg, mnA, alA); RESC(alA);
    SBAR(); qkt<3>(pB0, pB1, K_lds, r32, hi, qr, ACT(3), INITV(3)); finishSM(pA0, pA1, alA, l_reg, pa0, pa1, pa2, pa3); SBAR();
    pv_tile<2>(o, vb0, pa0, pa1, pa2, pa3, ACT(2)); MASKT(pB0, pB1, 3); partialSM(pB0, pB1, m_reg, mnB, alB); RESC(alB);
    finishSM(pB0, pB1, alB, l_reg, pa0, pa1, pa2, pa3); SBAR(); pv_tile<3>(o, vb0, pa0, pa1, pa2, pa3, ACT(3));
    } else { asm volatile("" :: "v"(qr[0]), "v"(qr[7])); l_reg = 1.f; }
    if (MODE == 1) { const int hn2 = nxt >= 0 ? (nxt & 0xffff) : (h * NBLK + blk);     int tid2 = threadIdx.x; asm volatile("" : "+v"(tid2)); const int sr = tid2 >> 4, sc = (tid2 & 15) * 8; MOBA_KVLOAD(*kvc, hn2 >> 5, hn2 & 31); MOBA_QLOAD(*kvc, hn2 >> 5, *raw_io & 8191); MOBA_LUTLOAD(*kvc, hn2 >> 5, tid2); }
    if (MODE == 2) { const int hn2 = nxt >= 0 ? nxt : (h * NBLK + blk); int tid2 = threadIdx.x; asm volatile("" : "+v"(tid2)); const int sr = tid2 >> 4, sc = (tid2 & 15) * 8;
        MOBA_KVLOAD(*kvc, hn2 >> 5, hn2 & 31); MOBA_QLOAD(*kvc, hn2 >> 5, (hn2 & 31) * BLK + rbw * QBLK + r32); MOBA_LUTLOAD(*kvc, hn2 >> 5, tid2); }
    __syncthreads();
    char* stg = lds + OFF_K + wid * 8192;
    if (MODE == 1) {
        if (hi == 0 && ent >= 0) { float* p = PML + (((size_t)qrow * AH + h) * 3 + (ent >> 13)) * 2; p[0] = m_reg; p[1] = l_reg; }
#pragma unroll
        for (int r = 0; r < 16; ++r) { const int row = crow(r, hi);
#pragma unroll
            for (int d0 = 0; d0 < 4; ++d0) *(bf16*)(stg + row * 256 + (d0 * 32 + r32) * 2) = (bf16)f2bf(o[d0][r]); }
        asm volatile("s_waitcnt lgkmcnt(0)" ::: "memory");
#pragma unroll
        for (int i = 0; i < 8; ++i) { const int c = lane + 64 * i, row = c >> 4, ch = c & 15; const int er = ent_s[row];
            const v4u v = *(const v4u*)(stg + row * 256 + ch * 16);
            if (er >= 0) *(GAS v4u*)(PART + (((size_t)(er & 8191) * AH + h) * 3 + (er >> 13)) * D + ch * 8) = v; }
    } else {
        { float mt[3] = {-1e30f, -1e30f, -1e30f}, lt[3] = {0.f, 0.f, 0.f};
#pragma unroll
          for (int t = 0; t < 3; ++t) { const f32x2 ml = *(const GAS f32x2*)(PML + (((size_t)qrow * AH + h) * 3 + t) * 2); mt[t] = (t < nsel) ? ml[0] : -1e30f; lt[t] = (t < nsel) ? ml[1] : 0.f; }
          const float M = fmaxf(fmaxf(m_reg, mt[0]), fmaxf(mt[1], mt[2]));
          const float fo = __builtin_amdgcn_exp2f(m_reg - M); float L = l_reg * fo; float ft[3];
#pragma unroll
          for (int t = 0; t < 3; ++t) { ft[t] = (t < nsel) ? __builtin_amdgcn_exp2f(mt[t] - M) : 0.f; L += lt[t] * ft[t]; }
          const float rL = 1.0f / L;
          if (hi == 0) { li_l[r32] = fo * rL; fs[r32] = ft[0] * rL; fs[32 + r32] = ft[1] * rL; fs[64 + r32] = ft[2] * rL; } }
        asm volatile("s_waitcnt lgkmcnt(0)" ::: "memory");
#pragma unroll
        for (int r = 0; r < 16; ++r) { const int row = crow(r, hi); const float sc_ = li_l[row];
#pragma unroll
            for (int d0 = 0; d0 < 4; ++d0) *(bf16*)(stg + row * 256 + (d0 * 32 + r32) * 2) = (bf16)f2bf(o[d0][r] * sc_); }
        asm volatile("s_waitcnt lgkmcnt(0)" ::: "memory");
        bf16* Ow = O + (size_t)qlo * LD + h * D;
        auto merge = [&](auto NSEL_) { constexpr int NS = decltype(NSEL_)::value;
            v4u pwb[2][NS > 0 ? NS : 1];
#define MRG_LD(i_, b_) do { const int c_ = lane + 64 * (i_), row_ = c_ >> 4, ch_ = c_ & 15; \
                _Pragma("unroll") for (int t = 0; t < NS; ++t) pwb[b_][t] = *(const GAS v4u*)(PART + (((size_t)(qlo + row_) * AH + h) * 3 + t) * D + ch_ * 8); } while (0)
            MRG_LD(0, 0);
#pragma unroll
            for (int i = 0; i < 8; ++i) { const int c = lane + 64 * i, row = c >> 4, ch = c & 15;
                if (i + 1 < 8) MRG_LD(i + 1, (i + 1) & 1);
                v4u (&pw)[NS > 0 ? NS : 1] = pwb[i & 1];
                float v[8]; { const v4u w = *(const v4u*)(stg + row * 256 + ch * 16); v[0] = bflo(w.x); v[1] = bfhi(w.x); v[2] = bflo(w.y); v[3] = bfhi(w.y); v[4] = bflo(w.z); v[5] = bfhi(w.z); v[6] = bflo(w.w); v[7] = bfhi(w.w); }
#pragma unroll
                for (int t = 0; t < NS; ++t) { const float f = fs[t * 32 + row]; const v4u w = pw[t];
                    v[0] += f * bflo(w.x); v[1] += f * bfhi(w.x); v[2] += f * bflo(w.y); v[3] += f * bfhi(w.y); v[4] += f * bflo(w.z); v[5] += f * bfhi(w.z); v[6] += f * bflo(w.w); v[7] += f * bfhi(w.w); }
                v4u ov; ov.x = pk2(v[0], v[1]); ov.y = pk2(v[2], v[3]); ov.z = pk2(v[4], v[5]); ov.w = pk2(v[6], v[7]);
                *(GAS v4u*)(Ow + (size_t)row * LD + ch * 8) = ov; }
#undef MRG_LD
        };
        if (nsel == 3) merge(std::integral_constant<int, 3>{}); else if (nsel == 2) merge(std::integral_constant<int, 2>{}); else if (nsel == 1) merge(std::integral_constant<int, 1>{}); else merge(std::integral_constant<int, 0>{});
    }
    __syncthreads();
#undef RESC
#undef KBASE
#undef ACT
#undef NEAR
#undef INITV
#undef MASKT
}
#undef MOBA_KVLOAD
#undef MOBA_LUTLOAD
#undef MOBA_QLOAD
#undef LD8
}

namespace ssd {
using att::crow; using att::cvtpk;
constexpr int OFF_B = 0;
constexpr int OFF_X = 65536;
constexpr int OFF_ACS = 132096;
constexpr int OFF_DT = OFF_ACS + 8192;
constexpr float LOG2E = 1.4426950408889634f;
static_assert(OFF_DT + 16384 <= LDSCTL_OFF, "SSD LDS scratch overlaps the control words");
__device__ __forceinline__ int v_st64(int k, int c) { const int kk = (k & ~0xC) | ((k & 4) << 1) | ((k & 8) >> 1); return ((kk >> 3) * 2 + (c >> 5)) * 512 + ((kk & 7) * 32 + (c & 31)) * 2; }
constexpr int v_rd_off64(int d0, int ks, int half) { return d0 * 512 + ks * 2048 + half * 1024; }

__device__ __forceinline__ void conv8(const bf16* __restrict__ XBC, int t, int ch0, const float (&w)[4][8], const float (&bs)[8], float (&out)[8]) {
    v4u raw[4];
#pragma unroll
    for (int k = 0; k < 4; ++k) { const int ts = t - 3 + k; raw[k] = *(const GAS v4u*)(XBC + (size_t)(ts < 0 ? 0 : ts) * DXBC + ch0); }
#pragma unroll
    for (int e = 0; e < 8; ++e) out[e] = bs[e];
#pragma unroll
    for (int k = 0; k < 4; ++k) { const float ok = (t - 3 + k) >= 0 ? 1.f : 0.f; float a[8]; unpack8(raw[k], a);
#pragma unroll
        for (int e = 0; e < 8; ++e) out[e] += (w[k][e] * ok) * a[e]; }
#pragma unroll
    for (int e = 0; e < 8; ++e) out[e] = siluf(out[e]);
}
template <int NTOK>
__device__ __forceinline__ void conv8_load(const bf16* __restrict__ XBC, int t, int ch0, v4u (&raw)[NTOK + 3]) {
#pragma unroll
    for (int k = 0; k < NTOK + 3; ++k) { const int ts = t - 3 + k; raw[k] = *(const GAS v4u*)(XBC + (size_t)(ts < 0 ? 0 : ts) * DXBC + ch0); }
}
template <int NTOK>
__device__ __forceinline__ void conv8_comp(int t, v4u (&raw)[NTOK + 3], const float (&w)[4][8], const float (&bs)[8], float (&out)[NTOK][8]) {
    if (t < 3) {
#pragma unroll
        for (int k = 0; k < 3; ++k) if (t - 3 + k < 0) raw[k] = (v4u){0u, 0u, 0u, 0u};
    }
    float a[4][8];
#pragma unroll
    for (int k = 0; k < 3; ++k) unpack8(raw[k], a[k]);
#pragma unroll
    for (int i = 0; i < NTOK; ++i) { unpack8(raw[i + 3], a[(i + 3) & 3]);
#pragma unroll
        for (int e = 0; e < 8; ++e) { float v = bs[e];
#pragma unroll
            for (int k = 0; k < 4; ++k) v += w[k][e] * a[(i + k) & 3][e];
            out[i][e] = siluf(v); } }
}
template <int NTOK>
__device__ __forceinline__ void conv8_run(const bf16* __restrict__ XBC, int t, int ch0, const float (&w)[4][8], const float (&bs)[8], float (&out)[NTOK][8]) {
    v4u raw[NTOK + 3]; conv8_load<NTOK>(XBC, t, ch0, raw); conv8_comp<NTOK>(t, raw, w, bs, out);
}
__device__ __forceinline__ void load_convw(const float* __restrict__ cw, const float* __restrict__ cb, int ch0, float (&w)[4][8], float (&bs)[8]) {
#pragma unroll
    for (int k = 0; k < 4; ++k)
#pragma unroll
        for (int e = 0; e < 8; ++e) w[k][e] = cw[k * DXBC + ch0 + e];
#pragma unroll
    for (int e = 0; e < 8; ++e) bs[e] = cb[ch0 + e];
}
__device__ __forceinline__ void conv8_lite(const bf16* __restrict__ XBC, int t, int ch0, const float* __restrict__ cw, const float* __restrict__ cb, float (&out)[8]) {
    { const f32x4 b0 = *(const GAS f32x4*)(cb + ch0), b1 = *(const GAS f32x4*)(cb + ch0 + 4); out[0] = b0[0]; out[1] = b0[1]; out[2] = b0[2]; out[3] = b0[3]; out[4] = b1[0]; out[5] = b1[1]; out[6] = b1[2]; out[7] = b1[3]; }
#pragma unroll
    for (int k = 0; k < 4; ++k) { const int ts = t - 3 + k; const float ok = ts >= 0 ? 1.f : 0.f; const int row = ts >= 0 ? ts : 0;
        float a[8]; unpack8(*(const GAS v4u*)(XBC + (size_t)row * DXBC + ch0), a);
        const f32x4 w0 = *(const GAS f32x4*)(cw + k * DXBC + ch0) * ok, w1 = *(const GAS f32x4*)(cw + k * DXBC + ch0 + 4) * ok;
        out[0] += w0[0] * a[0]; out[1] += w0[1] * a[1]; out[2] += w0[2] * a[2]; out[3] += w0[3] * a[3]; out[4] += w1[0] * a[4]; out[5] += w1[1] * a[5]; out[6] += w1[2] * a[6]; out[7] += w1[3] * a[7]; }
#pragma unroll
    for (int e = 0; e < 8; ++e) out[e] = siluf(out[e]);
}
__device__ __forceinline__ v4u pack8f(const float (&v)[8]) { v4u o; o.x = pk2(v[0], v[1]); o.y = pk2(v[2], v[3]); o.z = pk2(v[4], v[5]); o.w = pk2(v[6], v[7]); return o; }

#define SSD_TRRD(dst, base, off) asm volatile("ds_read_b64_tr_b16 %0, %1 offset:%2" : "=&v"(dst) : "v"(base), "i"(off) : "memory")
#define SSD_F8(l, h) ((bf16x8){l[0], l[1], l[2], l[3], h[0], h[1], h[2], h[3]})

__device__ __forceinline__ void states_unit(int c, int g, const Args& A, char* lds, int flag = 0) {
    int tid = threadIdx.x; asm volatile("" : "+v"(tid));
    const int wid = __builtin_amdgcn_readfirstlane(tid >> 6), lane = tid & 63, r32 = lane & 31, hi = lane >> 5;
    unsigned char* ws = A.ws;
    const bf16* XBC = (const bf16*)(ws + WS_XBC); const float* DT = (const float*)(ws + WS_DT); float* ACS = (float*)(ws + WS_ACS); float* ST = (float*)(ws + WS_STATES);
    const float* cw = A.in[I_SCW]; const float* cb = A.in[I_SCB];
    float* acs_s = (float*)(lds + OFF_ACS); float* dt_s = (float*)(lds + OFF_DT);
    bf16* BCC = (bf16*)(ws + WS_BCC); bf16* XC = (bf16*)A.out;
    const int t0 = c * CHK;
    v4u rawB[11], rawC[11]; const int chB = DI + g * NST + (tid & 15) * 8, chC = DI + NG * NST + g * NST + (tid & 15) * 8;
    if (flag != 8) { conv8_load<8>(XBC, t0 + (tid >> 4) * 8, chB, rawB); conv8_load<8>(XBC, t0 + (tid >> 4) * 8, chC, rawC); }
    { const int head = g * 8 + wid; const float Aneg = -__expf(A.in[I_ALOG][head]);
      float d[4], a[4];
#pragma unroll
      for (int i = 0; i < 4; ++i) d[i] = DT[(size_t)(t0 + 4 * lane + i) * NHS + head];
      a[0] = d[0] * Aneg; a[1] = a[0] + d[1] * Aneg; a[2] = a[1] + d[2] * Aneg; a[3] = a[2] + d[3] * Aneg;
      float incl = a[3];
#pragma unroll
      for (int o = 1; o < 64; o <<= 1) { const float v = __shfl_up(incl, o); if (lane >= o) incl += v; }
      const float excl = incl - a[3];
#pragma unroll
      for (int i = 0; i < 4; ++i) { const float v = a[i] + excl; acs_s[wid * CHK + 4 * lane + i] = v; dt_s[wid * CHK + 4 * lane + i] = d[i];     ACS[(size_t)(t0 + 4 * lane + i) * NHS + head] = v; } }
    if (flag != 8) { float w[4][8], bs[8]; const int ch0 = chB; load_convw(cw, cb, ch0, w, bs);
      const int l0 = (tid >> 4) * 8; float v[8][8];
      conv8_comp<8>(t0 + l0, rawB, w, bs, v);
#pragma unroll
      for (int i = 0; i < 8; ++i) { const int l = l0 + i; const v4u pk = pack8f(v[i]);
          *(v4u*)(lds + OFF_B + (l >> 6) * 16384 + att::v_st(l & 63, (tid & 15) * 8)) = pk;
          *(GAS v4u*)(BCC + (size_t)(t0 + l) * 2048 + g * NST + (tid & 15) * 8) = pk; } }
    if (flag != 8) { float w[4][8], bs[8]; const int ch0 = chC; load_convw(cw, cb, ch0, w, bs);
      const int l0 = (tid >> 4) * 8; float v[8][8]; conv8_comp<8>(t0 + l0, rawC, w, bs, v);
#pragma unroll
      for (int i = 0; i < 8; ++i) *(GAS v4u*)(BCC + (size_t)(t0 + l0 + i) * 2048 + 1024 + g * NST + (tid & 15) * 8) = pack8f(v[i]); }
    __syncthreads();
    const int mb = wid & 1, nb = wid >> 1;
    const int rdb = att::v_rd_base(lane);
    v4u xraw[7]; float xw[4][8], xbs[8];
    auto xs_load = [&](int r) { const int ch0 = (g * 8 + r) * HP + (tid & 7) * 8; load_convw(cw, cb, ch0, xw, xbs); conv8_load<4>(XBC, t0 + (tid >> 3) * 4, ch0, xraw); };
    auto xs_finish = [&](int r) {
        const int head = g * 8 + r; char* xs = lds + OFF_X + (r & 1) * 32768; const int ch0 = head * HP + (tid & 7) * 8;
        const float alast = acs_s[r * CHK + 255];
        const int l0 = (tid >> 3) * 4; float vv[4][8]; conv8_comp<4>(t0 + l0, xraw, xw, xbs, vv);
        const f32x4 dt4 = *(const f32x4*)(dt_s + r * CHK + l0), ac4 = *(const f32x4*)(acs_s + r * CHK + l0);
#pragma unroll
        for (int i = 0; i < 4; ++i) { const int l = l0 + i;
            const float dtl = dt4[i], f = __expf(alast - ac4[i]);
#pragma unroll
            for (int e = 0; e < 8; ++e) vv[i][e] *= dtl;
            *(GAS v4u*)(XC + (size_t)(t0 + l) * DI + ch0) = pack8f(vv[i]);
#pragma unroll
            for (int e = 0; e < 8; ++e) vv[i][e] *= f;
            *(v4u*)(xs + (l >> 6) * 8192 + v_st64(l & 63, (tid & 7) * 8)) = pack8f(vv[i]); } };
    if (flag != 7) { xs_load(0); xs_finish(0); xs_load(1); }
    __syncthreads();
    for (int r = 0; r < ((flag == 7) ? 0 : 8); ++r) {
        const int head = g * 8 + r; char* xs = lds + OFF_X + (r & 1) * 32768;
        if (r + 1 < 8) xs_finish(r + 1);
        xs_load(r + 2 < 8 ? r + 2 : 7);
        f32x16 acc = {};
        if (flag == 9) { __syncthreads(); continue; }
        const int xb = (int)(uintptr_t)xs + rdb, bb = (int)(uintptr_t)(lds + OFF_B) + rdb;
#pragma unroll
        for (int tl = 0; tl < 4; ++tl) {
            const int xbt = xb + tl * 8192 + mb * 512, bbt = bb + tl * 16384 + nb * 512;
            s16x4 al[4], ah[4], bl[4], bh[4];
#define ST_RD(ks) do { SSD_TRRD(al[ks], xbt, (ks) * 2048); SSD_TRRD(ah[ks], xbt, (ks) * 2048 + 1024); SSD_TRRD(bl[ks], bbt, (ks) * 4096); SSD_TRRD(bh[ks], bbt, (ks) * 4096 + 2048); } while (0)
            ST_RD(0); ST_RD(1); ST_RD(2); ST_RD(3);
            asm volatile("s_waitcnt lgkmcnt(0)" ::: "memory"); __builtin_amdgcn_sched_barrier(0);
#pragma unroll
            for (int ks = 0; ks < 4; ++ks) acc = __builtin_amdgcn_mfma_f32_32x32x16_bf16(SSD_F8(al[ks], ah[ks]), SSD_F8(bl[ks], bh[ks]), acc, 0, 0, 0);
#undef ST_RD
#define ST_KS(ks)
#undef ST_KS
        }
        bf16* so = (bf16*)ST + (((size_t)c * NHS + head) * HP + mb * 32) * NST + nb * 32 + r32;
#pragma unroll
        for (int q = 0; q < 16; ++q) { const float v = acc[q], vn = dpp_xor1(v); if ((r32 & 1) == 0) *(unsigned*)(so + (size_t)crow(q, hi) * NST) = cvtpk(v, vn); }
        __syncthreads();
    }
}
__device__ __forceinline__ void ssd_states_phase(Frame& F, const Args& A, char* lds, int flag = 0) {
    for (int u = F.vcu; u < NCH * NG; u += F.G) states_unit(u >> 3, u & 7, A, lds, flag);
}

__device__ __forceinline__ void ssd_scan_phase(Frame& F, const Args& A) {
    unsigned char* ws = A.ws;
    const bf16* SL = (const bf16*)(ws + WS_STATES); bf16* HPB = (bf16*)(ws + WS_HPREV); const float* ACS = (const float*)(ws + WS_ACS);
    constexpr int PER = NHS * HP * NST;
    typedef unsigned u32x2_t __attribute__((ext_vector_type(2)));
    for (int e4 = F.vcu * NTHR + F.tid; e4 < PER / 4; e4 += F.G * NTHR) {
        const int head = (e4 * 4) / (HP * NST);
        u32x2_t s[NCH]; float dec[NCH];
#pragma unroll
        for (int c = 0; c < NCH; ++c) s[c] = *(const GAS u32x2_t*)(SL + (size_t)c * PER + (size_t)e4 * 4);
#pragma unroll
        for (int c = 0; c < NCH; ++c) dec[c] = ACS[(size_t)(c * CHK + CHK - 1) * NHS + head];
        float h0 = 0.f, h1 = 0.f, h2 = 0.f, h3 = 0.f;
#pragma unroll
        for (int c = 0; c < NCH; ++c) {
            u32x2_t o; o.x = pk2(h0, h1); o.y = pk2(h2, h3);
            *(GAS u32x2_t*)(HPB + (size_t)c * PER + (size_t)e4 * 4) = o;
            const float d = __expf(dec[c]);
            h0 = h0 * d + bflo(s[c].x); h1 = h1 * d + bfhi(s[c].x); h2 = h2 * d + bflo(s[c].y); h3 = h3 * d + bfhi(s[c].y); }
    }
}

__device__ __forceinline__ void cb_tile(f32x16& p0, f32x16& p1, const char* Kt, int r32, int hi, const bf16x8* qr) {
#pragma unroll
    for (int r = 0; r < 16; ++r) { p0[r] = 0.f; p1[r] = 0.f; }
#pragma unroll
    for (int d0 = 0; d0 < 8; ++d0) { const char* a = Kt + KSWZ(r32, ((d0 & 3) * 16 + hi * 8) * 2) + (d0 >> 2) * 128;
        const bf16x8 b0 = *reinterpret_cast<const bf16x8*>(a), b1 = *reinterpret_cast<const bf16x8*>(a + 32 * 256);
        p0 = __builtin_amdgcn_mfma_f32_32x32x16_bf16(b0, qr[d0], p0, 0, 0, 0);
        p1 = __builtin_amdgcn_mfma_f32_32x32x16_bf16(b1, qr[d0], p1, 0, 0, 0); }
}
__device__ __forceinline__ void out_unit(int c, int g, const Args& A, char* lds, int flag = 0) {
    int tid = threadIdx.x; asm volatile("" : "+v"(tid));
    const int wv = __builtin_amdgcn_readfirstlane(tid >> 6), wid = wv < 4 ? wv : 11 - wv, lane = tid & 63, r32 = lane & 31, hi = lane >> 5;
    unsigned char* ws = A.ws;
    const bf16* __restrict__ Z = (const bf16*)(ws + WS_Z); const float* __restrict__ DT = (const float*)(ws + WS_DT); const float* __restrict__ ACS = (const float*)(ws + WS_ACS);
    const bf16* __restrict__ HPV = (const bf16*)(ws + WS_HPREV); bf16* __restrict__ YG = (bf16*)(ws + WS_YG);
    const bf16* BCC = (const bf16*)(ws + WS_BCC); const bf16* XC = (const bf16*)A.out;
    float* acs_s = (float*)(lds + OFF_ACS); char* ht = lds + OFF_DT;
    const int t0 = c * CHK;
    for (int i = tid; i < CHK * 8; i += NTHR) { const int l = i >> 3, r = i & 7; acs_s[r * CHK + l] = ACS[(size_t)(t0 + l) * NHS + g * 8 + r] * LOG2E; }
    { for (int i = 0; i < 8; ++i) { const int l = (tid >> 4) + 32 * i;
          *(v4u*)(lds + OFF_B + (l >> 6) * 16384 + KSWZ(l & 63, (tid & 15) * 16)) = *(const GAS v4u*)(BCC + (size_t)(t0 + l) * 2048 + g * NST + (tid & 15) * 8); } }
    bf16x8 qr[8];
    { const int l = wid * 32 + r32;
#pragma unroll
      for (int d0 = 0; d0 < 8; ++d0) qr[d0] = *reinterpret_cast<const bf16x8*>(BCC + (size_t)(t0 + l) * 2048 + 1024 + g * NST + d0 * 16 + hi * 8); }
    const int lrow = wid * 32 + r32;
    const int nt = (wid >> 1) + 1;
    const int rdb = att::v_rd_base(lane);
    auto stage_x = [&](int r) {
        const int head = g * 8 + r; char* xs = lds + OFF_X + (r & 1) * 32768;
#pragma unroll
        for (int i = 0; i < 4; ++i) { const int l = (tid >> 3) + 64 * i;
            *(v4u*)(xs + i * 8192 + v_st64(l & 63, (tid & 7) * 8)) = *(const GAS v4u*)(XC + (size_t)(t0 + l) * DI + head * HP + (tid & 7) * 8); } };
    v4u hreg[2];
    auto load_h = [&](int r) { const bf16* hp = HPV + (((size_t)c * NHS + g * 8 + r) * HP + (tid >> 3)) * NST + (tid & 7) * 16;
        hreg[0] = *(const GAS v4u*)hp; hreg[1] = *(const GAS v4u*)(hp + 8); };
    auto write_h = [&]() { *(v4u*)(ht + KSWZ(tid >> 3, (tid & 7) * 32)) = hreg[0]; *(v4u*)(ht + KSWZ(tid >> 3, (tid & 7) * 32 + 16)) = hreg[1]; };
    v4u xreg[4];
    auto load_x = [&](int r) { const int head = g * 8 + r;
#pragma unroll
        for (int i = 0; i < 4; ++i) { const int l = (tid >> 3) + 64 * i; xreg[i] = *(const GAS v4u*)(XC + (size_t)(t0 + l) * DI + head * HP + (tid & 7) * 8); } };
    auto write_x = [&](int r) { char* xs = lds + OFF_X + (r & 1) * 32768;
#pragma unroll
        for (int i = 0; i < 4; ++i) { const int l = (tid >> 3) + 64 * i; *(v4u*)(xs + i * 8192 + v_st64(l & 63, (tid & 7) * 8)) = xreg[i]; } };
    stage_x(0); load_h(0); write_h();
    __syncthreads();
    for (int r = 0; r < 8; ++r) {
        const int head = g * 8 + r; const char* xs = lds + OFF_X + (r & 1) * 32768;
        load_x(r + 1 < 8 ? r + 1 : 7); load_h(r + 1 < 8 ? r + 1 : 7);
        const float a2l = acs_s[r * CHK + lrow];
        f32x16 o[2] = {};
        if (flag != 4) { const float el = __builtin_amdgcn_exp2f(a2l);
#pragma unroll
          for (int d0 = 0; d0 < 8; ++d0) { float cv[8]; unpack8(__builtin_bit_cast(v4u, qr[d0]), cv);
#pragma unroll
              for (int e = 0; e < 8; ++e) cv[e] *= el;
              const bf16x8 af = __builtin_bit_cast(bf16x8, pack8f(cv));
              const char* a = ht + KSWZ(r32, ((d0 & 3) * 16 + hi * 8) * 2) + (d0 >> 2) * 128;
              const bf16x8 b0 = *reinterpret_cast<const bf16x8*>(a), b1 = *reinterpret_cast<const bf16x8*>(a + 32 * 256);
              o[0] = __builtin_amdgcn_mfma_f32_32x32x16_bf16(af, b0, o[0], 0, 0, 0);
              o[1] = __builtin_amdgcn_mfma_f32_32x32x16_bf16(af, b1, o[1], 0, 0, 0); } }
        __syncthreads();
        if (r + 1 < 8) { write_x(r + 1); write_h(); }
        const float dskip = A.in[I_SD][head] / fmaxf(DT[(size_t)(t0 + lrow) * NHS + head], 1e-30f);
        for (int t = 0; t < ((flag == 3) ? 0 : nt); ++t) {
            f32x16 p0, p1; cb_tile(p0, p1, lds + OFF_B + t * 16384, r32, hi, qr);
            const int dq = lrow - t * 64 - 4 * hi;
#pragma unroll
            for (int q = 0; q < 16; ++q) { const int cc = (q & 3) + 8 * (q >> 2);
                const f32x4 A0 = *(const f32x4*)(acs_s + r * CHK + t * 64 + 8 * (q >> 2) + 4 * hi), A1 = *(const f32x4*)(acs_s + r * CHK + t * 64 + 32 + 8 * (q >> 2) + 4 * hi);
                const float e0 = __builtin_amdgcn_exp2f(a2l - A0[q & 3]), e1 = __builtin_amdgcn_exp2f(a2l - A1[q & 3]);
                float v0 = p0[q] * e0, v1 = p1[q] * e1;
                v0 = (cc > dq) ? 0.f : v0; v1 = (cc + 32 > dq) ? 0.f : v1;
                v0 += (cc == dq) ? dskip : 0.f; v1 += (cc + 32 == dq) ? dskip : 0.f;
                p0[q] = v0; p1[q] = v1;
                if ((q & 3) == 3) __builtin_amdgcn_sched_barrier(0); }
            bf16x8 pa0, pa1, pa2, pa3;
            PK4(p0, 0, pa0); PK4(p0, 8, pa1); PK4(p1, 0, pa2); PK4(p1, 8, pa3);
            const int xb = (int)(uintptr_t)xs + rdb + t * 8192;
#define PV64(d0) do { s16x4 l0, l1, l2, l3, h0, h1, h2, h3; \
            SSD_TRRD(l0, xb, v_rd_off64(d0, 0, 0)); SSD_TRRD(h0, xb, v_rd_off64(d0, 0, 1)); SSD_TRRD(l1, xb, v_rd_off64(d0, 1, 0)); SSD_TRRD(h1, xb, v_rd_off64(d0, 1, 1)); \
            SSD_TRRD(l2, xb, v_rd_off64(d0, 2, 0)); SSD_TRRD(h2, xb, v_rd_off64(d0, 2, 1)); SSD_TRRD(l3, xb, v_rd_off64(d0, 3, 0)); SSD_TRRD(h3, xb, v_rd_off64(d0, 3, 1)); \
            asm volatile("s_waitcnt lgkmcnt(0)" ::: "memory"); __builtin_amdgcn_sched_barrier(0); \
            o[d0] = __builtin_amdgcn_mfma_f32_32x32x16_bf16(pa0, SSD_F8(l0, h0), o[d0], 0, 0, 0); o[d0] = __builtin_amdgcn_mfma_f32_32x32x16_bf16(pa1, SSD_F8(l1, h1), o[d0], 0, 0, 0); \
            o[d0] = __builtin_amdgcn_mfma_f32_32x32x16_bf16(pa2, SSD_F8(l2, h2), o[d0], 0, 0, 0); o[d0] = __builtin_amdgcn_mfma_f32_32x32x16_bf16(pa3, SSD_F8(l3, h3), o[d0], 0, 0, 0); } while (0)
            PV64(0); PV64(1);
#undef PV64
        }
        if (flag != 5)
#pragma unroll
        for (int d0 = 0; d0 < 2; ++d0) {
#pragma unroll
          for (int q = 0; q < 16; ++q) { const size_t off = (size_t)(t0 + wid * 32 + crow(q, hi)) * DI + head * HP + r32 + d0 * 32;
              const float v = o[d0][q]; const float vn = dpp_xor1(v);
              if ((r32 & 1) == 0) *(unsigned*)(YG + off) = cvtpk(v, vn); } }
        __syncthreads();
    }
    asm volatile("s_waitcnt vmcnt(0)" ::: "memory");
    if (flag != 5 && flag != 6) { const float* nw = A.in[I_SNW] + g * 512 + lane * 8; float nwv[8];
#pragma unroll
      for (int e = 0; e < 8; ++e) nwv[e] = nw[e];
      v4u raw[2][8], zr[2][8];
#define SSD_LDB(k, s_) do { _Pragma("unroll") for (int j = 0; j < 8; ++j) { const size_t off = (size_t)(t0 + wid * 32 + (k) * 8 + j) * DI + g * 512 + lane * 8; raw[s_][j] = *(const GAS v4u*)(YG + off); zr[s_][j] = *(const GAS v4u*)(Z + off); } } while (0)
      SSD_LDB(0, 0);
#pragma unroll
      for (int k = 0; k < 4; ++k) { const int s_ = k & 1;
          if (k + 1 < 4) SSD_LDB(k + 1, s_ ^ 1);
#pragma unroll
          for (int j = 0; j < 8; ++j) { float v[8], zz[8]; unpack8(raw[s_][j], v); unpack8(zr[s_][j], zz); float sq = 0.f;
#pragma unroll
              for (int e = 0; e < 8; ++e) { v[e] *= siluf(zz[e]); sq += v[e] * v[e]; }
              sq = wave_sum(sq); const float rsv = __builtin_amdgcn_rsqf(sq * (1.0f / 512.f) + EPS);
#pragma unroll
              for (int e = 0; e < 8; ++e) v[e] *= rsv * nwv[e];
              __builtin_nontemporal_store(pack8f(v), (GAS v4u*)(YG + (size_t)(t0 + wid * 32 + k * 8 + j) * DI + g * 512 + lane * 8)); } }
#undef SSD_LDB
    }
    __syncthreads();
}
__device__ __forceinline__ void ssd_out_phase(Frame& F, const Args& A, char* lds, int flag = 0) {
    for (int u = F.vcu; u < NCH * NG; u += F.G) out_unit(u >> 3, u & 7, A, lds, flag);
}
#undef SSD_TRRD
#undef SSD_F8
}

__device__ __forceinline__ void moba_sel_phase(Frame& F, const Args& A, char* lds) {
    unsigned char* ws = A.ws;
    att::SelRegs pre;
    if (F.vcu < AH * 31) att::moba_sel_load(pre, F.vcu / 31, 1 + F.vcu % 31, (const bf16*)(ws + WS_Q), (const bf16*)(ws + WS_KBARB));
    for (int u = F.vcu; u < AH * 31; u += F.G) { const int un = (u + F.G < AH * 31) ? u + F.G : u;
        att::moba_sel_unit(u / 31, 1 + u % 31, (const bf16*)(ws + WS_Q), (const bf16*)(ws + WS_KBARB), (int*)(ws + WS_CNT), (int*)(ws + WS_LIST), lds, pre, un / 31, 1 + un % 31); }
}
__device__ __forceinline__ void moba_part_phase(Frame& F, const Args& A, char* lds, int flag = 0) {
    unsigned char* ws = A.ws;
    int* nu_s = (int*)(lds + att::OFF_KBAR);
    int* base_s = nu_s + 1024; int* mine_s = nu_s + 1536; int* nmine_s = nu_s + 1600;
    const int* CNT = (const int*)(ws + WS_CNT);
    if (F.tid < AH * NBLK) { const int cv = *(volatile const int*)(CNT + F.tid); nu_s[F.tid] = (cv + 255) >> 8; nu_s[512 + F.tid] = cv; }
    if (F.tid == 0) *nmine_s = 0;
    __syncthreads();
    if (F.tid < 64) {
        int v[8], s = 0;
#pragma unroll
        for (int i = 0; i < 8; ++i) { v[i] = nu_s[F.tid * 8 + i]; s += v[i]; }
        int incl = s;
#pragma unroll
        for (int o = 1; o < 64; o <<= 1) { const int t = __shfl_up(incl, o); if (F.tid >= o) incl += t; }
        int run = incl - s;
#pragma unroll
        for (int i = 0; i < 8; ++i) { base_s[F.tid * 8 + i] = run; run += v[i]; }
    }
    __syncthreads();
    if (F.tid < AH * NBLK) { const int base = base_s[F.tid], nu = nu_s[F.tid];
        int g = base + (((F.vcu - base) % F.G) + F.G) % F.G;
        for (; g < base + nu; g += F.G) { const int idx = atomicAdd(nmine_s, 1); if (idx < 64) mine_s[idx] = F.tid | ((g - base) << 16); } }
    __syncthreads();
    const int nmine = *nmine_s < 64 ? *nmine_s : 64;
    int raw = 0;
    if (nmine > 0) { const int e = __builtin_amdgcn_readfirstlane(mine_s[0]); const int hn = e & 0xffff, e0 = (e >> 16) * 256; const int cnt = nu_s[512 + hn], nv = (cnt - e0) < 256 ? (cnt - e0) : 256;
        const int ei = F.wave * 32 + (F.lane & 31); raw = ((const int*)(ws + WS_LIST))[(size_t)hn * SEQ + e0 + (ei < nv ? ei : 0)]; }
    att::KVRegs kvc;
    if (nmine > 0) { const int hn = __builtin_amdgcn_readfirstlane(mine_s[0]) & 0xffff; att::moba_kv_first(kvc, hn >> 5, hn & 31, raw, (const bf16*)(ws + WS_Q), (const bf16*)(ws + WS_K), (const bf16*)(ws + WS_V), A.in[I_REL]); }
    for (int i = 0; i < nmine; ++i) { const int e = __builtin_amdgcn_readfirstlane(mine_s[i]); const int hn = e & 0xffff, jj = e >> 16;
        const int nxt = (i + 1 < nmine) ? __builtin_amdgcn_readfirstlane(mine_s[i + 1]) : -1;
        att::moba_tile_unit<1>(hn >> 5, hn & 31, jj, (const bf16*)(ws + WS_Q), (const bf16*)(ws + WS_K), (const bf16*)(ws + WS_V), flag == 23 ? (bf16*)(ws + WS_Q) : nullptr, CNT, (const int*)(ws + WS_LIST),
                               (bf16*)(ws + WS_PART), (float*)(ws + WS_PML), A.in[I_REL], lds, &raw, nxt, &kvc); }
}
__device__ __forceinline__ void moba_own_phase(Frame& F, const Args& A, char* lds, int flag = 0) {
    unsigned char* ws = A.ws;
    att::KVRegs kvc;
    if (F.vcu < AH * NBLK) att::moba_kv_first_own(kvc, F.vcu >> 5, F.vcu & 31, (const bf16*)(ws + WS_Q), (const bf16*)(ws + WS_K), (const bf16*)(ws + WS_V), A.in[I_REL]);
    for (int u = F.vcu; u < AH * NBLK; u += F.G)
        att::moba_tile_unit<2>(u >> 5, u & 31, flag == 24 ? 1 : 0, (const bf16*)(ws + WS_Q), (const bf16*)(ws + WS_K), (const bf16*)(ws + WS_V), (flag == 22 || flag == 24) ? (bf16*)A.out : (bf16*)(ws + WS_Q), nullptr, nullptr,
                               (bf16*)(ws + WS_PART), (float*)(ws + WS_PML), A.in[I_REL], lds, nullptr, (u + F.G < AH * NBLK) ? u + F.G : -1, &kvc);
}

#if MK_VARIANT != 6
__global__ void diag_cmp(const bf16* __restrict__ a, const bf16* __restrict__ b, size_t n, unsigned* stat) {
    float md = 0.f, mb = 0.f;
    for (size_t i = (size_t)blockIdx.x * blockDim.x + threadIdx.x; i < n; i += (size_t)gridDim.x * blockDim.x) { const float x = bf2f(a[i]), y = bf2f(b[i]); const float d = fabsf(x - y); md = (d > md || d != d) ? d : md; mb = fmaxf(mb, fabsf(y)); }
    if (md != md) md = 1e30f;
    atomicMax(stat, __float_as_uint(md)); atomicMax(stat + 1, __float_as_uint(mb));
    float sd = 0.f, cnt = 0.f;
    for (size_t i = (size_t)blockIdx.x * blockDim.x + threadIdx.x; i < n; i += (size_t)gridDim.x * blockDim.x) { const float d = fabsf(bf2f(a[i]) - bf2f(b[i])); sd += d; cnt += (d > 0.02f) ? 1.f : 0.f; }
    sd = wave_sum(sd); cnt = wave_sum(cnt);
    if ((threadIdx.x & 63) == 0) { atomicAdd((float*)(stat + 2), sd); atomicAdd((float*)(stat + 3), cnt); }
}
__global__ void diag_emit(const unsigned* stat, float* out, float scale, int which) {
    if (threadIdx.x == 0 && blockIdx.x == 0) out[0] = __uint_as_float(stat[which]) * scale;
}

__global__ void diag_stamps(const unsigned long long* ts, float* out, int ka, int kb) {
    if (threadIdx.x == 0 && blockIdx.x == 0) {
        out[0] = (ka == 10) ? (float)(ts[10] - ts[0]) * 0.01f : (float)(ts[ka + 1] - ts[ka]) * 0.01f;
        out[1] = (kb == 10) ? (float)(ts[10] - ts[0]) * 0.01f : (float)(ts[kb + 1] - ts[kb]) * 0.01f; }
}
#endif

__global__ void __launch_bounds__(NTHR, 2) mk_fwd(Args args) {
    extern __shared__ __attribute__((aligned(16))) unsigned char lds[];
    Frame F;
    F.lds = (LAS unsigned char*)lds;
    volatile LAS unsigned* MISC = (volatile LAS unsigned*)(F.lds + MISC_OFF);
    F.tid = threadIdx.x; F.lane = F.tid & 63; F.wave = __builtin_amdgcn_readfirstlane(F.tid >> 6);
    F.G = gridDim.x; { const int bx = blockIdx.x; F.vcu = (F.G % 8 == 0) ? (bx % 8) * (F.G / 8) + bx / 8 : bx; }
    unsigned char* ws = args.ws;
    gu32* ctl = (gu32*)(ws + WS_CTL);
    for (int u = F.tid; u < (LDS_BYTES - LDSCTL_OFF) / 4; u += NTHR) ((LAS unsigned*)(F.lds + LDSCTL_OFF))[u] = 0u;
    __syncthreads();
    const int lo = args.ph_lo, hi = args.ph_hi;
    const bool multi = (hi - lo) > 1;
    XcdBarrier bar; bar.bar = (unsigned*)(ctl + CW_BAR) + args.li * XCD_BAR_WORDS; bar.x = 0; bar.st = nullptr;
    if (multi) bar = xcd_barrier_post((unsigned*)(ctl + CW_BAR) + args.li * XCD_BAR_WORDS, MISC + 8);
#define IN(k) (lo <= (k) && (k) < hi)
#if MK_STAMPS
    unsigned long long* tsp = (unsigned long long*)(ws + WS_CTL + 8192);
    if (blockIdx.x == 0 && F.tid == 0) tsp[0] = __builtin_amdgcn_s_memrealtime();
#define STAMP(k) do { if (blockIdx.x == 0 && F.tid == 0) tsp[(k) + 1] = __builtin_amdgcn_s_memrealtime(); } while (0)
#else
#define STAMP(k) do { } while (0)
#endif
#define SEAM(k) do { if (IN(k) && IN((k) + 1)) xcd_barrier(bar); STAMP(k); } while (0)

    const int flag = args.pad;
    if (IN(0)) { p0_prologue(F, args, 0); SEAM(0); }
    if (IN(1)) {
        pg8::Gemm g{(const bf16*)(ws + WS_XB), (const bf16*)(ws + WS_WIN), SEQ, NIN, DM}; pg8::StaticOrder S; S.init(SEQ, NIN, F.G, (int)blockIdx.x);
        pg8::EpiInProj E{(bf16*)(ws + WS_Z), (bf16*)(ws + WS_XBC), (bf16*)(ws + WS_Q), (bf16*)(ws + WS_K), (bf16*)(ws + WS_V), (bf16*)(ws + WS_GT), args.in[I_BG], flag,
                          (PG8_LAS float*)(F.lds + QK_SCR_OFF), args.in[I_QNW], args.in[I_KNW], (float*)(ws + WS_KBAR), (bf16*)(ws + WS_KBARB)};
        const int cls = (F.vcu >> 5) % 3;
        if (flag == 0) { if (cls >= 1) p0_prologue(F, args, 1); if (cls == 2) p0_prologue(F, args, 2); __syncthreads(); }
        pg8::gemm_phase<pg8::EpiInProj, pg8::StaticOrder, true, true>(F.lds + RING_OFF, g, S, E);
        if (flag == 0) { __syncthreads(); if (cls == 0) p0_prologue(F, args, 1); if (cls <= 1) p0_prologue(F, args, 2); __syncthreads(); }
        if (flag != 10 && flag != 11) dt_phase(F, args);
        SEAM(1);
    }
    if (IN(2)) {
        const bool sel_first = ((F.vcu >> 5) & 1) == 0;
        if (flag == 0 && sel_first) { moba_sel_phase(F, args, (char*)lds); __syncthreads(); }
        ssd::ssd_states_phase(F, args, (char*)lds, flag);
        if (flag == 0 && !sel_first) { __syncthreads(); moba_sel_phase(F, args, (char*)lds); }
        SEAM(2); }
    if (IN(3)) { ssd::ssd_scan_phase(F, args); SEAM(3); }
    if (IN(4)) { if (flag != 21 && flag != 23) ssd::ssd_out_phase(F, args, (char*)lds, flag); if (flag == 0 || flag == 21 || flag == 23) moba_part_phase(F, args, (char*)lds, flag); SEAM(4); }
    if (IN(5)) { moba_own_phase(F, args, (char*)lds, flag); SEAM(5); }
    if (IN(6)) {
        { pg8::Gemm g{(const bf16*)(ws + WS_Q), (const bf16*)(ws + WS_WAT), SEQ, DM, DA}, g2{(const bf16*)(ws + WS_YG), (const bf16*)(ws + WS_WSS), SEQ, DM, DI};
          pg8::StaticOrder S; S.init(SEQ, DM, F.G, (int)blockIdx.x);
          pg8::EpiGateMix E{(bf16*)(ws + WS_XB), (const bf16*)(ws + WS_GT)};
          pg8::gemm_phase<pg8::EpiGateMix, pg8::StaticOrder, true, true, true>(F.lds + RING_OFF, g, S, E, g2); }
        SEAM(6);
    }
    if (IN(7)) {
        pg8::Gemm g{(const bf16*)(ws + WS_XB), (const bf16*)(ws + WS_WOUT), SEQ, DM, DM}; pg8::StaticOrder S; S.init(SEQ, DM, F.G, (int)blockIdx.x);
        pg8::EpiResid1 E{args.in[I_X], flag == 30 ? (float*)(ws + WS_Z) : args.out, flag == 30 ? (bf16*)(ws + WS_V) : (bf16*)(ws + WS_K), (float*)(ws + WS_SS2), flag == 30};
        pg8::gemm_phase<pg8::EpiResid1, pg8::StaticOrder, true, true>(F.lds + RING_OFF, g, S, E);
        SEAM(7);
    }
    if (IN(8)) {
        { pg8::Gemm g{(const bf16*)(ws + WS_K), (const bf16*)(ws + WS_WUP), SEQ, DFF2, DM}; pg8::StaticOrder S; S.init(SEQ, 40 * 256, F.G, (int)blockIdx.x);
          pg8::EpiFfnAct E{(bf16*)(ws + WS_ACT), (bf16*)(ws + WS_HALO), (const float*)(ws + WS_SS2), args.in[I_FCW], args.in[I_FCB]};
          pg8::gemm_phase<pg8::EpiFfnAct, pg8::StaticOrder, true, true>(F.lds + RING_OFF, g, S, E); }
        if (F.G == 256) { const int c = (int)blockIdx.x, tt = c & 127, half = c >> 7;
          pg8::Gemm g{(const bf16*)(ws + WS_K) + half * 1024, (const bf16*)(ws + WS_WUP) + half * 1024, SEQ, DFF2, 1024, DM};
          pg8::OneUnit S{{tt >> 2, 40 + (tt & 3)}};
          pg8::EpiUpPre E{half ? (bf16*)(ws + WS_UP2) : (bf16*)(ws + WS_UPRE), (const float*)(ws + WS_SS2), half ? 1024 : DFF2, half ? 40 * 256 : 0};
          pg8::gemm_phase<pg8::EpiUpPre, pg8::OneUnit, true, true>(F.lds + RING_OFF, g, S, E); }
        SEAM(8);
    }
    if (IN(9)) { ffn_fix_phase(F, args); SEAM(9); }
    if (IN(10)) {
        pg8::Gemm g{(const bf16*)(ws + WS_ACT), (const bf16*)(ws + WS_WDN), SEQ, DM, DFF}; pg8::StaticOrder S; S.init(SEQ, DM, F.G, (int)blockIdx.x);
        pg8::EpiResid2 E{(const bf16*)(ws + WS_K), flag == 31 ? (float*)(ws + WS_Z) : args.out};
        pg8::gemm_phase<pg8::EpiResid2, pg8::StaticOrder, true, true>(F.lds + RING_OFF, g, S, E);
        STAMP(10);
    }
#undef IN
#undef SEAM
}

extern "C" void kernel_launch(void* const* d_in, const int* in_sizes, int n_in, void* d_out, int out_size, void* d_ws, size_t ws_size, hipStream_t stream) {
    static int grid = 0;
    if (grid == 0) {
        if (n_in != N_INPUTS || in_sizes[0] != SEQ * DM || out_size != SEQ * DM || ws_size < WS_END) {
            fprintf(stderr, "kernel_launch: unexpected shapes: n_in %d in0 %d out %d ws %zu (need %zu)\n", n_in, n_in > 0 ? in_sizes[0] : -1, out_size, ws_size, (size_t)WS_END); grid = -1; return; }
        int dev = 0, cus = 0;
        if (hipGetDevice(&dev) != hipSuccess || hipDeviceGetAttribute(&cus, hipDeviceAttributeMultiprocessorCount, dev) != hipSuccess) { grid = -1; return; }
        if (hipFuncSetAttribute((const void*)mk_fwd, hipFuncAttributeMaxDynamicSharedMemorySize, LDS_BYTES) != hipSuccess) { fprintf(stderr, "kernel_launch: hipFuncSetAttribute failed\n"); grid = -1; return; }
        (void)hipGetLastError();
        grid = cus;
    }
    if (grid < 0) return;
    (void)hipMemsetAsync((char*)d_ws + WS_CTL, 0, CTL_ZERO_BYTES, stream);
    Args a{};
    for (int i = 0; i < N_INPUTS; ++i) a.in[i] = (const float*)d_in[i];
    a.out = (float*)d_out; a.ws = (unsigned char*)d_ws;
    unsigned char* ws = (unsigned char*)d_ws;
    auto launch = [&](int lo, int hi, int li, int flag = 0) { a.ph_lo = lo; a.ph_hi = hi; a.li = li; a.pad = flag; hipLaunchKernelGGL(mk_fwd, dim3(grid), dim3(NTHR), LDS_BYTES, stream, a); };
#if MK_VARIANT == 6
    launch(0, 11, 0);
#endif
#if MK_VARIANT == 8
    for (int k = 0; k < 11; ++k) {
        if (k == EXTRA_PH && EXTRA_FLAG) launch(k, k + 1, 0, EXTRA_FLAG);
        launch(k, k + 1, 0);
        if (k == EXTRA_PH && !EXTRA_FLAG) launch(k, k + 1, 0, k == 2 ? 2 : (k == 4 ? 20 : 0));
    }
#endif
#if MK_VARIANT == 10
    (void)hipMemsetAsync(ws + WS_CTL + 1024, 0, 64, stream);
    for (int k = 0; k < 5; ++k) launch(k, k + 1, 0);
    (void)hipMemcpyAsync(d_out, ws + WS_Q, (size_t)SEQ * DA * 2, hipMemcpyDeviceToDevice, stream);
    launch(5, 6, 0);
    naive_attn<<<SEQ * AH / 4, 256, 0, stream>>>((const bf16*)d_out, (const bf16*)(ws + WS_K), (const bf16*)(ws + WS_V), (const bf16*)(ws + WS_KBARB), a.in[I_REL], (bf16*)d_out + (size_t)SEQ * DA);
    diag_cmp<<<1024, 256, 0, stream>>>((const bf16*)(ws + WS_Q), (const bf16*)d_out + (size_t)SEQ * DA, (size_t)SEQ * DA, (unsigned*)(ws + WS_CTL + 1024));
    for (int k = 6; k < 11; ++k) launch(k, k + 1, 0);
    diag_emit<<<1, 64, 0, stream>>>((const unsigned*)(ws + WS_CTL + 1024), (float*)d_out, DIAG_SCALE, DIAG_WHICH);
#endif
}
```
